# Optimizing an MI355X kernel written in HIP

```python
import math
import jax, jax.numpy as jnp
from jax import lax
import numpy as np

D_MODEL = 1024
BATCH = 8
SEQ = 4096
DEPTH = 2

D_MIX = D_MODEL
HEAD_DIM = 64
ATT_WIDTH = 3 * D_MIX // 8
ATT_HEADS = ATT_WIDTH // HEAD_DIM
LRU_WIDTH = 3 * D_MIX // 8
LRU_BLOCKS = 6
LRU_BLOCK_DIM = LRU_WIDTH // LRU_BLOCKS
S5_WIDTH = D_MIX - ATT_WIDTH - LRU_WIDTH
S5_GROUP_CH = 16
S5_GROUPS = S5_WIDTH // S5_GROUP_CH
S5_STATE = 64
CONV_WIDTH = 4
LRU_C = 8.0
MOBA_BLOCK = 256
MOBA_TOPK = 3
Q_CHUNK = 64
ROPE_THETA = 10000.0
D_FF = 2816
N_EXPERTS = 8
TOP_K = 2
D_FF_EXPERT = 3584
N_DENSE = (DEPTH + 1) // 2
N_MOE = DEPTH // 2
IN_WIDTH = 3 * ATT_WIDTH + 2 * LRU_WIDTH + S5_WIDTH
IN_SPLITS = (ATT_WIDTH, 2 * ATT_WIDTH, 3 * ATT_WIDTH,
             3 * ATT_WIDTH + LRU_WIDTH, 3 * ATT_WIDTH + 2 * LRU_WIDTH)
EPS = 1e-6
NEG = -1e30

kernel_name = 'hybrid_moba_rglru_s5_moe_block'


def rms_norm(x, g):
    x32 = x.astype(jnp.float32)
    y = x32 * lax.rsqrt(jnp.mean(x32 * x32, axis=-1, keepdims=True) + EPS)
    return (y * g.astype(jnp.float32)).astype(x.dtype)


def rope_tables(positions):
    inv = ROPE_THETA ** (-jnp.arange(0, HEAD_DIM, 2, dtype=jnp.float32) / HEAD_DIM)
    ang = positions.astype(jnp.float32)[..., None] * inv
    return jnp.cos(ang)[:, :, None, :], jnp.sin(ang)[:, :, None, :]


def apply_rope(x, cos, sin):
    half = x.shape[-1] // 2
    x32 = x.astype(jnp.float32)
    x1, x2 = x32[..., :half], x32[..., half:]
    return jnp.concatenate([x1 * cos - x2 * sin, x2 * cos + x1 * sin], axis=-1).astype(x.dtype)


def moba_attention(q, k, v):
    b, s, h, d = q.shape
    n_blk = -(-s // MOBA_BLOCK)
    s_pad = n_blk * MOBA_BLOCK
    top_k = min(MOBA_TOPK, n_blk)
    q = jnp.transpose(q, (0, 2, 1, 3)) * (d ** -0.5)
    pad = ((0, 0), (0, 0), (0, s_pad - s), (0, 0))
    k = jnp.pad(jnp.transpose(k, (0, 2, 1, 3)), pad)
    v = jnp.pad(jnp.transpose(v, (0, 2, 1, 3)), pad)
    k_blocks = k.reshape(b, h, n_blk, MOBA_BLOCK, d)
    v_blocks = v.reshape(b, h, n_blk, MOBA_BLOCK, d)
    k_mean = jnp.mean(k_blocks.astype(jnp.float32), axis=3)
    gather = jax.vmap(jax.vmap(lambda blocks, idx: blocks[idx]))
    blk_ids = jnp.arange(n_blk)
    q_off = jnp.arange(Q_CHUNK)
    k_off = jnp.arange(MOBA_BLOCK)

    def chunk(ci):
        s0 = ci * Q_CHUNK
        j = s0 // MOBA_BLOCK
        qc = lax.dynamic_slice_in_dim(q, s0, Q_CHUNK, axis=2)
        gate = jnp.einsum('bhqd,bhnd->bhqn', qc.astype(jnp.float32), k_mean)
        gate = jnp.where(blk_ids < j, gate, NEG)
        _, sel = lax.top_k(gate, top_k)
        sel_valid = jnp.arange(top_k) < j
        k_sel = gather(k_blocks, sel)
        v_sel = gather(v_blocks, sel)
        k_own = lax.dynamic_slice_in_dim(k, j * MOBA_BLOCK, MOBA_BLOCK, axis=2)
        v_own = lax.dynamic_slice_in_dim(v, j * MOBA_BLOCK, MOBA_BLOCK, axis=2)
        s_sel = jnp.einsum('bhqd,bhqnkd->bhqnk', qc, k_sel).astype(jnp.float32)
        s_sel = jnp.where(sel_valid[:, None], s_sel, NEG).reshape(b, h, Q_CHUNK, top_k * MOBA_BLOCK)
        s_own = jnp.einsum('bhqd,bhkd->bhqk', qc, k_own).astype(jnp.float32)
        causal = (j * MOBA_BLOCK + k_off)[None, :] <= (s0 + q_off)[:, None]
        s_own = jnp.where(causal, s_own, NEG)
        p = jax.nn.softmax(jnp.concatenate([s_own, s_sel], axis=-1), axis=-1).astype(v.dtype)
        p_own = p[..., :MOBA_BLOCK]
        p_sel = p[..., MOBA_BLOCK:].reshape(b, h, Q_CHUNK, top_k, MOBA_BLOCK)
        return (jnp.einsum('bhqk,bhkd->bhqd', p_own, v_own)
                + jnp.einsum('bhqnk,bhqnkd->bhqd', p_sel, v_sel))

    out = lax.map(chunk, jnp.arange(s // Q_CHUNK))
    return jnp.transpose(out, (1, 0, 3, 2, 4)).reshape(b, s, h * d)


def linear_scan(a, u):
    def combine(e1, e2):
        return (e1[0] * e2[0], e2[0] * e1[1] + e2[1])
    return lax.associative_scan(combine, (a, u), axis=1)[1]


def rglru_branch(xr, gate, conv_w, conv_b, w_a, b_a, w_x, b_x, lam):
    b, s, w = xr.shape
    xc = lax.conv_general_dilated(xr, conv_w[:, None, :], window_strides=(1,),
                                  padding=[(CONV_WIDTH - 1, 0)],
                                  dimension_numbers=('NWC', 'WIO', 'NWC'),
                                  feature_group_count=w) + conv_b
    xb = xc.reshape(b, s, LRU_BLOCKS, LRU_BLOCK_DIM)
    r = jax.nn.sigmoid(jnp.einsum('bshi,hij->bshj', xb, w_a).reshape(b, s, w) + b_a)
    i = jax.nn.sigmoid(jnp.einsum('bshi,hij->bshj', xb, w_x).reshape(b, s, w) + b_x)
    log_a = -LRU_C * r.astype(jnp.float32) * jax.nn.softplus(-lam.astype(jnp.float32))
    a = jnp.exp(log_a)
    u = jnp.sqrt(jnp.maximum(-jnp.expm1(2.0 * log_a), 0.0)) * (i * xc).astype(jnp.float32)
    hseq = linear_scan(a, u)
    return hseq.astype(xr.dtype) * jax.nn.gelu(gate)


def s5_branch(u, lam_re, lam_im, log_dt, b_re, b_im, c_re, c_im, d_skip, glu_w, glu_b):
    b, s, w = u.shape
    f32 = jnp.float32
    ug = u.reshape(b, s, S5_GROUPS, S5_GROUP_CH).astype(f32)
    dt = jnp.exp(log_dt.astype(f32))[:, None]
    lr, li = lam_re.astype(f32), lam_im.astype(f32)
    mag = jnp.exp(lr * dt)
    ab_re, ab_im = mag * jnp.cos(li * dt), mag * jnp.sin(li * dt)
    den = lr * lr + li * li
    nr, ni = ab_re - 1.0, ab_im
    co_re = (nr * lr + ni * li) / den
    co_im = (ni * lr - nr * li) / den
    br, bi = b_re.astype(f32), b_im.astype(f32)
    bb_re = co_re[..., None] * br - co_im[..., None] * bi
    bb_im = co_re[..., None] * bi + co_im[..., None] * br
    bu_re = jnp.einsum('bsgh,gph->bsgp', ug, bb_re)
    bu_im = jnp.einsum('bsgh,gph->bsgp', ug, bb_im)
    a_re = jnp.broadcast_to(ab_re, bu_re.shape)
    a_im = jnp.broadcast_to(ab_im, bu_re.shape)

    def combine(e1, e2):
        ar1, ai1, xr1, xi1 = e1
        ar2, ai2, xr2, xi2 = e2
        return (ar2 * ar1 - ai2 * ai1, ar2 * ai1 + ai2 * ar1,
                ar2 * xr1 - ai2 * xi1 + xr2, ar2 * xi1 + ai2 * xr1 + xi2)

    _, _, st_re, st_im = lax.associative_scan(combine, (a_re, a_im, bu_re, bu_im), axis=1)
    y = (jnp.einsum('bsgp,ghp->bsgh', st_re, c_re.astype(f32))
         - jnp.einsum('bsgp,ghp->bsgh', st_im, c_im.astype(f32))
         + d_skip.astype(f32).reshape(S5_GROUPS, S5_GROUP_CH) * ug)
    y = jax.nn.gelu(y.reshape(b, s, w)).astype(u.dtype)
    return y * jax.nn.sigmoid(y @ glu_w + glu_b)


def mixer(h, cos, sin, w_in, conv_w, conv_b, w_a, b_a, w_x, b_x, lam,
          lam_re, lam_im, log_dt, s5b_re, s5b_im, s5c_re, s5c_im, s5_d, glu_w, glu_b,
          mix_gain, w_out):
    b, s, _ = h.shape
    proj = h @ w_in
    q, k, v, xr, gate, u = jnp.split(proj, IN_SPLITS, axis=-1)
    q = apply_rope(q.reshape(b, s, ATT_HEADS, HEAD_DIM), cos, sin)
    k = apply_rope(k.reshape(b, s, ATT_HEADS, HEAD_DIM), cos, sin)
    v = v.reshape(b, s, ATT_HEADS, HEAD_DIM)
    o_att = moba_attention(q, k, v)
    o_lru = rglru_branch(xr, gate, conv_w, conv_b, w_a, b_a, w_x, b_x, lam)
    o_s5 = s5_branch(u, lam_re, lam_im, log_dt, s5b_re, s5b_im, s5c_re, s5c_im, s5_d, glu_w, glu_b)
    o = jnp.concatenate([
        rms_norm(o_att, mix_gain[:ATT_WIDTH]),
        rms_norm(o_lru, mix_gain[ATT_WIDTH:ATT_WIDTH + LRU_WIDTH]),
        rms_norm(o_s5, mix_gain[ATT_WIDTH + LRU_WIDTH:])], axis=-1)
    return o @ w_out


def swiglu(h, wg, wu, wd):
    return (jax.nn.silu(h @ wg) * (h @ wu)) @ wd


def moe_swiglu(h, router_w, wg, wu, wd):
    logits = (h @ router_w).astype(jnp.float32)
    top_v, top_i = lax.top_k(logits, TOP_K)
    probs = jax.nn.softmax(top_v, axis=-1)
    weights = jnp.sum(jax.nn.one_hot(top_i, N_EXPERTS, dtype=jnp.float32) * probs[..., None], axis=-2)
    out = jnp.zeros_like(h)
    for e in range(N_EXPERTS):
        out = out + weights[..., e:e + 1].astype(h.dtype) * swiglu(h, wg[e], wu[e], wd[e])
    return out


def setup_inputs(seed: int = 0) -> dict:
    key = jax.random.key(seed)
    keys = jax.random.split(key, 48)
    counter = [0]
    f32 = jnp.float32
    L = DEPTH

    def nxt():
        kk = keys[counter[0]]
        counter[0] += 1
        return kk

    def nrm(shape, scale):
        return jax.random.normal(nxt(), shape, f32) * scale

    x = nrm((BATCH, SEQ, D_MODEL), 1.0)
    c = nrm((BATCH, D_MODEL), 1.0)
    offs = jax.random.randint(nxt(), (BATCH, 1), 0, 2048, dtype=jnp.int32)
    positions = offs + jnp.arange(SEQ, dtype=jnp.int32)[None, :]
    w_in = nrm((L, D_MODEL, IN_WIDTH), D_MODEL ** -0.5)
    lru_conv_w = nrm((L, CONV_WIDTH, LRU_WIDTH), CONV_WIDTH ** -0.5)
    lru_conv_b = nrm((L, LRU_WIDTH), 0.01)
    lru_w_a = nrm((L, LRU_BLOCKS, LRU_BLOCK_DIM, LRU_BLOCK_DIM), LRU_BLOCK_DIM ** -0.5)
    lru_b_a = nrm((L, LRU_WIDTH), 0.01)
    lru_w_x = nrm((L, LRU_BLOCKS, LRU_BLOCK_DIM, LRU_BLOCK_DIM), LRU_BLOCK_DIM ** -0.5)
    lru_b_x = nrm((L, LRU_WIDTH), 0.01)
    a_c = jax.random.uniform(nxt(), (L, LRU_WIDTH), f32, 0.9, 0.999)
    a0 = a_c ** (1.0 / LRU_C)
    lru_lambda = jnp.log(a0) - jnp.log1p(-a0)
    s5_lambda_re = -0.5 + nrm((L, S5_GROUPS, S5_STATE), 0.01)
    s5_lambda_im = math.pi * jnp.arange(S5_STATE, dtype=f32) + nrm((L, S5_GROUPS, S5_STATE), 0.01)
    s5_log_dt = jax.random.uniform(nxt(), (L, S5_GROUPS), f32, math.log(1e-3), math.log(1e-1))
    s5_b_re = nrm((L, S5_GROUPS, S5_STATE, S5_GROUP_CH), (2.0 * S5_GROUP_CH) ** -0.5)
    s5_b_im = nrm((L, S5_GROUPS, S5_STATE, S5_GROUP_CH), (2.0 * S5_GROUP_CH) ** -0.5)
    s5_c_re = nrm((L, S5_GROUPS, S5_GROUP_CH, S5_STATE), (2.0 * S5_STATE) ** -0.5)
    s5_c_im = nrm((L, S5_GROUPS, S5_GROUP_CH, S5_STATE), (2.0 * S5_STATE) ** -0.5)
    s5_d = nrm((L, S5_WIDTH), 1.0)
    s5_glu_w = nrm((L, S5_WIDTH, S5_WIDTH), S5_WIDTH ** -0.5)
    s5_glu_b = nrm((L, S5_WIDTH), 0.01)
    mix_gain = 1.0 + nrm((L, D_MIX), 0.01)
    w_out = nrm((L, D_MIX, D_MODEL), D_MIX ** -0.5)
    norm1_g = 1.0 + nrm((L, D_MODEL), 0.01)
    norm2_g = 1.0 + nrm((L, D_MODEL), 0.01)
    ada_w = nrm((L, D_MODEL, 6 * D_MODEL), 0.5 * D_MODEL ** -0.5)
    ada_b = nrm((L, 6 * D_MODEL), 0.01)
    ffn_w_gate = nrm((N_DENSE, D_MODEL, D_FF), D_MODEL ** -0.5)
    ffn_w_up = nrm((N_DENSE, D_MODEL, D_FF), D_MODEL ** -0.5)
    ffn_w_down = nrm((N_DENSE, D_FF, D_MODEL), D_FF ** -0.5)
    router_w = nrm((N_MOE, D_MODEL, N_EXPERTS), D_MODEL ** -0.5)
    moe_w_gate = nrm((N_MOE, N_EXPERTS, D_MODEL, D_FF_EXPERT), D_MODEL ** -0.5)
    moe_w_up = nrm((N_MOE, N_EXPERTS, D_MODEL, D_FF_EXPERT), D_MODEL ** -0.5)
    moe_w_down = nrm((N_MOE, N_EXPERTS, D_FF_EXPERT, D_MODEL), D_FF_EXPERT ** -0.5)
    final_g = 1.0 + nrm((D_MODEL,), 0.01)
    return {'x': x, 'c': c, 'positions': positions, 'w_in': w_in,
            'lru_conv_w': lru_conv_w, 'lru_conv_b': lru_conv_b, 'lru_w_a': lru_w_a,
            'lru_b_a': lru_b_a, 'lru_w_x': lru_w_x, 'lru_b_x': lru_b_x, 'lru_lambda': lru_lambda,
            's5_lambda_re': s5_lambda_re, 's5_lambda_im': s5_lambda_im, 's5_log_dt': s5_log_dt,
            's5_b_re': s5_b_re, 's5_b_im': s5_b_im, 's5_c_re': s5_c_re, 's5_c_im': s5_c_im,
            's5_d': s5_d, 's5_glu_w': s5_glu_w, 's5_glu_b': s5_glu_b, 'mix_gain': mix_gain,
            'w_out': w_out, 'norm1_g': norm1_g, 'norm2_g': norm2_g, 'ada_w': ada_w, 'ada_b': ada_b,
            'ffn_w_gate': ffn_w_gate, 'ffn_w_up': ffn_w_up, 'ffn_w_down': ffn_w_down,
            'router_w': router_w, 'moe_w_gate': moe_w_gate, 'moe_w_up': moe_w_up,
            'moe_w_down': moe_w_down, 'final_g': final_g}


def reference(x, c, positions, w_in, lru_conv_w, lru_conv_b, lru_w_a, lru_b_a, lru_w_x, lru_b_x,
              lru_lambda, s5_lambda_re, s5_lambda_im, s5_log_dt, s5_b_re, s5_b_im, s5_c_re, s5_c_im,
              s5_d, s5_glu_w, s5_glu_b, mix_gain, w_out, norm1_g, norm2_g, ada_w, ada_b,
              ffn_w_gate, ffn_w_up, ffn_w_down, router_w, moe_w_gate, moe_w_up, moe_w_down, final_g):
    cos, sin = rope_tables(positions)
    cond = jax.nn.silu(c)
    for l in range(DEPTH):
        mod = (cond @ ada_w[l] + ada_b[l])[:, None, :]
        shift1, scale1, gate1, shift2, scale2, gate2 = jnp.split(mod, 6, axis=-1)
        h = rms_norm(x, norm1_g[l]) * (1.0 + scale1) + shift1
        x = x + gate1 * mixer(h, cos, sin, w_in[l], lru_conv_w[l], lru_conv_b[l], lru_w_a[l],
                              lru_b_a[l], lru_w_x[l], lru_b_x[l], lru_lambda[l],
                              s5_lambda_re[l], s5_lambda_im[l], s5_log_dt[l], s5_b_re[l],
                              s5_b_im[l], s5_c_re[l], s5_c_im[l], s5_d[l], s5_glu_w[l],
                              s5_glu_b[l], mix_gain[l], w_out[l])
        h = rms_norm(x, norm2_g[l]) * (1.0 + scale2) + shift2
        if l % 2 == 0:
            f = swiglu(h, ffn_w_gate[l // 2], ffn_w_up[l // 2], ffn_w_down[l // 2])
        else:
            f = moe_swiglu(h, router_w[l // 2], moe_w_gate[l // 2], moe_w_up[l // 2], moe_w_down[l // 2])
        x = x + gate2 * f
    return rms_norm(x, final_g)
```

```cpp
#define DENSE_FP8 0
#include <hip/hip_runtime.h>
#include <cstdio>
#include <cstdint>
#include <cmath>

#ifndef DENSE_FP8
#define DENSE_FP8 1
#endif
#define GAS __attribute__((address_space(1)))
#define LAS __attribute__((address_space(3)))
typedef _Float16 half_t;
typedef _Float16 h8 __attribute__((ext_vector_type(8)));
typedef _Float16 h4 __attribute__((ext_vector_type(4)));
typedef _Float16 h2 __attribute__((ext_vector_type(2)));
typedef float f32x4 __attribute__((ext_vector_type(4)));
typedef float f32x2 __attribute__((ext_vector_type(2)));
typedef float f32x16 __attribute__((ext_vector_type(16)));
typedef unsigned u32x4 __attribute__((ext_vector_type(4)));
typedef unsigned u32x2 __attribute__((ext_vector_type(2)));
typedef short s16x8 __attribute__((ext_vector_type(8)));
typedef short s16x4 __attribute__((ext_vector_type(4)));
typedef int v8i_t __attribute__((ext_vector_type(8)));

constexpr int BATCH = 8, SEQ = 4096, M = BATCH * SEQ, D = 1024, NH = 6, HD = 64;
constexpr int NPROJ = 2176, NPROJ_PAD = 2304;
constexpr int COL_K = 384, COL_V = 768, COL_XR = 1152, COL_GT = 1536, COL_U = 1920;
constexpr int FF = 2816, FFE = 3584, NE = 8;
constexpr int LRU_W = 384, S5_W = 256, S5_G = 16, S5_P = 64;
constexpr int CH_T = 64, NCH = SEQ / CH_T;
constexpr float EPS = 1e-6f;
constexpr float C2 = 0.125f * 1.4426950408889634f;
constexpr int MOE_CH_TILES = 136;
constexpr int MOE_REG_TILES = 128;
constexpr int MOE_MAX_TILES = 264;
constexpr int MOE_NCHUNK = 2;
constexpr int MOE_SLOTS = MOE_MAX_TILES * 256;

__device__ __forceinline__ unsigned pk_fp8x4(float a, float b, float c, float d) { int w = __builtin_amdgcn_cvt_pk_fp8_f32(a, b, 0, false); w = __builtin_amdgcn_cvt_pk_fp8_f32(c, d, w, true); return (unsigned)w; }
__device__ __forceinline__ unsigned pkh(float lo, float hi) { f32x2 v = {lo, hi}; h2 h = __builtin_convertvector(v, h2); return __builtin_bit_cast(unsigned, h); }
__device__ __forceinline__ float sigmoidf_(float x) { return __builtin_amdgcn_rcpf(1.f + __expf(-x)); }
__device__ __forceinline__ float siluf_(float x) { return x * sigmoidf_(x); }
__device__ __forceinline__ float gelu_tanh(float x) { const float y = 0.7978845608028654f * (x + 0.044715f * x * x * x); const float t = 1.f - 2.f * __builtin_amdgcn_rcpf(1.f + __expf(2.f * y)); return 0.5f * x * (1.f + t); }
template <int O> __device__ __forceinline__ float xor_lane(float v) {
    if constexpr (O < 32) return __builtin_bit_cast(float, __builtin_amdgcn_ds_swizzle(__builtin_bit_cast(int, v), 0x1f | (O << 10)));
    else { unsigned z_ = 0u; asm volatile("" : "+v"(z_)); const int lane = (int)__builtin_amdgcn_mbcnt_hi(~0u, __builtin_amdgcn_mbcnt_lo(~0u, z_));
        return __builtin_bit_cast(float, __builtin_amdgcn_ds_bpermute((lane ^ 32) << 2, __builtin_bit_cast(int, v))); }
}
#define DPP_ADD(v, ctrl, rmask) ((v) + __builtin_bit_cast(float, __builtin_amdgcn_update_dpp(0, __builtin_bit_cast(int, (v)), (ctrl), (rmask), 0xf, true)))
__device__ __forceinline__ float wave_sum(float v) {
    v = DPP_ADD(v, 0xB1, 0xf);
    v = DPP_ADD(v, 0x4E, 0xf);
    v = DPP_ADD(v, 0x141, 0xf);
    v = DPP_ADD(v, 0x140, 0xf);
    v = DPP_ADD(v, 0x142, 0xa);
    v = DPP_ADD(v, 0x143, 0xc);
    return __builtin_bit_cast(float, __builtin_amdgcn_readlane(__builtin_bit_cast(int, v), 63));
}
#define LDS_WAIT() asm volatile("s_waitcnt lgkmcnt(0)" ::: "memory")
#define VM_WAIT() asm volatile("s_waitcnt vmcnt(0)" ::: "memory")

namespace pg8 {
constexpr int BM = 256, BK = 64, HALF = 128, HTB = HALF * BK * 2, STAGE_BYTES = 8 * HTB, NXCD = 8, WGM = 8;
__host__ __device__ __forceinline__ int lds_byte(int r, int c) { const int st = (r >> 4) * 2 + (c >> 5), rr = r & 15, cc = c & 31, ob = rr * 64 + cc * 2; return st * 1024 + (ob ^ (((ob >> 9) & 1) << 5)); }
__host__ __device__ __forceinline__ void stage_rc(int b, int& R, int& C) { const int st = b / 1024, sb = b % 1024, swz = sb ^ (((sb >> 9) & 1) << 5); R = (st >> 1) * 16 + swz / 64; C = (st & 1) * 32 + (swz % 64) / 2; }
__host__ __device__ __forceinline__ int perm32(int rho) { const int n = rho >> 4, i = rho & 15; return 8 * (i >> 2) + 4 * n + (i & 3); }

struct Unit { int pm, pn, pb; };
struct Gemm { const void* A; const void* Bt; int M, N, K; const int* gidx; const float* ssq; int midk; };

struct StaticOrder {
    int nM, nN, nwg, G, c;
    __host__ __device__ void init(int M_, int N_, int G_, int c_) { nM = M_ / BM; nN = N_ / BM; nwg = nM * nN; G = G_; c = c_; }
    __host__ __device__ bool next(int i, Unit& u) const { return at((long)i * G + c, u); }
    __host__ __device__ bool at(long L, Unit& u) const {
        if (L >= nwg) return false;
        int wgid = (int)L; { const int q = nwg / NXCD, r = nwg % NXCD, xcd = wgid % NXCD, off = wgid / NXCD; wgid = (xcd < r ? xcd * (q + 1) : r * (q + 1) + (xcd - r) * q) + off; }
        const int nig = WGM * nN, gid = wgid / nig, fm = gid * WGM, gsz = (nM - fm) < WGM ? (nM - fm) : WGM;
        u.pm = fm + ((wgid % nig) % gsz); u.pn = (wgid % nig) / gsz; u.pb = u.pn; return true;
    }
};
struct MoeOrder {
    StaticOrder so; const int* texp; int nNe;
#ifdef DBG_NOTEXP
    __device__ bool next(int i, Unit& u) const { if (!so.next(i, u)) return false; u.pb = (u.pm & 7) * nNe + u.pn; return true; }
#else
    __device__ bool next(int i, Unit& u) const { if (!so.next(i, u)) return false; const int e = texp[u.pm]; u.pb = e * nNe + u.pn; return true; }
#endif
};

struct MoeSkewOrder {
    static constexpr int LATE = 3;
    StaticOrder so; const int* texp; int nNe, T;
    __device__ bool next(int i, Unit& u) const {
        const int c = so.c, G = so.G; long L;
        if (c < T) L = (long)LATE * (G - T) + (long)i * G + c;
        else L = i < LATE ? (long)i * (G - T) + (c - T) : (long)LATE * (G - T) + (long)(i - LATE) * G + c;
        if (!so.at(L, u)) return false; const int e = texp[u.pm]; u.pb = e * nNe + u.pn; return true; }
};

template <class Epi, class Sched, bool ALIGN_EPI, bool SP2, bool GATHER, bool FP8 = false>
__device__ __forceinline__ void gemm_phase(LAS unsigned char* lds, const Gemm g, const Sched& S, const Epi& E, int wave_) {
    unsigned z_ = 0u; asm volatile("" : "+v"(z_)); int tid_ = wave_ * 64 + (int)__builtin_amdgcn_mbcnt_hi(~0u, __builtin_amdgcn_mbcnt_lo(~0u, z_));
    const int tid = tid_, wid = wave_, lane = tid & 63, wr = wid >> 2, wc = wid & 3, fr = lane & 15, fq = lane >> 4;
    constexpr int EB = FP8 ? 1 : 2;
    int K_ = g.K; asm volatile("" : "+s"(K_));
    const int K = K_, nt = K * EB / (BK * 2);
    unsigned voffA[2], voffB[2]; int RA[2], CA[2];
#pragma unroll
    for (int i = 0; i < 2; ++i) { int R, C; stage_rc(tid * 16 + i * 8192, R, C); const int Rb = Epi::PERM ? ((R & ~31) + perm32(R & 31)) : R;
        voffA[i] = (unsigned)(R * K * EB + C * 2); voffB[i] = (unsigned)(Rb * K * EB + C * 2); RA[i] = R; CA[i] = C; }
    const size_t kstep = (size_t)(BK * 2);
    const size_t hstep = (size_t)HALF * K * EB;
    const size_t tstep = 2 * hstep;
    const unsigned ldsw = (unsigned)wid * 1024u;
    const int aoff = lds_byte(wr * 64 + fr, fq * 8), boff = lds_byte(wc * 32 + fr, fq * 8);
    const int aoff8a = lds_byte(wr * 64 + fr, 16 * fq), boff8a = lds_byte(wc * 32 + fr, 16 * fq); constexpr int aoff8b = 16, boff8b = 16;
    unsigned offC[2][2], offN[2][2];
#define PG8_SA(b, h) (((b) * 2 + (h)) * HTB)
#define PG8_SB(b, h) ((4 + (b) * 2 + (h)) * HTB)
#define PG8_GLDS(gp, lp) __builtin_amdgcn_global_load_lds((const unsigned*)(gp), (LAS unsigned*)(lp), 16, 0, 0)
#define PG8_STAGE(bufoff, gbase, voff) do { _Pragma("unroll") for (int _i = 0; _i < 2; ++_i) PG8_GLDS((const char*)(gbase) + (voff)[_i], lds + (bufoff) + ldsw + _i * 8192); } while (0)
#define PG8_STAGE_A(bufoff, gbase, hh, nx) do { if constexpr (GATHER) { _Pragma("unroll") for (int _i = 0; _i < 2; ++_i) { const unsigned _o = (nx) ? offN[hh][_i] : offC[hh][_i]; PG8_GLDS((const char*)(gbase) + _o, lds + (bufoff) + ldsw + _i * 8192); } } \
        else { PG8_STAGE(bufoff, (gbase) + (hh) * hstep, voffA); } } while (0)
#define PG8_LD32(p0, p1) __builtin_bit_cast(v8i_t, __builtin_shufflevector(*(const LAS u32x4*)(p0), *(const LAS u32x4*)(p1), 0, 1, 2, 3, 4, 5, 6, 7))
#define PG8_LDA(dst, b, h) do { if constexpr (FP8) { _Pragma("unroll") for (int m = 0; m < 4; ++m) dst##8[m] = PG8_LD32(lds + PG8_SA(b, h) + aoff8a + m * 2048, lds + PG8_SA(b, h) + aoff8a + aoff8b + m * 2048); } \
        else { _Pragma("unroll") for (int m = 0; m < 4; ++m) _Pragma("unroll") for (int k = 0; k < 2; ++k) dst[m][k] = *(const LAS h8*)(lds + PG8_SA(b, h) + aoff + m * 2048 + k * 1024); } } while (0)
#define PG8_LDB(dst, b, h) do { if constexpr (FP8) { _Pragma("unroll") for (int n = 0; n < 2; ++n) dst##8[n] = PG8_LD32(lds + PG8_SB(b, h) + boff8a + n * 2048, lds + PG8_SB(b, h) + boff8a + boff8b + n * 2048); } \
        else { _Pragma("unroll") for (int n = 0; n < 2; ++n) _Pragma("unroll") for (int k = 0; k < 2; ++k) dst[n][k] = *(const LAS h8*)(lds + PG8_SB(b, h) + boff + n * 2048 + k * 1024); } } while (0)
#define PG8_MMA(ai, bj, At, Bt) do { __builtin_amdgcn_s_setprio(1); if constexpr (FP8) { _Pragma("unroll") for (int m = 0; m < 4; ++m) _Pragma("unroll") for (int n = 0; n < 2; ++n) \
        asm volatile("v_mfma_f32_16x16x128_f8f6f4 %0, %1, %2, %0" : "+v"(acc[ai][bj][m][n]) : "v"(Bt##8[n]), "v"(At##8[m])); PG8_FP8_PAD } \
        else { _Pragma("unroll") for (int m = 0; m < 4; ++m) _Pragma("unroll") for (int n = 0; n < 2; ++n) _Pragma("unroll") for (int k = 0; k < 2; ++k) \
        acc[ai][bj][m][n] = __builtin_amdgcn_mfma_f32_16x16x32_f16(Bt[n][k], At[m][k], acc[ai][bj][m][n], 0, 0, 0); } __builtin_amdgcn_s_setprio(0); } while (0)
#ifdef DBG_DRAIN
#define PG8_WAIT_V(n) asm volatile("s_waitcnt vmcnt(0)" ::: "memory")
#else
#define PG8_WAIT_V(n) asm volatile("s_waitcnt vmcnt(" #n ")" ::: "memory")
#endif
#ifdef DBG_FP8PAD
#define PG8_FP8_PAD asm volatile("s_nop 15\n\ts_nop 15\n\ts_nop 15\n\ts_nop 15\n\ts_nop 15" ::: "memory");
#else
#define PG8_FP8_PAD
#endif
#define PG8_WAIT_L(n) asm volatile("s_waitcnt lgkmcnt(" #n ")" ::: "memory")
#define PG8_BAR __builtin_amdgcn_s_barrier()
#define PG8_SCHED __builtin_amdgcn_sched_barrier(0)
#define PG8_GOFF(dst, u_) do { if constexpr (GATHER) { _Pragma("unroll") for (int _h = 0; _h < 2; ++_h) _Pragma("unroll") for (int _i = 0; _i < 2; ++_i) \
        dst[_h][_i] = (unsigned)(((const GAS int*)g.gidx)[(u_).pm * BM + _h * HALF + RA[_i]] * K * EB + CA[_i] * 2); } } while (0)
    Unit cur, nxt; int ui = 0;
    if (!S.next(0, cur)) return;
    f32x4 acc[2][2][4][2];
#pragma unroll
    for (int a = 0; a < 2; ++a)
#pragma unroll
        for (int b = 0; b < 2; ++b)
#pragma unroll
            for (int m = 0; m < 4; ++m)
#pragma unroll
                for (int n = 0; n < 2; ++n) acc[a][b][m][n] = (f32x4){0.f, 0.f, 0.f, 0.f};
    h8 At[4][2], B0[2][2], B1[2][2];
    v8i_t At8[4], B08[2], B18[2];
    PG8_GOFF(offC, cur);
#pragma unroll
    for (int _h = 0; _h < 2; ++_h)
#pragma unroll
        for (int _i = 0; _i < 2; ++_i) offN[_h][_i] = offC[_h][_i];
    const char* cA = GATHER ? (const char*)g.A : (const char*)g.A + (size_t)cur.pm * tstep; const char* cB = (const char*)g.Bt + (size_t)cur.pb * tstep;
    if constexpr (SP2) {
        PG8_STAGE(PG8_SB(0, 0), cB, voffB); PG8_STAGE(PG8_SB(0, 1), cB + hstep, voffB); PG8_STAGE_A(PG8_SA(0, 0), cA, 0, false); PG8_STAGE_A(PG8_SA(0, 1), cA, 1, false);
        if (wr == 1) PG8_BAR;
        PG8_WAIT_V(2); PG8_BAR;
        PG8_STAGE(PG8_SB(1, 0), cB + kstep, voffB); PG8_STAGE_A(PG8_SA(1, 0), cA + kstep, 0, false); PG8_STAGE(PG8_SB(1, 1), cB + hstep + kstep, voffB);
        PG8_WAIT_V(6); PG8_BAR;
    } else {
        PG8_STAGE(PG8_SB(0, 0), cB, voffB); PG8_STAGE_A(PG8_SA(0, 0), cA, 0, false); PG8_STAGE(PG8_SB(0, 1), cB + hstep, voffB); PG8_STAGE_A(PG8_SA(0, 1), cA, 1, false);
        if (wr == 1) PG8_BAR;
        PG8_WAIT_V(4); PG8_BAR;
        PG8_STAGE(PG8_SB(1, 0), cB + kstep, voffB); PG8_STAGE_A(PG8_SA(1, 0), cA + kstep, 0, false); PG8_STAGE(PG8_SB(1, 1), cB + hstep + kstep, voffB);
        PG8_WAIT_V(6); PG8_BAR;
    }
    for (;;) {
        const bool has_next = S.next(ui + 1, nxt);
        if (g.ssq) {
            LAS float* RS = (LAS float*)(lds + 131072 + 2048);
            if (tid < BM) { const float* sp = g.ssq + (size_t)(cur.pm * BM + tid) * 8; const f32x4 s0 = *(const f32x4*)sp, s1 = *(const f32x4*)(sp + 4);
                RS[tid] = 1.f / sqrtf(((s0[0] + s0[1]) + (s0[2] + s0[3]) + (s1[0] + s1[1])) * (1.f / 384.f) + 1e-6f); } }
        const char* nA = has_next ? (GATHER ? (const char*)g.A : (const char*)g.A + (size_t)nxt.pm * tstep) : cA; const char* nB = has_next ? (const char*)g.Bt + (size_t)nxt.pb * tstep : cB;
#pragma nounroll
        for (int t = 0; t < nt; t += 2) {
#ifndef DBG_NOHOOK
            if (g.ssq && t == g.midk)
#else
            if (false)
#endif
            {
#pragma unroll
                for (int ai = 0; ai < 2; ++ai)
#pragma unroll
                    for (int m = 0; m < 4; ++m) { const float rs = ((const LAS float*)(lds + 131072 + 2048))[ai * HALF + wr * 64 + m * 16 + fr];
#pragma unroll
                        for (int bj = 0; bj < 2; ++bj)
#pragma unroll
                            for (int n = 0; n < 2; ++n) acc[ai][bj][m][n] = acc[ai][bj][m][n] * rs; } }
            const bool last = (t == nt - 2);
            const char* a1 = cA + (size_t)(t + 1) * kstep;
            const char* a2 = last ? nA : cA + (size_t)(t + 2) * kstep; const char* b2 = last ? nB : cB + (size_t)(t + 2) * kstep;
            const char* a3 = a2 + kstep; const char* b3 = b2 + kstep;
            if constexpr (SP2) {
            PG8_LDB(B0, 0, 0); PG8_LDB(B1, 0, 1); PG8_SCHED; PG8_LDA(At, 0, 0); PG8_STAGE_A(PG8_SA(1, 1), a1, 1, false);
            PG8_WAIT_V(8); PG8_WAIT_L(0); PG8_BAR; PG8_MMA(0, 0, At, B0); PG8_MMA(0, 1, At, B1); PG8_BAR; PG8_SCHED;
            PG8_LDA(At, 0, 1); PG8_STAGE(PG8_SB(0, 0), b2, voffB); PG8_STAGE(PG8_SB(0, 1), b2 + hstep, voffB); PG8_STAGE_A(PG8_SA(0, 0), a2, 0, last);
            PG8_WAIT_V(8); PG8_WAIT_L(0); PG8_BAR; PG8_MMA(1, 0, At, B0); PG8_MMA(1, 1, At, B1); PG8_BAR; PG8_SCHED;
            PG8_LDB(B0, 1, 0); PG8_LDB(B1, 1, 1); PG8_SCHED; PG8_LDA(At, 1, 0); PG8_STAGE_A(PG8_SA(0, 1), a2, 1, last);
            PG8_WAIT_V(8); PG8_WAIT_L(0); PG8_BAR; PG8_MMA(0, 0, At, B0); PG8_MMA(0, 1, At, B1); PG8_BAR; PG8_SCHED;
            PG8_LDA(At, 1, 1); PG8_STAGE(PG8_SB(1, 0), b3, voffB); PG8_STAGE(PG8_SB(1, 1), b3 + hstep, voffB); PG8_STAGE_A(PG8_SA(1, 0), a3, 0, last);
            PG8_WAIT_V(8); PG8_WAIT_L(0); PG8_BAR; PG8_MMA(1, 0, At, B0); PG8_MMA(1, 1, At, B1); PG8_BAR; PG8_SCHED;
            } else {
            PG8_LDB(B0, 0, 0); PG8_SCHED; PG8_LDA(At, 0, 0); PG8_STAGE_A(PG8_SA(1, 1), a1, 1, false);
            PG8_WAIT_L(8); PG8_BAR; PG8_WAIT_L(0); PG8_MMA(0, 0, At, B0); PG8_BAR; PG8_SCHED;
            PG8_LDB(B1, 0, 1); PG8_STAGE(PG8_SB(0, 0), b2, voffB);
            PG8_BAR; PG8_WAIT_L(0); PG8_MMA(0, 1, At, B1); PG8_BAR;
            PG8_LDA(At, 0, 1); PG8_STAGE_A(PG8_SA(0, 0), a2, 0, last);
            PG8_BAR; PG8_WAIT_L(0); PG8_MMA(1, 0, At, B0); PG8_BAR; PG8_SCHED;
            PG8_STAGE(PG8_SB(0, 1), b2 + hstep, voffB);
            PG8_WAIT_V(6); PG8_BAR; PG8_MMA(1, 1, At, B1); PG8_BAR;
            PG8_LDB(B0, 1, 0); PG8_SCHED; PG8_LDA(At, 1, 0); PG8_STAGE_A(PG8_SA(0, 1), a2, 1, last);
            PG8_WAIT_L(8); PG8_BAR; PG8_WAIT_L(0); PG8_MMA(0, 0, At, B0); PG8_BAR; PG8_SCHED;
            PG8_LDB(B1, 1, 1); PG8_STAGE(PG8_SB(1, 0), b3, voffB);
            PG8_BAR; PG8_WAIT_L(0); PG8_MMA(0, 1, At, B1); PG8_BAR;
            PG8_LDA(At, 1, 1); PG8_STAGE_A(PG8_SA(1, 0), a3, 0, last);
            PG8_BAR; PG8_WAIT_L(0); PG8_MMA(1, 0, At, B0); PG8_BAR; PG8_SCHED;
            PG8_STAGE(PG8_SB(1, 1), b3 + hstep, voffB);
            PG8_WAIT_V(6); PG8_BAR; PG8_MMA(1, 1, At, B1); PG8_BAR;
            }
        }
        if constexpr (ALIGN_EPI) { if (wr == 0) PG8_BAR; }
        if constexpr (FP8) asm volatile("s_nop 15\n\ts_nop 15" ::: "memory");
        E(acc, cur, wr, wc, fr, fq);
        if (!has_next) break;
#pragma unroll
        for (int a = 0; a < 2; ++a)
#pragma unroll
            for (int b = 0; b < 2; ++b)
#pragma unroll
                for (int m = 0; m < 4; ++m)
#pragma unroll
                    for (int n = 0; n < 2; ++n) acc[a][b][m][n] = (f32x4){0.f, 0.f, 0.f, 0.f};
        cur = nxt; cA = nA; cB = nB; ++ui;
#pragma unroll
        for (int _h = 0; _h < 2; ++_h)
#pragma unroll
            for (int _i = 0; _i < 2; ++_i) offC[_h][_i] = offN[_h][_i];
        if constexpr (ALIGN_EPI) { if (wr == 1) PG8_BAR; }
    }
    PG8_WAIT_V(0);
    if constexpr (!ALIGN_EPI) { if (wr == 0) PG8_BAR; }
    PG8_BAR;
#undef PG8_SA
#undef PG8_SB
#undef PG8_GLDS
#undef PG8_STAGE
#undef PG8_STAGE_A
#undef PG8_LDA
#undef PG8_LDB
#undef PG8_MMA
#undef PG8_LD32
#undef PG8_WAIT_V
#undef PG8_WAIT_L
#undef PG8_BAR
#undef PG8_SCHED
#undef PG8_GOFF
}
}

namespace attn_body {
constexpr int D_ = 64;
constexpr int PQ = NPROJ;
constexpr int PO = D;
constexpr int NW = 8, QBLK = 32, QB = QBLK * NW, KVBLK = 64;
__device__ __forceinline__ int crow(int r, int hi) { return (r & 3) + 8 * (r >> 2) + 4 * hi; }
__device__ __forceinline__ constexpr int crow0(int r) { return (r & 3) + 8 * (r >> 2); }
#define SBAR() __builtin_amdgcn_sched_barrier(0)
__device__ __forceinline__ void cmask(f32x16& p0, f32x16& p1, int jb, int qrel, int hi) {
    const float NEG = -INFINITY; int kb = 64 * jb + 4 * hi;
    const int lim = qrel - kb;
#pragma unroll
    for (int r = 0; r < 16; ++r) { if (crow0(r) > lim) p0[r] = NEG; if (crow0(r) + 32 > lim) p1[r] = NEG; }
}
__device__ __forceinline__ void killmask(f32x16& p0, f32x16& p1, bool dead) {
    const float NEG = -INFINITY;
#pragma unroll
    for (int r = 0; r < 16; ++r) { p0[r] = dead ? NEG : p0[r]; p1[r] = dead ? NEG : p1[r]; }
}
constexpr int NSLOT = 3, SLOTB = 8192;
constexpr int LDS_K = 0, LDS_V = NSLOT * SLOTB, LDS_WS = 2 * NSLOT * SLOTB, LDS_OST = LDS_WS + NW * 64 * 4, LDS_BYTES = LDS_OST + NW * 4096;
__device__ __forceinline__ void glds16(const void* gsrc, unsigned lds_dst) { unsigned keep;
    asm volatile("s_mov_b32 %0, m0\n\ts_mov_b32 m0, %2\n\ts_nop 0\n\tglobal_load_lds_dwordx4 %1, off\n\ts_mov_b32 m0, %0" : "=&s"(keep) : "v"(gsrc), "s"(lds_dst) : "memory"); }
__device__ __forceinline__ float max3f(float a, float b, float c) { float r; asm("v_max3_f32 %0, %1, %2, %3" : "=v"(r) : "v"(a), "v"(b), "v"(c)); return r; }
__device__ __forceinline__ float max2f(float a, float b) { float r; asm("v_max_f32_e32 %0, %1, %2" : "=v"(r) : "v"(a), "v"(b)); return r; }
__device__ __forceinline__ float fadd_s(float a, float b) { float r; asm("v_add_f32_e32 %0, %1, %2" : "=v"(r) : "v"(a), "v"(b)); return r; }
__device__ __forceinline__ float fsub_s(float a, float b) { float r; asm("v_sub_f32_e32 %0, %1, %2" : "=v"(r) : "v"(a), "v"(b)); return r; }
__device__ __forceinline__ unsigned cvtpk_s(float lo, float hi) { return pkh(lo, hi); }
#define WAIT_BAR(N) asm volatile("s_waitcnt vmcnt(" #N ") lgkmcnt(0)\n\ts_barrier" ::: "memory")
#define MFMA32(a, b, c) __builtin_amdgcn_mfma_f32_32x32x16_f16(__builtin_bit_cast(h8, a), __builtin_bit_cast(h8, b), c, 0, 0, 0)

__device__ __forceinline__ void qkt(f32x16& p0, f32x16& p1, const LAS char* Kslot, const s16x8* qr, const f32x16& negm, int r32, int hi) {
    const LAS char* kb = Kslot + hi * 1024 + r32 * 16;
#pragma unroll
    for (int d0 = 0; d0 < 4; ++d0) {
        const s16x8 b0 = *(const LAS s16x8*)(kb + d0 * 2048);
        const s16x8 b1 = *(const LAS s16x8*)(kb + d0 * 2048 + 512);
        if (d0 == 0) { p0 = MFMA32(b0, qr[0], negm); p1 = MFMA32(b1, qr[0], negm); }
        else { p0 = MFMA32(b0, qr[d0], p0); p1 = MFMA32(b1, qr[d0], p1); } }
}
typedef __attribute__((address_space(3))) const char* lds_cptr;
typedef short v4i16_t __attribute__((ext_vector_type(4)));
__device__ __forceinline__ void kload8(s16x8* kf, lds_cptr kp) {
    kf[0] = *(const LAS s16x8*)(kp);        kf[1] = *(const LAS s16x8*)(kp + 512);
    kf[2] = *(const LAS s16x8*)(kp + 2048); kf[3] = *(const LAS s16x8*)(kp + 2560);
    kf[4] = *(const LAS s16x8*)(kp + 4096); kf[5] = *(const LAS s16x8*)(kp + 4608);
    kf[6] = *(const LAS s16x8*)(kp + 6144); kf[7] = *(const LAS s16x8*)(kp + 6656);
}
__device__ __forceinline__ void kload2(s16x8* kf, lds_cptr kp, int j) { kf[2 * j] = *(const LAS s16x8*)(kp + j * 2048); kf[2 * j + 1] = *(const LAS s16x8*)(kp + j * 2048 + 512); }
__device__ __forceinline__ s16x4 vtr(lds_cptr p) { return __builtin_bit_cast(s16x4, __builtin_amdgcn_ds_read_tr16_b64_v4i16((LAS v4i16_t*)p)); }
__device__ __forceinline__ float rowmax(const f32x16& p0, const f32x16& p1) {
    float a = max3f(p0[0], p0[1], p1[0]), b = max3f(p0[2], p0[3], p1[1]); a = max3f(a, p1[2], p1[3]);
#pragma unroll
    for (int r = 4; r < 16; r += 4) { a = max3f(a, p0[r], p0[r + 1]); b = max3f(b, p0[r + 2], p0[r + 3]); a = max3f(a, p1[r], p1[r + 1]); b = max3f(b, p1[r + 2], p1[r + 3]); }
    const float m = max2f(a, b);
    auto rr = __builtin_amdgcn_permlane32_swap(__float_as_uint(m), __float_as_uint(m), false, false);
    return max2f(__uint_as_float(rr[0]), __uint_as_float(rr[1]));
}
__device__ __forceinline__ void pv(f32x16* o, int vb, s16x8 pa0, s16x8 pa1, s16x8 pa2, s16x8 pa3) {
#pragma unroll
    for (int d0 = 0; d0 < 2; ++d0) { s16x4 lo[4], hi[4];
#pragma unroll
        for (int ks = 0; ks < 4; ++ks) {
            asm volatile("ds_read_b64_tr_b16 %0,%1 offset:%c2" : "=&v"(lo[ks]) : "v"(vb), "i"(d0 * 4096 + ks * 1024) : "memory");
            asm volatile("ds_read_b64_tr_b16 %0,%1 offset:%c2" : "=&v"(hi[ks]) : "v"(vb), "i"(d0 * 4096 + ks * 1024 + 512) : "memory"); }
        asm volatile("s_waitcnt lgkmcnt(0)" ::: "memory"); SBAR();
#define PK(k) (s16x8){lo[k][0], lo[k][1], lo[k][2], lo[k][3], hi[k][0], hi[k][1], hi[k][2], hi[k][3]}
        o[d0] = MFMA32(pa0, PK(0), o[d0]);
        o[d0] = MFMA32(pa1, PK(1), o[d0]);
        o[d0] = MFMA32(pa2, PK(2), o[d0]);
        o[d0] = MFMA32(pa3, PK(3), o[d0]);
#undef PK
    }
}

template <int THRL> __device__ __forceinline__ void attn_unit(int b, int h, int qb, const half_t* Q, const half_t* __restrict__ K, const half_t* __restrict__ V, half_t* O, const float* __restrict__ kmean, float* __restrict__ ssq, LAS char* shm, int wave_) {
    unsigned z_ = 0u; asm volatile("" : "+v"(z_)); int tid_ = wave_ * 64 + (int)__builtin_amdgcn_mbcnt_hi(~0u, __builtin_amdgcn_mbcnt_lo(~0u, z_));
    const int tid = tid_, lane = tid & 63, r32 = lane & 31, hi = lane >> 5; const int wid = wave_;
    const long rowbase = (long)b * SEQ; const int q0 = qb * QB;
    const half_t* Qw = Q + (rowbase + q0 + wid * QBLK) * PQ + h * D_;
    const half_t* Kh = K + rowbase * PQ + h * D_, *Vh = V + rowbase * PQ + h * D_;
    const unsigned lds0 = (unsigned)(uintptr_t)shm;
    LAS float* wsf = (LAS float*)(shm + LDS_WS) + wid * 64; LAS float* wsfh = wsf + 4 * hi;
    const half_t* ksrc = Kh + (long)lane * PQ + wid * 8;
    const half_t* vsrc = Vh + (long)(16 * (wid & 3) + (lane >> 2)) * PQ + (wid >> 2) * 32 + (lane & 3) * 8;
    const unsigned kdst = lds0 + LDS_K + wid * 1024, vdst = lds0 + LDS_V + wid * 1024;
    const int NT = (q0 + QB) / KVBLK;
#define PHYS(t) (((t) < 4) ? (NT - 4 + (t)) : ((t) - 4))
#define DMA_K(t, slot) glds16(ksrc + (long)PHYS(t) * KVBLK * PQ, (unsigned)__builtin_amdgcn_readfirstlane(kdst + (slot)))
#define DMA_V(t, slot) glds16(vsrc + (long)PHYS(t) * KVBLK * PQ, (unsigned)__builtin_amdgcn_readfirstlane(vdst + (slot)))
    const int vb0 = (int)(lds0 + LDS_V) + ((lane >> 4) & 1) * 32 + (lane & 3) * 8 + (4 * hi + ((lane & 15) >> 2)) * 64;
    const LAS char* Kbase = shm + LDS_K; s16x8 kf[8];
    const lds_cptr shm3 = (lds_cptr)shm; const lds_cptr kp0 = shm3 + LDS_K + hi * 1024 + r32 * 16; const lds_cptr vp0 = shm3 + LDS_V + ((lane >> 4) & 1) * 32 + (lane & 3) * 8 + (4 * hi + ((lane & 15) >> 2)) * 64;
    DMA_K(0, 0); DMA_V(0, 0); DMA_K(1, SLOTB);
    s16x8 qr[4];
#pragma unroll
    for (int d0 = 0; d0 < 4; ++d0) qr[d0] = *reinterpret_cast<const s16x8*>(&Qw[(long)r32 * PQ + d0 * 16 + hi * 8]);
    unsigned pmask = 0u;
    if (qb > 0) {
        float v1 = -INFINITY, v2 = -INFINITY, v3 = -INFINITY; int i1 = 0, i2 = 0, i3 = 0;
        for (int n0 = 0; n0 < qb; n0 += 4) {
            f32x4 ka[4][4], kb2[4][4];
#pragma unroll
            for (int u = 0; u < 4; ++u) { const int n = n0 + u < qb ? n0 + u : qb - 1; const float* km = kmean + n * 64 + hi * 8;
#pragma unroll
                for (int d0 = 0; d0 < 4; ++d0) { ka[u][d0] = *(const f32x4*)(km + d0 * 16); kb2[u][d0] = *(const f32x4*)(km + d0 * 16 + 4); } }
#pragma unroll
            for (int u = 0; u < 4; ++u) { const int n = n0 + u; float gsum = 0.f;
#pragma unroll
                for (int d0 = 0; d0 < 4; ++d0) { const h8 qh = __builtin_bit_cast(h8, qr[d0]);
                    gsum += (float)qh[0] * ka[u][d0][0] + (float)qh[1] * ka[u][d0][1] + (float)qh[2] * ka[u][d0][2] + (float)qh[3] * ka[u][d0][3] + (float)qh[4] * kb2[u][d0][0] + (float)qh[5] * kb2[u][d0][1] + (float)qh[6] * kb2[u][d0][2] + (float)qh[7] * kb2[u][d0][3]; }
                { auto rr = __builtin_amdgcn_permlane32_swap(__float_as_uint(gsum), __float_as_uint(gsum), false, false); gsum = __uint_as_float(rr[0]) + __uint_as_float(rr[1]); }
                if (n < qb) {
                    if (gsum > v1) { v3 = v2; i3 = i2; v2 = v1; i2 = i1; v1 = gsum; i1 = n; }
                    else if (gsum > v2) { v3 = v2; i3 = i2; v2 = gsum; i2 = n; }
                    else if (gsum > v3) { v3 = gsum; i3 = n; } } } }
        pmask = 1u << i1; if (qb >= 2) pmask |= 1u << i2; if (qb >= 3) pmask |= 1u << i3;
    }
    float mhat = 0.f, l_reg = 0.f; f32x16 o[2]; o[0] = f32x16{}; o[1] = f32x16{}; f32x16 negm = f32x16{}; asm volatile("" : "+v"(negm));
    const int qrel = wid * QBLK + r32;
#define CMASK(P0, P1, t) do { if ((t) < 4) cmask(P0, P1, (t), qrel, hi); } while (0)
#define SETNEGM(tn) do { const bool dd_ = ((tn) >= 4) && (((pmask >> (((tn) - 4) >> 2)) & 1u) == 0u); const float nv_ = dd_ ? -INFINITY : -mhat; \
      _Pragma("unroll") for (int r = 0; r < 16; ++r) negm[r] = nv_; asm volatile("" : "+v"(negm)); } while (0)
    bool resc = false;
#define START(P0, P1) do { const float rm = rowmax(P0, P1); resc = false; \
    { const float dl = rm; mhat = fadd_s(mhat, dl); \
      _Pragma("unroll") for (int r = 0; r < 16; ++r) { P0[r] = fsub_s(P0[r], dl); P1[r] = fsub_s(P1[r], dl); } \
      _Pragma("unroll") for (int r = 0; r < 16; ++r) negm[r] = -mhat; asm volatile("" : "+v"(negm)); } \
    _Pragma("unroll") for (int r = 0; r < 16; ++r) P0[r] = __builtin_amdgcn_exp2f(P0[r]); } while (0)
#define RESC() do { if (resc) { asm volatile("s_waitcnt lgkmcnt(0)" ::: "memory"); \
      _Pragma("unroll") for (int d_ = 0; d_ < 2; ++d_) _Pragma("unroll") for (int r = 0; r < 16; ++r) o[d_][r] *= wsfh[crow0(r)]; } } while (0)
    f32x16 pA0, pA1, pB0, pB1;
    int sl_prev = 0, sl_cur = 0, sl_next = SLOTB;
#define ROT() do { sl_prev = sl_cur; sl_cur = sl_next; sl_next = (sl_next == (NSLOT - 1) * SLOTB) ? 0 : sl_next + SLOTB; } while (0)
    DMA_K(2, 2 * SLOTB);
    WAIT_BAR(3);
    qkt(pA0, pA1, Kbase, qr, negm, r32, hi); asm volatile("s_nop 15\n\ts_nop 7" : "+v"(pA0), "+v"(pA1)); CMASK(pA0, pA1, 0);
    START(pA0, pA1);
    _Pragma("unroll") for (int r = 0; r < 16; ++r) pA1[r] = __builtin_amdgcn_exp2f(pA1[r]);
    WAIT_BAR(0);
    DMA_K(3, 0); DMA_V(1, SLOTB);
    ROT();
    kload8(kf, kp0 + sl_cur);
    WAIT_BAR(2);
    s16x4 vlo[8], vhi[8]; u32x4 pw0, pw1, pw2, pw3;
#define PKW(P, B) cvtpk_s(P[B], P[B + 1])
#define PAF(k) __builtin_bit_cast(s16x8, pw##k)
#define VFR(i) (s16x8){vlo[i][0], vlo[i][1], vlo[i][2], vlo[i][3], vhi[i][0], vhi[i][1], vhi[i][2], vhi[i][3]}
#define PIN(x) asm volatile("" : "+v"(x))
#define MX3(a, b, c) __builtin_fmaxf(__builtin_fmaxf((a), (b)), (c))
#define GAPA(MF, A0, A1, A2, A3, W0, W1, PW) do { MF; sacc += A0; sacc += A1; sacc += A2; sacc += A3; PIN(sacc); W0; W1; PIN(PW); SBAR(); } while (0)
#define EX(v) __builtin_amdgcn_exp2f(v)
#define GAPB(MF, X, B) do { MF; X[B] = EX(X[B]); X[B + 1] = EX(X[B + 1]); X[B + 2] = EX(X[B + 2]); X[B + 3] = EX(X[B + 3]); PIN(X); SBAR(); } while (0)
#define VRD(i) do { vlo[i] = vtr(vp_ + (((i) >> 2) * 4096 + ((i) & 3) * 1024)); vhi[i] = vtr(vp_ + (((i) >> 2) * 4096 + ((i) & 3) * 1024 + 512)); } while (0)
#define KRD(G, j) do { if (G) { kload2(kf, kp0 + sl_next, j); SBAR(); } } while (0)
#define STEP(C0, C1, P0, P1, t, GK, GV, GL) do { SBAR(); \
    const lds_cptr vp_ = vp0 + sl_prev; \
    VRD(0); SBAR(); float sacc = (P0[0] + P0[1]); \
    GAPA(C0 = MFMA32(kf[0], qr[0], negm), P0[2], P0[3], P0[4], P0[5],     pw0[0] = PKW(P0, 0), pw0[1] = PKW(P0, 2), pw0); \
    VRD(4); SBAR(); GAPA(C1 = MFMA32(kf[1], qr[0], negm), P0[6], P0[7], P0[8], P0[9],     pw0[2] = PKW(P0, 4), pw0[3] = PKW(P0, 6), pw0); \
    VRD(1); SBAR(); GAPA(C0 = MFMA32(kf[2], qr[1], C0),   P0[10], P0[11], P0[12], P0[13], pw1[0] = PKW(P0, 8), pw1[1] = PKW(P0, 10), pw1); \
    VRD(5); SBAR(); GAPA(C1 = MFMA32(kf[3], qr[1], C1),   P0[14], P0[15], P1[0], P1[1],   pw1[2] = PKW(P0, 12), pw1[3] = PKW(P0, 14), pw1); \
    VRD(2); SBAR(); GAPA(C0 = MFMA32(kf[4], qr[2], C0),   P1[2], P1[3], P1[4], P1[5],     pw2[0] = PKW(P1, 0), pw2[1] = PKW(P1, 2), pw2); \
    VRD(6); SBAR(); GAPA(C1 = MFMA32(kf[5], qr[2], C1),   P1[6], P1[7], P1[8], P1[9],     pw2[2] = PKW(P1, 4), pw2[3] = PKW(P1, 6), pw2); \
    VRD(3); SBAR(); GAPA(C0 = MFMA32(kf[6], qr[3], C0),   P1[10], P1[11], P1[12], P1[13], pw3[0] = PKW(P1, 8), pw3[1] = PKW(P1, 10), pw3); \
    VRD(7); SBAR(); GAPA(C1 = MFMA32(kf[7], qr[3], C1),   P1[14], P1[15], 0.f, 0.f,       pw3[2] = PKW(P1, 12), pw3[3] = PKW(P1, 14), pw3); \
    l_reg += sacc; \
    if (GK) { DMA_K((t) + 3, sl_cur); } if (GV) { DMA_V((t) + 1, sl_next); } \
    CMASK(C0, C1, t); \
    { float a = MX3(C0[0], C0[1], C1[0]), b = MX3(C0[2], C0[3], C1[1]); a = MX3(a, C1[2], C1[3]); \
      _Pragma("unroll") for (int r = 4; r < 16; r += 4) { a = MX3(a, C0[r], C0[r + 1]); b = MX3(b, C0[r + 2], C0[r + 3]); a = MX3(a, C1[r], C1[r + 1]); b = MX3(b, C1[r + 2], C1[r + 3]); } \
      float rm = __builtin_fmaxf(a, b); { auto rr = __builtin_amdgcn_permlane32_swap(__float_as_uint(rm), __float_as_uint(rm), false, false); rm = __builtin_fmaxf(__uint_as_float(rr[0]), __uint_as_float(rr[1])); } \
      resc = false; \
      if (__builtin_expect(__any(rm > (float)THRL), 0)) { const float dl = __builtin_fmaxf(rm, 0.f); mhat += dl; \
        _Pragma("unroll") for (int r = 0; r < 16; ++r) { C0[r] -= dl; C1[r] -= dl; } \
        SETNEGM((t) + 1); \
        const float f = __builtin_amdgcn_exp2f(-dl); l_reg *= f; if (hi == 0) wsf[r32] = f; resc = true; } } \
    if (((((t) + 1) & 3) == 0) && (t) + 1 >= 4) SETNEGM((t) + 1); \
    SBAR(); \
    GAPB(o[0] = MFMA32(PAF(0), VFR(0), o[0]), C0, 0); \
    GAPB(o[1] = MFMA32(PAF(0), VFR(4), o[1]), C0, 4); \
    KRD(GL, 0); GAPB(o[0] = MFMA32(PAF(1), VFR(1), o[0]), C0, 8); \
    KRD(GL, 1); GAPB(o[1] = MFMA32(PAF(1), VFR(5), o[1]), C0, 12); \
    KRD(GL, 2); GAPB(o[0] = MFMA32(PAF(2), VFR(2), o[0]), C1, 0); \
    KRD(GL, 3); GAPB(o[1] = MFMA32(PAF(2), VFR(6), o[1]), C1, 4); \
    GAPB(o[0] = MFMA32(PAF(3), VFR(3), o[0]), C1, 8); \
    GAPB(o[1] = MFMA32(PAF(3), VFR(7), o[1]), C1, 12); \
    } while (0)
    int t = 1;
    for (; t + 5 < NT; t += 2) {
        STEP(pB0, pB1, pA0, pA1, t, true, true, true);     WAIT_BAR(2); RESC(); ROT();
        STEP(pA0, pA1, pB0, pB1, t + 1, true, true, true); WAIT_BAR(2); RESC(); ROT();
    }
#define ENDW(tt) do { if ((tt) + 3 < NT) { WAIT_BAR(2); } else if ((tt) + 2 < NT) { WAIT_BAR(1); } else { WAIT_BAR(0); } } while (0)
    for (; t + 1 < NT; t += 2) {
        STEP(pB0, pB1, pA0, pA1, t, (t + 3 < NT), (t + 1 < NT), (t + 1 < NT));           ENDW(t);     RESC(); ROT();
        STEP(pA0, pA1, pB0, pB1, t + 1, (t + 4 < NT), (t + 2 < NT), (t + 2 < NT));       ENDW(t + 1); RESC(); ROT();
    }
    STEP(pB0, pB1, pA0, pA1, NT - 1, false, false, false); RESC();
    { float sacc = pB0[0] + pB0[1]; _Pragma("unroll") for (int r = 2; r < 16; ++r) sacc += pB0[r]; _Pragma("unroll") for (int r = 0; r < 16; ++r) sacc += pB1[r]; l_reg += sacc;
      pw0 = (u32x4){PKW(pB0, 0), PKW(pB0, 2), PKW(pB0, 4), PKW(pB0, 6)}; pw1 = (u32x4){PKW(pB0, 8), PKW(pB0, 10), PKW(pB0, 12), PKW(pB0, 14)}; pw2 = (u32x4){PKW(pB1, 0), PKW(pB1, 2), PKW(pB1, 4), PKW(pB1, 6)}; pw3 = (u32x4){PKW(pB1, 8), PKW(pB1, 10), PKW(pB1, 12), PKW(pB1, 14)};
      SBAR(); pv(o, vb0 + sl_cur, PAF(0), PAF(1), PAF(2), PAF(3)); }
#undef PKW
#undef PAF
#undef VFR
#undef PIN
#undef MX3
#undef GAPA
#undef GAPB
#undef EX
#undef VRD
#undef KRD
#undef STEP
#undef ENDW
    { auto rr = __builtin_amdgcn_permlane32_swap(__float_as_uint(l_reg), __float_as_uint(l_reg), false, false); l_reg = __uint_as_float(rr[0]) + __uint_as_float(rr[1]); }
    if (hi == 0) wsf[32 + r32] = l_reg; asm volatile("s_waitcnt lgkmcnt(0)" ::: "memory");
    float rli[16];
#pragma unroll
    for (int r = 0; r < 16; ++r) rli[r] = __builtin_amdgcn_rcpf(wsfh[32 + crow0(r)]);
    half_t* Ow = O + (rowbase + q0 + wid * QBLK) * PO + h * D_;
    { LAS half_t* stg = (LAS half_t*)(shm + LDS_OST) + wid * 2048; LAS half_t* stgl = stg + hi * 256 + r32;
#pragma unroll
      for (int r = 0; r < 16; ++r) {
#pragma unroll
        for (int d0 = 0; d0 < 2; ++d0) stgl[crow0(r) * 64 + d0 * 32] = (half_t)(o[d0][r] * rli[r]); }
      asm volatile("s_waitcnt lgkmcnt(0)" ::: "memory");
#pragma unroll
      for (int i = 0; i < 4; ++i) { const int row = i * 8 + (lane >> 3), ch = lane & 7; const u32x4 v = *(const LAS u32x4*)(stg + row * 64 + ch * 8); *(u32x4*)(Ow + (long)row * PO + ch * 8) = v;
          const h8 hv = __builtin_bit_cast(h8, v); float s2 = 0.f;
#pragma unroll
          for (int e = 0; e < 8; ++e) s2 += (float)hv[e] * (float)hv[e];
          s2 += xor_lane<1>(s2); s2 += xor_lane<2>(s2); s2 += xor_lane<4>(s2);
#ifndef DBG_NOSSQW
          if (ch == 0) ssq[(rowbase + q0 + wid * QBLK + row) * 8 + h] = s2;
#endif
          } }
    asm volatile("s_waitcnt lgkmcnt(0)\n\ts_barrier" ::: "memory");
#undef DMA_K
#undef DMA_V
#undef PHYS
#undef CMASK
#undef SETNEGM
#undef START
#undef RESC
#undef ROT
}
#undef SBAR
#undef WAIT_BAR
#undef MFMA32
}

constexpr size_t MiB = 1u << 20;
constexpr size_t WS_CTL = 0, CTL_ZERO_BYTES = 1 * MiB;
constexpr size_t WS_MOD = 1 * MiB;
constexpr size_t WS_KMEAN = 1 * MiB + 512 * 1024;
constexpr size_t WS_S5E = 2 * MiB;
constexpr size_t WS_ROPE_C = 6 * MiB, WS_ROPE_S = 10 * MiB;
constexpr size_t WS_SMALL = 14 * MiB;
constexpr size_t SM_ABAR = WS_SMALL, SM_ABART = SM_ABAR + 16384, SM_BBT = SM_ABART + 16384, SM_CMT = SM_BBT + 262144, SM_GLUT = SM_CMT + 131072,
                 SM_WAT = SM_GLUT + 262144, SM_WXT = SM_WAT + 98304, SM_SP = SM_WXT + 98304, SM_END = SM_SP + 4096;
constexpr size_t PAR_CONVW = SM_END, PAR_CONVB = PAR_CONVW + 2 * 4 * 384 * 4, PAR_BA = PAR_CONVB + 2 * 384 * 4, PAR_BX = PAR_BA + 2 * 384 * 4, PAR_S5D = PAR_BX + 2 * 384 * 4, PAR_GLUB = PAR_S5D + 2 * 256 * 4,
                 PAR_GAIN = PAR_GLUB + 2 * 256 * 4, PAR_N1G = PAR_GAIN + 2 * 1024 * 4, PAR_N2G = PAR_N1G + 2 * 1024 * 4, PAR_ROUTER = PAR_N2G + 2 * 1024 * 4, PAR_FG = PAR_ROUTER + 1024 * 8 * 4, PAR_END = PAR_FG + 1024 * 4;
static_assert(PAR_END <= 16 * MiB, "small params");
constexpr size_t WS_MOE = 16 * MiB;
constexpr size_t MO_SEL = WS_MOE, MO_WSEL = MO_SEL + 131072, MO_TOKSLOT = MO_WSEL + 262144, MO_SLOTTOK = MO_TOKSLOT + 262144, MO_TEXP = MO_SLOTTOK + 294912, MO_BLKCNT = MO_TEXP + 4096, MO_END = MO_BLKCNT + 8192;
static_assert(MO_END <= 18 * MiB && MOE_SLOTS * 4 <= 294912, "moe tables");
#ifndef DBG_NOKSCALE
#define DBG_NOKSCALE 0
#endif
constexpr size_t WS_SSQ = 20 * MiB;
constexpr size_t WS_WIN = 32 * MiB, WS_WOUT = 41 * MiB, WS_WGU = 45 * MiB, WS_WD = 56 * MiB, WS_MGU = 62 * MiB, WS_MD = 118 * MiB;
constexpr size_t WS_RES = 146 * MiB;
constexpr size_t WS_XN8 = 210 * MiB;
constexpr size_t WS_XG8 = 242 * MiB;
constexpr size_t WS_XN = 210 * MiB;
constexpr size_t WS_PROJ = 274 * MiB;
constexpr size_t WS_O = 410 * MiB;
constexpr size_t WS_PR = 474 * MiB;
constexpr size_t WS_HID = 308 * MiB;
constexpr size_t WS_Y = 427 * MiB;
constexpr size_t WS_END = 559 * MiB;
static_assert(WS_WIN + 2ull * NPROJ_PAD * D * 2 <= WS_WOUT && WS_WOUT + 2ull * D * D * 2 <= WS_WGU && WS_WGU + 2ull * FF * D * 2 <= WS_WD && WS_WD + (size_t)D * FF * 2 <= WS_MGU &&
              WS_MGU + 8ull * 2 * FFE * D <= WS_MD && WS_MD + 8ull * D * FFE <= WS_RES && WS_RES + (size_t)M * D * 2 <= WS_XN8 && WS_XN8 + (size_t)M * D <= WS_XG8 && WS_XG8 + (size_t)MOE_SLOTS * D <= WS_HID && WS_XN + (size_t)M * D * 2 <= WS_PROJ && WS_PROJ + (size_t)M * NPROJ * 2 <= WS_O &&
              WS_O + (size_t)M * D * 2 <= WS_PR && WS_PR + (size_t)M * LRU_W * 4 <= WS_END && WS_XN + (size_t)M * D * 2 <= WS_HID && WS_HID + (size_t)M * FF * 2 <= WS_END && WS_HID + (size_t)MOE_CH_TILES * 256 * FFE * 1 <= WS_Y &&
              WS_Y + (size_t)MOE_SLOTS * D * 2 <= WS_END && (size_t)M * LRU_W * 4 <= (size_t)M * D * 2, "d_ws map");
constexpr int CW_TMO = 0, CW_CODE = 1, CW_Q0 = 64, CW_Q1 = 128, CW_NT = 192, CW_BAR = 4096;

constexpr int RING_BYTES = 131072;
constexpr int LDSCTL_OFF = RING_BYTES, MISC_OFF = LDSCTL_OFF + 320;
constexpr int LDS_BYTES = 147456;
constexpr int NWAVES = 8;

typedef GAS unsigned gu32;
#define RLX_AGENT __ATOMIC_RELAXED, __HIP_MEMORY_SCOPE_AGENT

#define XB_TMO      128
#define XB_XCNT(j)  (256  + 64 * (j))
#define XB_XSUB(j)  (1280 + 64 * (j))
#define XB_XGEN(j)  (2304 + 64 * (j))
#define XB_TOP      3328
#define XB_TOPGEN   3392
#define XCD_BAR_WORDS 3456
#define XB_SPIN_CAP (1u << 18)
__device__ __forceinline__ unsigned xb_ld(unsigned* p)              { return __hip_atomic_load(p, __ATOMIC_RELAXED, __HIP_MEMORY_SCOPE_AGENT); }
__device__ __forceinline__ unsigned xb_add(unsigned* p, unsigned v) { return __hip_atomic_fetch_add(p, v, __ATOMIC_RELAXED, __HIP_MEMORY_SCOPE_AGENT); }
__device__ __forceinline__ unsigned xb_xcc_id() { return (unsigned)__builtin_amdgcn_s_getreg((3 << 11) | 20) & 0xFu; }
#define XB_SPIN(cond, bar) do { unsigned _sp = 0; while (cond) { __builtin_amdgcn_s_sleep(1); \
    if ((++_sp & 255u) == 0u) { if (xb_ld(&(bar)[XB_TMO])) break; if (_sp > XB_SPIN_CAP) { atomicAdd(&(bar)[XB_TMO], 1u); break; } } } } while (0)
struct XcdBarrier { unsigned* bar; unsigned x; volatile LAS unsigned* st; };
__device__ __forceinline__ XcdBarrier xcd_barrier_post(unsigned* bar, volatile LAS unsigned* st) {
    XcdBarrier b; b.bar = bar; b.x = xb_xcc_id(); b.st = st;
    if (threadIdx.x == 0) (void)xb_add(&bar[XB_XCNT(b.x)], 1u);
    return b;
}
__device__ __forceinline__ void xcd_barrier_complete(unsigned* bar, unsigned x, unsigned& nloc, unsigned& nx) {
    const unsigned G = gridDim.x * gridDim.y * gridDim.z;
    unsigned sum, cnt, mine, sp = 0u;
    for (;;) {
        sum = 0u; cnt = 0u; mine = 0u;
#pragma unroll
        for (unsigned j = 0; j < 16; ++j) { const unsigned c = xb_ld(&bar[XB_XCNT(j)]); sum += c; cnt += (c > 0u) ? 1u : 0u; mine = (j == x) ? c : mine; }
        if (sum == G) break;
        __builtin_amdgcn_s_sleep(1);
        if ((++sp & 255u) == 0u) { if (xb_ld(&bar[XB_TMO])) break; if (sp > XB_SPIN_CAP) { atomicAdd(&bar[XB_TMO], 1u); break; } }
    }
    nloc = mine > 0u ? mine : 1u; nx = cnt > 0u ? cnt : 1u;
}
__device__ __forceinline__ void xcd_barrier(const XcdBarrier& b) {
    asm volatile("s_waitcnt vmcnt(0)" ::: "memory");
    __syncthreads();
    if (threadIdx.x == 0) {
        unsigned* bar = b.bar;
        __builtin_amdgcn_s_waitcnt(0);
        unsigned nloc = b.st[0], nx = b.st[1];
        if (nloc == 0u) { xcd_barrier_complete(bar, b.x, nloc, nx); b.st[0] = nloc; b.st[1] = nx; }
        const unsigned old = xb_add(&bar[XB_XSUB(b.x)], 1u);
        const unsigned gen = old / nloc;
        if (old + 1u == (gen + 1u) * nloc) {
            __builtin_amdgcn_fence(__ATOMIC_RELEASE, "agent");
            asm volatile("s_waitcnt vmcnt(0)" ::: "memory");
            const unsigned og = xb_add(&bar[XB_TOP], 1u);
            const unsigned tg = og / nx;
            if (og + 1u == (tg + 1u) * nx) xb_add(&bar[XB_TOPGEN], 1u);
            else XB_SPIN(xb_ld(&bar[XB_TOPGEN]) == tg, bar);
            __builtin_amdgcn_fence(__ATOMIC_ACQUIRE, "agent");
            xb_add(&bar[XB_XGEN(b.x)], 1u);
            asm volatile("s_waitcnt vmcnt(0)" ::: "memory");
        } else {
            XB_SPIN(xb_ld(&bar[XB_XGEN(b.x)]) == gen, bar);
            __builtin_amdgcn_fence(__ATOMIC_ACQUIRE, "agent");
            asm volatile("s_waitcnt vmcnt(0)" ::: "memory");
        }
    }
    __syncthreads();
}

struct Args {
    const void* in[35]; float* out; unsigned char* ws; int ph_lo, ph_hi;
};
enum ArgIdx { I_X = 0, I_C, I_POS, I_W_IN, I_CONV_W, I_CONV_B, I_W_A, I_B_A, I_W_X, I_B_X, I_LAM, I_S5_LRE, I_S5_LIM, I_S5_LDT, I_S5_BRE, I_S5_BIM, I_S5_CRE, I_S5_CIM, I_S5_D, I_GLU_W, I_GLU_B,
              I_MIX_GAIN, I_W_OUT, I_NORM1_G, I_NORM2_G, I_ADA_W, I_ADA_B, I_FFN_WG, I_FFN_WU, I_FFN_WD, I_ROUTER_W, I_MOE_WG, I_MOE_WU, I_MOE_WD, I_FINAL_G, I_OUT, I_WS };
__device__ __forceinline__ const void* karg(int i) {
    const __attribute__((address_space(4))) char* kp = (const __attribute__((address_space(4))) char*)__builtin_amdgcn_kernarg_segment_ptr();
    int off = 8 * i; asm volatile("" : "+s"(off));
    typedef const void* cvp_t;
    return *(const __attribute__((address_space(4))) cvp_t*)(kp + off);
}
#define KARG(T, i) ((const T*)(const GAS T*)(unsigned long long)karg(i))

using pg8::Unit;
struct EpiProj {
    static constexpr bool PERM = true;
    half_t* P; const float* rc; const float* rs;
    __device__ __forceinline__ void operator()(const f32x4 (&acc)[2][2][4][2], const Unit& u, int wr, int wc, int fr, int fq) const {
        const int i0 = 16 * (wc & 1) + 4 * fq;
#pragma unroll
        for (int ai = 0; ai < 2; ++ai)
#pragma unroll
            for (int m = 0; m < 4; ++m) {
                const int row = u.pm * 256 + ai * 128 + wr * 64 + m * 16 + fr;
                const f32x4 cv = *(const f32x4*)(rc + (size_t)row * 32 + i0), sv = *(const f32x4*)(rs + (size_t)row * 32 + i0);
#pragma unroll
                for (int bj = 0; bj < 2; ++bj) {
                    const int grp = u.pn * 4 + 2 * bj + (wc >> 1);
                    if (grp < 34) {
                        const f32x4 x1 = acc[ai][bj][m][0], x2 = acc[ai][bj][m][1]; f32x4 o1, o2;
                        if (grp < 12) { o1 = x1 * cv - x2 * sv; o2 = x2 * cv + x1 * sv; if (grp < 6) { o1 = o1 * C2; o2 = o2 * C2; } }
                        else { o1 = x1; o2 = x2; }
                        half_t* dst = P + (size_t)row * NPROJ + grp * 64 + i0;
                        u32x2 w1, w2; w1.x = pkh(o1[0], o1[1]); w1.y = pkh(o1[2], o1[3]); w2.x = pkh(o2[0], o2[1]); w2.y = pkh(o2[2], o2[3]);
                        *(u32x2*)dst = w1; *(u32x2*)(dst + 32) = w2;
                    }
                }
            }
    }
};
__device__ __forceinline__ f32x4 unpk4(u32x2 a) { const h4 h = __builtin_bit_cast(h4, a); return (f32x4){(float)h[0], (float)h[1], (float)h[2], (float)h[3]}; }
template <typename XI>
struct EpiResidT {
    static constexpr bool PERM = true;
    const XI* xin; half_t* xout; const float* gate; float osc;
    __device__ __forceinline__ void operator()(const f32x4 (&acc)[2][2][4][2], const Unit& u, int wr, int wc, int fr, int fq) const {
        const int b = u.pm >> 4; const float* gb = gate + (size_t)b * 6144;
#pragma unroll
        for (int bj = 0; bj < 2; ++bj) {
            const int col = u.pn * 256 + bj * 128 + wc * 32 + 8 * fq; const f32x4 gv0 = *(const f32x4*)(gb + col) * osc, gv1 = *(const f32x4*)(gb + col + 4) * osc;
#pragma unroll
            for (int ai = 0; ai < 2; ++ai)
#pragma unroll
                for (int m = 0; m < 4; ++m) { const size_t off = (size_t)(u.pm * 256 + ai * 128 + wr * 64 + m * 16 + fr) * D + col;
                    f32x4 x0, x1;
                    if constexpr (sizeof(XI) == 4) { x0 = *(const f32x4*)(xin + off); x1 = *(const f32x4*)(xin + off + 4); }
                    else { const u32x4 xv = *(const u32x4*)(xin + off); u32x2 lo2, hi2; lo2.x = xv.x; lo2.y = xv.y; hi2.x = xv.z; hi2.y = xv.w; x0 = unpk4(lo2); x1 = unpk4(hi2); }
                    const f32x4 r0 = x0 + gv0 * acc[ai][bj][m][0], r1 = x1 + gv1 * acc[ai][bj][m][1];
                    u32x4 w; w.x = pkh(r0[0], r0[1]); w.y = pkh(r0[2], r0[3]); w.z = pkh(r1[0], r1[1]); w.w = pkh(r1[2], r1[3]);
                    *(u32x4*)(xout + off) = w; }
        }
    }
};
struct EpiSwiglu {
    static constexpr bool PERM = true;
    half_t* H; int ldh;
    __device__ __forceinline__ void operator()(const f32x4 (&acc)[2][2][4][2], const Unit& u, int wr, int wc, int fr, int fq) const {
#pragma unroll
        for (int ai = 0; ai < 2; ++ai)
#pragma unroll
            for (int m = 0; m < 4; ++m) {
                const int row = u.pm * 256 + ai * 128 + wr * 64 + m * 16 + fr;
                const f32x4 g0 = acc[ai][0][m][0], g1 = acc[ai][0][m][1], u0 = acc[ai][1][m][0], u1 = acc[ai][1][m][1];
                u32x4 w; w.x = pkh(siluf_(g0[0]) * u0[0], siluf_(g0[1]) * u0[1]); w.y = pkh(siluf_(g0[2]) * u0[2], siluf_(g0[3]) * u0[3]);
                w.z = pkh(siluf_(g1[0]) * u1[0], siluf_(g1[1]) * u1[1]); w.w = pkh(siluf_(g1[2]) * u1[2], siluf_(g1[3]) * u1[3]);
                *(u32x4*)(H + (size_t)row * ldh + u.pn * 128 + wc * 32 + 8 * fq) = w;
            }
    }
};
struct EpiSwiglu8 {
    static constexpr bool PERM = true;
    unsigned char* H; int ldh; float osc;
    __device__ __forceinline__ void operator()(const f32x4 (&acc)[2][2][4][2], const Unit& u, int wr, int wc, int fr, int fq) const {
#pragma unroll
        for (int ai = 0; ai < 2; ++ai)
#pragma unroll
            for (int m = 0; m < 4; ++m) {
                const int row = u.pm * 256 + ai * 128 + wr * 64 + m * 16 + fr;
                const f32x4 g0 = acc[ai][0][m][0] * osc, g1 = acc[ai][0][m][1] * osc, u0 = acc[ai][1][m][0] * osc, u1 = acc[ai][1][m][1] * osc;
                u32x2 w; w.x = pk_fp8x4(siluf_(g0[0]) * u0[0], siluf_(g0[1]) * u0[1], siluf_(g0[2]) * u0[2], siluf_(g0[3]) * u0[3]);
                w.y = pk_fp8x4(siluf_(g1[0]) * u1[0], siluf_(g1[1]) * u1[1], siluf_(g1[2]) * u1[2], siluf_(g1[3]) * u1[3]);
                *(u32x2*)(H + (size_t)row * ldh + u.pn * 128 + wc * 32 + 8 * fq) = w;
            }
    }
};
struct EpiY {
    static constexpr bool PERM = true;
    half_t* Y; float osc;
    __device__ __forceinline__ void operator()(const f32x4 (&acc)[2][2][4][2], const Unit& u, int wr, int wc, int fr, int fq) const {
#pragma unroll
        for (int ai = 0; ai < 2; ++ai)
#pragma unroll
            for (int m = 0; m < 4; ++m) {
                const int row = u.pm * 256 + ai * 128 + wr * 64 + m * 16 + fr;
#pragma unroll
                for (int bj = 0; bj < 2; ++bj) { const f32x4 v0 = acc[ai][bj][m][0] * osc, v1 = acc[ai][bj][m][1] * osc;
                    u32x4 w; w.x = pkh(v0[0], v0[1]); w.y = pkh(v0[2], v0[3]); w.z = pkh(v1[0], v1[1]); w.w = pkh(v1[2], v1[3]);
                    *(u32x4*)(Y + (size_t)row * D + u.pn * 256 + bj * 128 + wc * 32 + 8 * fq) = w; }
            }
    }
};

__device__ __forceinline__ int map_row(int kind, int c) {
    if (kind == 0) return c;
    if (kind == 1) { const int grp = c >> 6, d = c & 63, n = d >> 5, i = d & 31, wcl = i >> 4, fq = (i >> 2) & 3, e = i & 3, pn = grp >> 2, hl = grp & 3, bj = hl >> 1, wc = 2 * (hl & 1) + wcl;
        return pn * 256 + 128 * bj + 32 * wc + 8 * fq + 4 * n + e; }
    const int tile = c >> 7, w = c & 127; return tile * 256 + (kind == 3 ? 128 : 0) + w;
}
__device__ __forceinline__ void p0_transpose_item(const float* W, int K, int N, half_t* WT, int kind, LAS half_t* scr, int item, int lane, const float* kscale = nullptr) {
    const int nblk = N / 64, kb = item / nblk, nb = item % nblk, k0 = 64 * kb, n0 = 64 * nb;
    const int n4 = lane & 15, kr = lane >> 4;
    f32x4 v[16];
#pragma unroll
    for (int i = 0; i < 16; ++i) v[i] = *(const f32x4*)(W + (size_t)(k0 + 4 * i + kr) * N + n0 + 4 * n4);
    if (kscale && !DBG_NOKSCALE) {
#pragma unroll
        for (int i = 0; i < 16; ++i) v[i] = v[i] * kscale[k0 + 4 * i + kr]; }
#pragma unroll
    for (int i = 0; i < 16; ++i) {
#pragma unroll
        for (int j = 0; j < 4; ++j) scr[(4 * n4 + j) * 72 + 4 * i + kr] = (half_t)v[i][j]; }
    LDS_WAIT(); asm volatile("" ::: "memory");
#pragma unroll
    for (int r = 0; r < 8; ++r) { const int idx = r * 64 + lane, n = idx >> 3, c = idx & 7;
        const u32x4 o = *(const LAS u32x4*)(scr + n * 72 + 8 * c);
        *(u32x4*)(WT + (size_t)map_row(kind, n0 + n) * K + k0 + 8 * c) = o; }
    LDS_WAIT(); asm volatile("" ::: "memory");
}
__device__ __forceinline__ void p0_transpose_item_fp8(const float* W, int K, int N, unsigned char* WT, int kind, float wscale, LAS unsigned char* scr, int item, int lane) {
    const int nblk = N / 32, kb = item / nblk, nb = item % nblk, k0 = 128 * kb, n0 = 32 * nb;
    const int n4 = lane & 7, kr = lane >> 3;
    LAS unsigned* sd = (LAS unsigned*)scr;
    f32x4 v[16];
#pragma unroll
    for (int i = 0; i < 16; ++i) v[i] = *(const f32x4*)(W + (size_t)(k0 + 32 * (i >> 2) + 4 * kr + (i & 3)) * N + n0 + 4 * n4);
#pragma unroll
    for (int ii = 0; ii < 4; ++ii) {
#pragma unroll
        for (int j = 0; j < 4; ++j) sd[(4 * n4 + j) * 33 + 8 * ii + kr] = pk_fp8x4(v[4 * ii][j] * wscale, v[4 * ii + 1][j] * wscale, v[4 * ii + 2][j] * wscale, v[4 * ii + 3][j] * wscale); }
    LDS_WAIT(); asm volatile("" ::: "memory");
#pragma unroll
    for (int r = 0; r < 4; ++r) { const int idx = r * 64 + lane, n = idx >> 3, c = idx & 7;
        u32x4 o; o.x = sd[n * 33 + 4 * c]; o.y = sd[n * 33 + 4 * c + 1]; o.z = sd[n * 33 + 4 * c + 2]; o.w = sd[n * 33 + 4 * c + 3];
        *(u32x4*)(WT + (size_t)map_row(kind, n0 + n) * K + k0 + 16 * c) = o; }
    LDS_WAIT(); asm volatile("" ::: "memory");
}
__device__ __forceinline__ void sincos_d(double a, double& s, double& c) {
    const double q = rint(a * 0.63661977236758134308), y = a - q * 1.57079632679489661923, y2 = y * y;
    const double sy = y * (1.0 + y2 * (-1.0 / 6 + y2 * (1.0 / 120 + y2 * (-1.0 / 5040 + y2 * (1.0 / 362880 + y2 * (-1.0 / 39916800 + y2 * (1.0 / 6227020800.0)))))));
    const double cy = 1.0 + y2 * (-0.5 + y2 * (1.0 / 24 + y2 * (-1.0 / 720 + y2 * (1.0 / 40320 + y2 * (-1.0 / 3628800 + y2 * (1.0 / 479001600.0))))));
    const int qi = ((int)(long long)q) & 3;
    s = (qi == 0) ? sy : (qi == 1) ? cy : (qi == 2) ? -sy : -cy;
    c = (qi == 0) ? cy : (qi == 1) ? -sy : (qi == 2) ? -cy : sy;
}

struct Ctx {
    LAS unsigned char* lds; int tid, lane, wave, G, bid, gw, NGW;
    unsigned char* ws;
};
#define WSP(T, off) ((T*)(GAS T*)((unsigned long long)C.ws + (off)))

__device__ __forceinline__ void p0_prologue(const Ctx& C) {
    LAS half_t* scr = (LAS half_t*)(C.lds + C.wave * 16384);
    constexpr int I_IN = (D / 64) * (NPROJ / 64), I_OUT = (D / 64) * (D / 64), I_FG = (D / 64) * (FF / 64), I_FD = (FF / 64) * (D / 64), I_MG = (D / 64) * (FFE / 64), I_MD = (FFE / 64) * (D / 64);
    constexpr int NITEMS = 2 * I_IN + 2 * I_OUT + 2 * I_FG + I_FD + 16 * I_MG + 8 * I_MD;
#ifndef DBG_P0MASK
#define DBG_P0MASK 0x7f
#endif
#ifndef DBG_ITEM_LO
#define DBG_ITEM_LO 0
#define DBG_ITEM_HI NITEMS
#endif
    if (DBG_P0MASK & 64) for (int it = C.bid; it < 2 * 96; it += C.G) {
        __syncthreads();
        LAS float* sc = (LAS float*)C.lds; LAS float* red = (LAS float*)(C.lds + 32768);
        for (int i = C.tid; i < BATCH * D; i += 512) sc[i] = siluf_(KARG(float, I_C)[i]);
        __syncthreads();
        const int l = it / 96, n = (it % 96) * 64 + C.lane; float acc[8];
#pragma unroll
        for (int b = 0; b < 8; ++b) acc[b] = 0.f;
        const float* wp = KARG(float, I_ADA_W) + ((size_t)l * D + C.wave * 128) * 6144 + n;
#pragma unroll 8
        for (int k = 0; k < 128; ++k) { const float wv = wp[(size_t)k * 6144];
#pragma unroll
            for (int b = 0; b < 8; ++b) acc[b] += sc[b * D + C.wave * 128 + k] * wv; }
#pragma unroll
        for (int b = 0; b < 8; ++b) red[(C.wave * 8 + b) * 64 + C.lane] = acc[b];
        __syncthreads();
        { const int b = C.wave; float s = KARG(float, I_ADA_B)[(size_t)l * 6144 + n];
#pragma unroll
          for (int w = 0; w < 8; ++w) s += red[(w * 8 + b) * 64 + C.lane];
          WSP(float, WS_MOD)[((size_t)l * 8 + b) * 6144 + n] = s; }
        __syncthreads();
    }
    constexpr int NMODB = 2 * 96, LATE = 3;
    if (DBG_P0MASK & 1) for (int rnd = (C.bid < NMODB ? LATE : 0); ; ++rnd) {
        const int it = rnd < LATE ? rnd * ((C.G - NMODB) * NWAVES) + (C.gw - NMODB * NWAVES) : LATE * ((C.G - NMODB) * NWAVES) + (rnd - LATE) * C.NGW + C.gw;
        if (it >= NITEMS) break;
        int r = it; if (it < DBG_ITEM_LO || it >= DBG_ITEM_HI) continue;
        if (r < 2 * I_IN) { const int l = r / I_IN; p0_transpose_item(KARG(float, I_W_IN) + (size_t)l * D * NPROJ, D, NPROJ, WSP(half_t, WS_WIN) + (size_t)l * NPROJ_PAD * D, 1, scr, r % I_IN, C.lane); continue; } r -= 2 * I_IN;
        if (r < 2 * I_OUT) { const int l = r / I_OUT; p0_transpose_item(KARG(float, I_W_OUT) + (size_t)l * D * D, D, D, WSP(half_t, WS_WOUT) + (size_t)l * D * D, 0, scr, r % I_OUT, C.lane, KARG(float, I_MIX_GAIN) + (size_t)l * D); continue; } r -= 2 * I_OUT;
#if DENSE_FP8
        if (r < I_FG) { p0_transpose_item_fp8(KARG(float, I_FFN_WG), D, FF, WSP(unsigned char, WS_WGU), 2, 32.f, (LAS unsigned char*)scr, r, C.lane); continue; } r -= I_FG;
        if (r < I_FG) { p0_transpose_item_fp8(KARG(float, I_FFN_WU), D, FF, WSP(unsigned char, WS_WGU), 3, 32.f, (LAS unsigned char*)scr, r, C.lane); continue; } r -= I_FG;
        if (r < I_FD) { p0_transpose_item_fp8(KARG(float, I_FFN_WD), FF, D, WSP(unsigned char, WS_WD), 0, 64.f, (LAS unsigned char*)scr, r, C.lane); continue; } r -= I_FD;
#else
        if (r < I_FG) { p0_transpose_item(KARG(float, I_FFN_WG), D, FF, WSP(half_t, WS_WGU), 2, scr, r, C.lane); continue; } r -= I_FG;
        if (r < I_FG) { p0_transpose_item(KARG(float, I_FFN_WU), D, FF, WSP(half_t, WS_WGU), 3, scr, r, C.lane); continue; } r -= I_FG;
        if (r < I_FD) { p0_transpose_item(KARG(float, I_FFN_WD), FF, D, WSP(half_t, WS_WD), 0, scr, r, C.lane); continue; } r -= I_FD;
#endif
        if (r < 8 * I_MG) { const int e = r / I_MG; p0_transpose_item_fp8(KARG(float, I_MOE_WG) + (size_t)e * D * FFE, D, FFE, WSP(unsigned char, WS_MGU) + (size_t)e * 2 * FFE * D, 2, 32.f, (LAS unsigned char*)scr, r % I_MG, C.lane); continue; } r -= 8 * I_MG;
        if (r < 8 * I_MG) { const int e = r / I_MG; p0_transpose_item_fp8(KARG(float, I_MOE_WU) + (size_t)e * D * FFE, D, FFE, WSP(unsigned char, WS_MGU) + (size_t)e * 2 * FFE * D, 3, 32.f, (LAS unsigned char*)scr, r % I_MG, C.lane); continue; } r -= 8 * I_MG;
        { const int e = r / I_MD; p0_transpose_item_fp8(KARG(float, I_MOE_WD) + (size_t)e * FFE * D, FFE, D, WSP(unsigned char, WS_MD) + (size_t)e * D * FFE, 0, 64.f, (LAS unsigned char*)scr, r % I_MD, C.lane); }
    }
    const int gt = C.bid * 512 + C.tid, NTH = C.G * 512;
    if (DBG_P0MASK & 2) for (int i = gt; i < 2 * 128 * D / 8; i += NTH) { const int l = i / (128 * D / 8), r = i % (128 * D / 8);
        *(u32x4*)(WSP(half_t, WS_WIN) + (size_t)l * NPROJ_PAD * D + (size_t)NPROJ * D + (size_t)r * 8) = (u32x4){0u, 0u, 0u, 0u}; }
    if (DBG_P0MASK & 4) for (int i = gt; i < M * 32; i += NTH) { const int row = i >> 5, fi = i & 31;
        const double inv = exp2(-(double)fi * (13.287712379549449 / 32.0));
        double s, c; sincos_d((double)KARG(int, I_POS)[row] * inv, s, c);
        WSP(float, WS_ROPE_C)[i] = (float)c; WSP(float, WS_ROPE_S)[i] = (float)s; }
    if (DBG_P0MASK & 8) for (int i = gt; i < 2 * S5_G * S5_P * 16; i += NTH) { const int q = i >> 4, h = i & 15, lg = q >> 6, p = q & 63;
        const double dt = exp((double)KARG(float, I_S5_LDT)[lg]), lr = KARG(float, I_S5_LRE)[q], li = KARG(float, I_S5_LIM)[q];
        const double mag = exp(lr * dt); double s, c; sincos_d(li * dt, s, c);
        const double are = mag * c, aim = mag * s, den = lr * lr + li * li, nr = are - 1.0, ni = aim;
        const double cre = (nr * lr + ni * li) / den, cim = (ni * lr - nr * li) / den;
        if (h == 0) { WSP(float, SM_ABAR)[2 * q] = (float)are; WSP(float, SM_ABAR)[2 * q + 1] = (float)aim;
            const double magT = exp(lr * dt * CH_T); double sT, cT; sincos_d(li * dt * CH_T, sT, cT);
            WSP(float, SM_ABART)[2 * q] = (float)(magT * cT); WSP(float, SM_ABART)[2 * q + 1] = (float)(magT * sT); }
        half_t* bbt = WSP(half_t, SM_BBT) + (size_t)lg * 128 * 32;
        const double br = KARG(float, I_S5_BRE)[(size_t)q * 16 + h], bi = KARG(float, I_S5_BIM)[(size_t)q * 16 + h];
        bbt[(2 * p) * 32 + h] = (half_t)(float)(cre * br - cim * bi); bbt[(2 * p + 1) * 32 + h] = (half_t)(float)(cre * bi + cim * br);
        bbt[(2 * p) * 32 + 16 + h] = (half_t)0.f; bbt[(2 * p + 1) * 32 + 16 + h] = (half_t)0.f;
        half_t* cmt = WSP(half_t, SM_CMT) + (size_t)lg * 16 * 128;
        cmt[h * 128 + 2 * p] = (half_t)KARG(float, I_S5_CRE)[((size_t)lg * 16 + h) * 64 + p]; cmt[h * 128 + 2 * p + 1] = (half_t)(-KARG(float, I_S5_CIM)[((size_t)lg * 16 + h) * 64 + p]);
    }
    if (DBG_P0MASK & 16) for (int i = gt; i < 2 * 256 * 256; i += NTH) { const int l = i >> 16, n = (i >> 8) & 255, k = i & 255; WSP(half_t, SM_GLUT)[i] = (half_t)KARG(float, I_GLU_W)[((size_t)l * 256 + k) * 256 + n]; }
    for (int i = gt; i < 2 * 6 * 64 * 64; i += NTH) { const int lh = i >> 12, j = (i >> 6) & 63, ii = i & 63;
        WSP(half_t, SM_WAT)[i] = (half_t)KARG(float, I_W_A)[((size_t)lh * 64 + ii) * 64 + j]; WSP(half_t, SM_WXT)[i] = (half_t)KARG(float, I_W_X)[((size_t)lh * 64 + ii) * 64 + j]; }
    for (int i = gt; i < 2 * LRU_W; i += NTH) WSP(float, SM_SP)[i] = (float)log1p(exp(-(double)KARG(float, I_LAM)[i]));
#define CPY(dst_off, src, n) for (int i = gt; i < (n); i += NTH) WSP(float, dst_off)[i] = (src)[i];
    CPY(PAR_CONVW, KARG(float, I_CONV_W), 2 * 4 * 384) CPY(PAR_CONVB, KARG(float, I_CONV_B), 2 * 384) CPY(PAR_BA, KARG(float, I_B_A), 2 * 384) CPY(PAR_BX, KARG(float, I_B_X), 2 * 384) CPY(PAR_S5D, KARG(float, I_S5_D), 2 * 256) CPY(PAR_GLUB, KARG(float, I_GLU_B), 2 * 256)
    CPY(PAR_GAIN, KARG(float, I_MIX_GAIN), 2 * 1024) CPY(PAR_N1G, KARG(float, I_NORM1_G), 2 * 1024) CPY(PAR_N2G, KARG(float, I_NORM2_G), 2 * 1024) CPY(PAR_ROUTER, KARG(float, I_ROUTER_W), 1024 * 8) CPY(PAR_FG, KARG(float, I_FINAL_G), 1024)
#undef CPY
}

template <typename XI> __device__ __forceinline__ f32x4 ldrow4(const XI* xin, int m, int lane, int j) {
    if constexpr (sizeof(XI) == 4) return ((const f32x4*)(xin + (size_t)m * D) + lane)[64 * j];
    else return unpk4(((const u32x2*)(xin + (size_t)m * D) + lane)[64 * j]);
}
template <bool ROUTER, bool FP8OUT = ROUTER, typename XI = half_t>
__device__ __forceinline__ void row_pass_xn(const Ctx& C, const XI* xin, const float* g, const float* shift0, const float* scale0, half_t* XN, const float* router_w, LAS unsigned* lcnt) {
    constexpr int RPW = M / (256 * NWAVES);
    const int m0 = C.gw * RPW, b = m0 >> 12;
    const float* shb = shift0 + (size_t)b * 6144; const float* scb = scale0 + (size_t)b * 6144;
    f32x4 gs[4], sh[4];
#pragma unroll
    for (int j = 0; j < 4; ++j) { const int col = 4 * C.lane + 256 * j; gs[j] = *(const f32x4*)(g + col) * (*(const f32x4*)(scb + col) + 1.f); sh[j] = *(const f32x4*)(shb + col); }
    f32x4 rw[ROUTER ? 16 : 1][2];
    if constexpr (ROUTER) {
#pragma unroll
        for (int j = 0; j < 4; ++j)
#pragma unroll
            for (int cc = 0; cc < 4; ++cc) { const int col = 4 * C.lane + 256 * j + cc; rw[4 * j + cc][0] = *(const f32x4*)(router_w + (size_t)col * 8); rw[4 * j + cc][1] = *(const f32x4*)(router_w + (size_t)col * 8 + 4); } }
    constexpr int RG = ROUTER ? 4 : 8;
    for (int mg = m0; mg < m0 + RPW; mg += RG) {
      f32x4 vv[RG][4];
#pragma unroll
      for (int r = 0; r < RG; ++r)
#pragma unroll
        for (int j = 0; j < 4; ++j) vv[r][j] = ldrow4(xin, mg + r, C.lane, j);
#pragma unroll
      for (int r = 0; r < RG; ++r) { const int m = mg + r;
        f32x4 v[4]; float ss = 0.f;
#pragma unroll
        for (int j = 0; j < 4; ++j) { v[j] = vv[r][j]; ss += (v[j].x * v[j].x + v[j].y * v[j].y) + (v[j].z * v[j].z + v[j].w * v[j].w); }
        const float rstd = 1.f / sqrtf(wave_sum(ss) * (1.f / D) + EPS);
        u32x2* o8 = (u32x2*)(XN + (size_t)m * D) + C.lane;
#pragma unroll
        for (int j = 0; j < 4; ++j) { v[j] = v[j] * rstd * gs[j] + sh[j];
            if constexpr (FP8OUT) ((unsigned*)((unsigned char*)XN + (size_t)m * D) + C.lane)[64 * j] = pk_fp8x4(v[j].x, v[j].y, v[j].z, v[j].w);
            else { u32x2 w; w.x = pkh(v[j].x, v[j].y); w.y = pkh(v[j].z, v[j].w); o8[64 * j] = w; } }
        if constexpr (ROUTER) {
            float lg[8];
#pragma unroll
            for (int e = 0; e < 8; ++e) lg[e] = 0.f;
#pragma unroll
            for (int j = 0; j < 4; ++j)
#pragma unroll
                for (int cc = 0; cc < 4; ++cc) { const f32x4 r0 = rw[4 * j + cc][0], r1 = rw[4 * j + cc][1]; const float hv = v[j][cc];
                    lg[0] += hv * r0.x; lg[1] += hv * r0.y; lg[2] += hv * r0.z; lg[3] += hv * r0.w; lg[4] += hv * r1.x; lg[5] += hv * r1.y; lg[6] += hv * r1.z; lg[7] += hv * r1.w; }
#pragma unroll
            for (int e = 0; e < 8; ++e) lg[e] = wave_sum(lg[e]);
            int e0 = 0; float t0 = lg[0];
#pragma unroll
            for (int e = 1; e < 8; ++e) if (lg[e] > t0) { t0 = lg[e]; e0 = e; }
            int e1 = -1; float t1 = -INFINITY;
#pragma unroll
            for (int e = 0; e < 8; ++e) if (e != e0 && lg[e] > t1) { t1 = lg[e]; e1 = e; }
            const float w0 = 1.f / (1.f + expf(t1 - t0));
            if (C.lane == 0) { WSP(int, MO_SEL)[m] = e0 | (e1 << 8); WSP(float, MO_WSEL)[2 * m] = w0; WSP(float, MO_WSEL)[2 * m + 1] = 1.f - w0;
                __hip_atomic_fetch_add(&lcnt[e0], 1u, __ATOMIC_RELAXED, __HIP_MEMORY_SCOPE_WORKGROUP); __hip_atomic_fetch_add(&lcnt[e1], 1u, __ATOMIC_RELAXED, __HIP_MEMORY_SCOPE_WORKGROUP); }
        }
      }
    }
}
__device__ __forceinline__ void row_pass_final(const Ctx& C, const half_t* xin, float* xout, const float* gate2_0, const float* fg) {
    constexpr int RPW = M / (256 * NWAVES);
    const int m0 = C.gw * RPW, b = m0 >> 12;
    int ts = 0; float wsv = 0.f;
    if (C.lane < 2 * RPW) { ts = WSP(int, MO_TOKSLOT)[2 * m0 + C.lane]; wsv = WSP(float, MO_WSEL)[2 * m0 + C.lane]; }
    f32x4 gg[4], fgv[4];
#pragma unroll
    for (int j = 0; j < 4; ++j) { const int col = 4 * C.lane + 256 * j; gg[j] = *(const f32x4*)(gate2_0 + (size_t)b * 6144 + col); fgv[j] = *(const f32x4*)(fg + col); }
    const half_t* Y = WSP(half_t, WS_Y);
    constexpr int FG = 4;
    for (int mg = 0; mg < RPW; mg += FG) {
        u32x2 xr[FG][4], ya[FG][4], yc[FG][4]; float w0[FG], w1[FG];
#pragma unroll
        for (int r = 0; r < FG; ++r) { const int s0 = __builtin_amdgcn_readlane(ts, 2 * (mg + r)), s1 = __builtin_amdgcn_readlane(ts, 2 * (mg + r) + 1);
            w0[r] = __builtin_bit_cast(float, __builtin_amdgcn_readlane(__builtin_bit_cast(int, wsv), 2 * (mg + r))); w1[r] = __builtin_bit_cast(float, __builtin_amdgcn_readlane(__builtin_bit_cast(int, wsv), 2 * (mg + r) + 1));
            const u32x2* y0 = (const u32x2*)(Y + (size_t)s0 * D) + C.lane; const u32x2* y1 = (const u32x2*)(Y + (size_t)s1 * D) + C.lane; const u32x2* xp = (const u32x2*)(xin + (size_t)(m0 + mg + r) * D) + C.lane;
#pragma unroll
            for (int j = 0; j < 4; ++j) { xr[r][j] = xp[64 * j]; ya[r][j] = y0[64 * j]; yc[r][j] = y1[64 * j]; } }
#pragma unroll
        for (int r = 0; r < FG; ++r) { f32x4* xo = (f32x4*)(xout + (size_t)(m0 + mg + r) * D) + C.lane;
            f32x4 v[4]; float ss = 0.f;
#pragma unroll
            for (int j = 0; j < 4; ++j) { v[j] = unpk4(xr[r][j]) + gg[j] * (unpk4(ya[r][j]) * w0[r] + unpk4(yc[r][j]) * w1[r]); ss += (v[j].x * v[j].x + v[j].y * v[j].y) + (v[j].z * v[j].z + v[j].w * v[j].w); }
            const float rstd = 1.f / sqrtf(wave_sum(ss) * (1.f / D) + EPS);
#pragma unroll
            for (int j = 0; j < 4; ++j) xo[64 * j] = v[j] * rstd * fgv[j]; }
    }
}
__device__ __forceinline__ void row_pass_attnorm(const Ctx& C, half_t* O, const float* gain) {
    constexpr int RPW = M / (256 * NWAVES);
    for (int m = C.gw * RPW; m < C.gw * RPW + RPW && m < M; ++m) {
        u32x2* o8 = (u32x2*)(O + (size_t)m * D) + C.lane;
        f32x4 v0, v1 = {0.f, 0.f, 0.f, 0.f};
        v0 = unpk4(o8[0]);
        if (C.lane < 32) v1 = unpk4(o8[64]);
        const float ss = (v0.x * v0.x + v0.y * v0.y) + (v0.z * v0.z + v0.w * v0.w) + (v1.x * v1.x + v1.y * v1.y) + (v1.z * v1.z + v1.w * v1.w);
#ifdef DBG_ATTSCALE
        const float rstd = DBG_ATTSCALE / sqrtf(wave_sum(ss) * (1.f / 384.f) + EPS);
#else
        const float rstd = 1.f / sqrtf(wave_sum(ss) * (1.f / 384.f) + EPS);
#endif
        { const f32x4 gg = *(const f32x4*)(gain + 4 * C.lane); const f32x4 r = v0 * rstd * gg; u32x2 w; w.x = pkh(r.x, r.y); w.y = pkh(r.z, r.w); o8[0] = w; }
        if (C.lane < 32) { const f32x4 gg = *(const f32x4*)(gain + 256 + 4 * C.lane); const f32x4 r = v1 * rstd * gg; u32x2 w; w.x = pkh(r.x, r.y); w.y = pkh(r.z, r.w); o8[64] = w; }
#ifdef DBG_KEEP
        { const u32x2 z = {0u, 0u};
          if (!(DBG_KEEP & 1)) { o8[0] = z; if (C.lane < 32) o8[64] = z; }
          if (!(DBG_KEEP & 2)) { if (C.lane >= 32) o8[64] = z; o8[128] = z; }
          if (!(DBG_KEEP & 4)) { o8[192] = z; } }
#endif
    }
}

__device__ __forceinline__ f32x4 mm16(const LAS half_t* Ap, int lda, const half_t* Bt, int ldb, int ksteps, f32x4 acc, int lane) {
    const int ar = lane & 15, kq = lane >> 4;
    for (int ks = 0; ks < ksteps; ++ks) { const h8 a = *(const LAS h8*)(Ap + ar * lda + ks * 32 + kq * 8); const h8 b = *(const h8*)(Bt + (size_t)ar * ldb + ks * 32 + kq * 8);
        acc = __builtin_amdgcn_mfma_f32_16x16x32_f16(a, b, acc, 0, 0, 0); }
    return acc;
}

__device__ __forceinline__ f32x4 mm16t(const LAS half_t* Ap, int lda, const half_t* Bt, int ldb, int ksteps, f32x4 acc, int lane) {
    const int ar = lane & 15, kq = lane >> 4;
    for (int ks = 0; ks < ksteps; ++ks) { const h8 a = *(const LAS h8*)(Ap + ar * lda + ks * 32 + kq * 8); const h8 b = *(const h8*)(Bt + (size_t)ar * ldb + ks * 32 + kq * 8);
        acc = __builtin_amdgcn_mfma_f32_16x16x32_f16(b, a, acc, 0, 0, 0); }
    return acc;
}
__device__ __forceinline__ void kmean_items(const Ctx& C) {
    const half_t* P = WSP(half_t, WS_PROJ); const int dch = C.lane & 7, rg = C.lane >> 3;
    for (int it = C.bid + C.G * C.wave; it < BATCH * NH * 16; it += C.NGW) { const int n = it & 15, bh = it >> 4, h = bh % NH, b = bh / NH;
        const half_t* kp = P + ((size_t)b * SEQ + n * 256 + rg) * NPROJ + COL_K + h * 64 + dch * 8; float s[8];
#pragma unroll
        for (int k = 0; k < 8; ++k) s[k] = 0.f;
#pragma unroll
        for (int r = 0; r < 32; ++r) { const h8 v = *(const h8*)(kp + (size_t)(8 * r) * NPROJ);
#pragma unroll
            for (int k = 0; k < 8; ++k) s[k] += (float)v[k]; }
#pragma unroll
        for (int k = 0; k < 8; ++k) { s[k] += xor_lane<8>(s[k]); s[k] += xor_lane<16>(s[k]); s[k] += xor_lane<32>(s[k]); }
        if (rg == 0) { float* o = WSP(float, WS_KMEAN) + (size_t)it * 64 + dch * 8; *(f32x4*)o = (f32x4){s[0], s[1], s[2], s[3]} * (1.f / 256.f); *(f32x4*)(o + 4) = (f32x4){s[4], s[5], s[6], s[7]} * (1.f / 256.f); } }
}
__device__ __forceinline__ void lru_prep_unit(const Ctx& C, int l, int b, int c) {
    constexpr int LDX = 392;
    LAS half_t* XC = (LAS half_t*)C.lds;
    LAS float* PRE = (LAS float*)(C.lds + 65536) + C.wave * 2048;
    const half_t* P = WSP(half_t, WS_PROJ); const size_t row0 = (size_t)b * SEQ + c * CH_T;
    const int h = C.wave < 6 ? C.wave : 0, ch = h * 64 + C.lane; const int ar = C.lane & 15, kq = C.lane >> 4; const bool act = C.wave < 6;
    const half_t* wat = WSP(half_t, SM_WAT) + ((size_t)l * 6 + h) * 4096; const half_t* wxt = WSP(half_t, SM_WXT) + ((size_t)l * 6 + h) * 4096;
    h8 wa[4][2], wx[4][2];
#pragma unroll
    for (int nt = 0; nt < 4; ++nt)
#pragma unroll
        for (int ks = 0; ks < 2; ++ks) { wa[nt][ks] = *(const h8*)(wat + (size_t)(nt * 16 + ar) * 64 + ks * 32 + kq * 8); wx[nt][ks] = *(const h8*)(wxt + (size_t)(nt * 16 + ar) * 64 + ks * 32 + kq * 8); }
    const float ba = WSP(float, PAR_BA)[l * LRU_W + ch], bx = WSP(float, PAR_BX)[l * LRU_W + ch], sp = WSP(float, SM_SP)[l * LRU_W + ch];
    __syncthreads();
    for (int i = C.tid; i < 67 * 48; i += 512) { const int r = i / 48, cc = i % 48; u32x4 v = {0u, 0u, 0u, 0u};
        if (c > 0 || r >= 3) v = *(const u32x4*)(P + (row0 + r - 3) * NPROJ + COL_XR + cc * 8);
        *(LAS u32x4*)(XC + r * LDX + cc * 8) = v; }
    __syncthreads();
    if (C.tid < LRU_W) { const int cch = C.tid; const float* cw = WSP(float, PAR_CONVW) + (size_t)l * 4 * LRU_W + cch; const float w0 = cw[0], w1 = cw[LRU_W], w2 = cw[2 * LRU_W], w3 = cw[3 * LRU_W], cb = WSP(float, PAR_CONVB)[l * LRU_W + cch];
        float x3 = (float)XC[66 * LDX + cch], x2 = (float)XC[65 * LDX + cch], x1 = (float)XC[64 * LDX + cch];
#pragma unroll 8
        for (int t = CH_T - 1; t >= 0; --t) { const float x0 = (float)XC[t * LDX + cch]; XC[(t + 3) * LDX + cch] = (half_t)(w0 * x0 + w1 * x1 + w2 * x2 + w3 * x3 + cb); x3 = x2; x2 = x1; x1 = x0; } }
    __syncthreads();
    float hl = 0.f, pr = 1.f; unsigned* HP = WSP(unsigned, WS_PR);
    for (int sc = 0; sc < 4; ++sc) {
        if (act) {
            const h8 a0 = *(const LAS h8*)(XC + (sc * 16 + 3 + ar) * LDX + h * 64 + kq * 8), a1 = *(const LAS h8*)(XC + (sc * 16 + 3 + ar) * LDX + h * 64 + 32 + kq * 8);
#pragma unroll
            for (int nt = 0; nt < 4; ++nt) { const f32x4 z = {0.f, 0.f, 0.f, 0.f};
                f32x4 ra = __builtin_amdgcn_mfma_f32_16x16x32_f16(wa[nt][0], a0, z, 0, 0, 0); ra = __builtin_amdgcn_mfma_f32_16x16x32_f16(wa[nt][1], a1, ra, 0, 0, 0);
                f32x4 rx = __builtin_amdgcn_mfma_f32_16x16x32_f16(wx[nt][0], a0, z, 0, 0, 0); rx = __builtin_amdgcn_mfma_f32_16x16x32_f16(wx[nt][1], a1, rx, 0, 0, 0);
                *(LAS f32x4*)(PRE + ar * 64 + nt * 16 + 4 * kq) = ra; *(LAS f32x4*)(PRE + 1024 + ar * 64 + nt * 16 + 4 * kq) = rx; } }
        __syncthreads();
        if (act) {
            float pa[16], px[16]; half_t xv[16];
#pragma unroll
            for (int tt = 0; tt < 16; ++tt) { pa[tt] = PRE[tt * 64 + C.lane]; px[tt] = PRE[1024 + tt * 64 + C.lane]; xv[tt] = XC[(sc * 16 + tt + 3) * LDX + ch]; }
#pragma unroll
            for (int tt = 0; tt < 16; ++tt) { const int t = sc * 16 + tt;
                const float rg = sigmoidf_(pa[tt] + ba), ig = sigmoidf_(px[tt] + bx), xcv = (float)xv[tt];
                const float a = __expf(-8.f * rg * sp); const float mult = __builtin_amdgcn_sqrtf(fmaxf((1.f - a) * (1.f + a), 0.f));
                hl = a * hl + mult * ig * xcv; pr *= a;
                HP[(row0 + t) * LRU_W + ch] = pkh(hl, pr); } }
        LDS_WAIT();
    }
    if (act) WSP(f32x2, WS_XN)[((size_t)b * NCH + c) * LRU_W + ch] = (f32x2){hl, pr};
}
__device__ __forceinline__ void lru_final_unit(const Ctx& C, int l, int b, int c) {
    LAS float* CAR = (LAS float*)C.lds;
    const unsigned* HP = WSP(unsigned, WS_PR); const half_t* P = WSP(half_t, WS_PROJ); const size_t row0 = (size_t)b * SEQ + c * CH_T;
    const bool hasB = C.lane < 32; const int cA = 4 * C.lane, cB = 256 + 4 * (C.lane & 31);
    u32x4 hpA[8], hpB[8]; u32x2 gtA[8], gtB[8];
#pragma unroll
    for (int r = 0; r < 8; ++r) { const size_t row = row0 + C.wave * 8 + r;
        hpA[r] = *(const u32x4*)(HP + row * LRU_W + cA); gtA[r] = *(const u32x2*)(P + row * NPROJ + COL_GT + cA);
        hpB[r] = *(const u32x4*)(HP + row * LRU_W + cB); gtB[r] = *(const u32x2*)(P + row * NPROJ + COL_GT + cB); }
    __syncthreads();
    if (C.tid < LRU_W) { const int ch = C.tid; float carry = 0.f; const f32x2* L0 = WSP(f32x2, WS_XN) + (size_t)b * NCH * LRU_W + ch;
        const f32x2* Z0 = WSP(f32x2, WS_CTL + 524288) + ch;
        const int nbat = (c + 31) / 32; int jb = c - nbat * 32;
        for (int bt = 0; bt < nbat; ++bt, jb += 32) { f32x2 ev[32];
#pragma unroll
            for (int u = 0; u < 32; ++u) { const int j = jb + u; const f32x2* s0 = j >= 0 ? L0 + (size_t)j * LRU_W : Z0; ev[u] = *s0; }
#pragma unroll
            for (int u = 0; u < 32; ++u) carry = ev[u].y * carry + ev[u].x; }
        CAR[ch] = carry; }
    __syncthreads();
    const f32x4 carA = *(const LAS f32x4*)(CAR + cA), carB = *(const LAS f32x4*)(CAR + cB);
    half_t* O = WSP(half_t, WS_O);
#pragma unroll
    for (int r = 0; r < 8; ++r) { const size_t row = row0 + C.wave * 8 + r;
        const h8 pa = __builtin_bit_cast(h8, hpA[r]), pb = __builtin_bit_cast(h8, hpB[r]);
        const f32x4 ga = unpk4(gtA[r]), gb = unpk4(gtB[r]);
        f32x4 oa = (f32x4){(float)pa[0], (float)pa[2], (float)pa[4], (float)pa[6]} + (f32x4){(float)pa[1], (float)pa[3], (float)pa[5], (float)pa[7]} * carA;
        f32x4 ob = (f32x4){(float)pb[0], (float)pb[2], (float)pb[4], (float)pb[6]} + (f32x4){(float)pb[1], (float)pb[3], (float)pb[5], (float)pb[7]} * carB;
        oa = (f32x4){oa.x * gelu_tanh(ga.x), oa.y * gelu_tanh(ga.y), oa.z * gelu_tanh(ga.z), oa.w * gelu_tanh(ga.w)};
        ob = (f32x4){ob.x * gelu_tanh(gb.x), ob.y * gelu_tanh(gb.y), ob.z * gelu_tanh(gb.z), ob.w * gelu_tanh(gb.w)};
        if (!hasB) ob = (f32x4){0.f, 0.f, 0.f, 0.f};
        const float ss = (oa.x * oa.x + oa.y * oa.y) + (oa.z * oa.z + oa.w * oa.w) + (ob.x * ob.x + ob.y * ob.y) + (ob.z * ob.z + ob.w * ob.w);
        const float rstd = 1.f / sqrtf(wave_sum(ss) * (1.f / 384.f) + EPS);
        { const f32x4 q = oa * rstd; u32x2 w; w.x = pkh(q.x, q.y); w.y = pkh(q.z, q.w); *(u32x2*)(O + row * D + 384 + cA) = w; }
        if (hasB) { const f32x4 q = ob * rstd; u32x2 w; w.x = pkh(q.x, q.y); w.y = pkh(q.z, q.w); *(u32x2*)(O + row * D + 384 + cB) = w; } }
}
template <bool FINAL>
__device__ __forceinline__ void s5_unit(const Ctx& C, int l, int b, int c) {
    constexpr int LDU = 264, LDB = 136;
    LAS half_t* UT = (LAS half_t*)C.lds;
    LAS half_t* SCR = (LAS half_t*)(C.lds + 34816) + C.wave * (2 * 16 * LDB);
    const half_t* P = WSP(half_t, WS_PROJ); const size_t row0 = (size_t)b * SEQ + c * CH_T;
    __syncthreads();
    for (int i = C.tid; i < 64 * 32; i += 512) { const int t = i >> 5, cc = i & 31; *(LAS u32x4*)(UT + t * LDU + cc * 8) = *(const u32x4*)(P + (row0 + t) * NPROJ + COL_U + cc * 8); }
    const int ar = C.lane & 15, kq = C.lane >> 4, p = C.lane;
    float xre[2] = {0.f, 0.f}, xim[2] = {0.f, 0.f};
    if constexpr (FINAL) {
        constexpr int FB = 32; float tre[2], tim[2]; const f32x2* E0 = WSP(f32x2, WS_S5E) + ((size_t)b * NCH * 16 + C.wave) * 64 + p;
#pragma unroll
        for (int gi = 0; gi < 2; ++gi) { const int lg = l * 16 + C.wave + 8 * gi; tre[gi] = WSP(float, SM_ABART)[2 * (lg * 64 + p)]; tim[gi] = WSP(float, SM_ABART)[2 * (lg * 64 + p) + 1]; }
        const f32x2* Z0 = WSP(f32x2, WS_CTL + 524288) + p;
        const int nbat = (c + FB - 1) / FB; int jb = c - nbat * FB;
        for (int bt = 0; bt < nbat; ++bt, jb += FB) { f32x2 ev[2][FB];
#pragma unroll
            for (int u = 0; u < FB; ++u) { const int j = jb + u; const f32x2* s0 = j >= 0 ? E0 + (size_t)j * 16 * 64 : Z0; const f32x2* s1 = j >= 0 ? E0 + (size_t)j * 16 * 64 + 8 * 64 : Z0; ev[0][u] = *s0; ev[1][u] = *s1; }
#pragma unroll
            for (int u = 0; u < FB; ++u) {
#pragma unroll
                for (int gi = 0; gi < 2; ++gi) { const float nre = tre[gi] * xre[gi] - tim[gi] * xim[gi] + ev[gi][u].x, nim = tre[gi] * xim[gi] + tim[gi] * xre[gi] + ev[gi][u].y; xre[gi] = nre; xim[gi] = nim; } } } }
    float are[2], aim[2]; f32x4 dskv[2]; h8 bfr[2][8], cfr[2][4];
#pragma unroll
    for (int gi = 0; gi < 2; ++gi) { const int g = C.wave + 8 * gi, lg = l * 16 + g;
        are[gi] = WSP(float, SM_ABAR)[2 * (lg * 64 + p)]; aim[gi] = WSP(float, SM_ABAR)[2 * (lg * 64 + p) + 1];
        const half_t* bbt = WSP(half_t, SM_BBT) + (size_t)lg * 128 * 32;
#pragma unroll
        for (int nt = 0; nt < 8; ++nt) bfr[gi][nt] = *(const h8*)(bbt + (nt * 16 + ar) * 32 + kq * 8);
        if constexpr (FINAL) { const half_t* cmt = WSP(half_t, SM_CMT) + (size_t)lg * 16 * 128;
#pragma unroll
            for (int ks = 0; ks < 4; ++ks) cfr[gi][ks] = *(const h8*)(cmt + ar * 128 + ks * 32 + kq * 8);
            dskv[gi] = *(const f32x4*)(WSP(float, PAR_S5D) + l * S5_W + g * 16 + 4 * kq); } }
    __syncthreads();
    for (int sc = 0; sc < 4; ++sc) {
#pragma unroll
        for (int gi = 0; gi < 2; ++gi) { const int g = C.wave + 8 * gi; LAS half_t* S = SCR + gi * (16 * LDB);
            h8 af = {}; if (kq < 2) af = *(const LAS h8*)(UT + (sc * 16 + ar) * LDU + g * 16 + kq * 8);
#pragma unroll
            for (int nt = 0; nt < 8; ++nt) { const f32x4 z = {0.f, 0.f, 0.f, 0.f}; const f32x4 r = __builtin_amdgcn_mfma_f32_16x16x32_f16(bfr[gi][nt], af, z, 0, 0, 0);
                u32x2 w; w.x = pkh(r[0], r[1]); w.y = pkh(r[2], r[3]); *(LAS u32x2*)(S + ar * LDB + nt * 16 + 4 * kq) = w; } }
        __syncthreads();
        { unsigned bw[2][16];
#pragma unroll
          for (int gi = 0; gi < 2; ++gi)
#pragma unroll
            for (int tt = 0; tt < 16; ++tt) bw[gi][tt] = ((const LAS unsigned*)(SCR + gi * (16 * LDB)))[tt * (LDB / 2) + p];
#pragma unroll
          for (int tt = 0; tt < 16; ++tt)
#pragma unroll
            for (int gi = 0; gi < 2; ++gi) { const h2 bu = __builtin_bit_cast(h2, bw[gi][tt]); const float bre = (float)bu[0], bim = (float)bu[1];
                const float nre = are[gi] * xre[gi] - aim[gi] * xim[gi] + bre, nim = are[gi] * xim[gi] + aim[gi] * xre[gi] + bim; xre[gi] = nre; xim[gi] = nim;
                if constexpr (FINAL) bw[gi][tt] = pkh(xre[gi], xim[gi]); }
          if constexpr (FINAL) {
#pragma unroll
            for (int gi = 0; gi < 2; ++gi)
#pragma unroll
              for (int tt = 0; tt < 16; ++tt) ((LAS unsigned*)(SCR + gi * (16 * LDB)))[tt * (LDB / 2) + p] = bw[gi][tt]; } }
        if constexpr (FINAL) {
            __syncthreads();
#pragma unroll
            for (int gi = 0; gi < 2; ++gi) { const int g = C.wave + 8 * gi; LAS half_t* S = SCR + gi * (16 * LDB);
                f32x4 y = {0.f, 0.f, 0.f, 0.f};
#pragma unroll
                for (int ks = 0; ks < 4; ++ks) { const h8 a = *(const LAS h8*)(S + ar * LDB + ks * 32 + kq * 8); y = __builtin_amdgcn_mfma_f32_16x16x32_f16(cfr[gi][ks], a, y, 0, 0, 0); }
                LAS u32x2* up = (LAS u32x2*)(UT + (sc * 16 + ar) * LDU + g * 16 + 4 * kq); const f32x4 uv = unpk4(*up); const f32x4 yv = y + dskv[gi] * uv;
                u32x2 w; w.x = pkh(gelu_tanh(yv.x), gelu_tanh(yv.y)); w.y = pkh(gelu_tanh(yv.z), gelu_tanh(yv.w)); *up = w; }
        }
        __syncthreads();
    }
    if constexpr (!FINAL) {
#pragma unroll
        for (int gi = 0; gi < 2; ++gi) WSP(f32x2, WS_S5E)[(((size_t)b * NCH + c) * 16 + C.wave + 8 * gi) * 64 + p] = (f32x2){xre[gi], xim[gi]}; }
    if constexpr (FINAL) {
        LAS float* OT = (LAS float*)(C.lds + 34816);
        const half_t* glut = WSP(half_t, SM_GLUT) + (size_t)l * 65536;
        h8 gf[2][8];
#pragma unroll
        for (int j = 0; j < 2; ++j)
#pragma unroll
            for (int ks = 0; ks < 8; ++ks) gf[j][ks] = *(const h8*)(glut + (size_t)((2 * C.wave + j) * 16 + ar) * 256 + ks * 32 + kq * 8);
#pragma unroll
        for (int j = 0; j < 2; ++j) { const int nt = 2 * C.wave + j; const f32x4 gb = *(const f32x4*)(WSP(float, PAR_GLUB) + l * S5_W + nt * 16 + 4 * kq);
#pragma unroll
            for (int mt = 0; mt < 4; ++mt) { f32x4 r = {0.f, 0.f, 0.f, 0.f};
#pragma unroll
                for (int ks = 0; ks < 8; ++ks) { const h8 a = *(const LAS h8*)(UT + (mt * 16 + ar) * LDU + ks * 32 + kq * 8); r = __builtin_amdgcn_mfma_f32_16x16x32_f16(gf[j][ks], a, r, 0, 0, 0); }
                const int t = mt * 16 + ar; const f32x4 yv = unpk4(*(const LAS u32x2*)(UT + t * LDU + nt * 16 + 4 * kq)); r = r + gb;
                *(LAS f32x4*)(OT + t * 260 + nt * 16 + 4 * kq) = (f32x4){yv.x * sigmoidf_(r.x), yv.y * sigmoidf_(r.y), yv.z * sigmoidf_(r.z), yv.w * sigmoidf_(r.w)}; } }
        __syncthreads();
        half_t* O = WSP(half_t, WS_O);
        for (int rr = 0; rr < 8; ++rr) { const int t = C.wave * 8 + rr; const f32x4 v = *(const LAS f32x4*)(OT + t * 260 + 4 * C.lane);
            const float ss = wave_sum((v.x * v.x + v.y * v.y) + (v.z * v.z + v.w * v.w)); const float rstd = 1.f / sqrtf(ss * (1.f / 256.f) + EPS);
            const f32x4 r = v * rstd; u32x2 w; w.x = pkh(r.x, r.y); w.y = pkh(r.z, r.w);
            *(u32x2*)(O + (row0 + t) * D + 768 + 4 * C.lane) = w; }
    }
}

__device__ __forceinline__ void moe_gather_rows(const Ctx& C, int nslots) {
    const unsigned char* X = WSP(unsigned char, WS_XN8); unsigned char* G = WSP(unsigned char, WS_XG8); const int* st = WSP(int, MO_SLOTTOK);
    for (int s = C.gw; s < nslots; s += C.NGW) { const int tok = st[s]; *((u32x4*)(G + (size_t)s * D) + C.lane) = *((const u32x4*)(X + (size_t)tok * D) + C.lane); }
}
__device__ __forceinline__ void moe_lists(const Ctx& C) {
    LAS int* cnt = (LAS int*)C.lds;
    LAS int* tot = cnt + 2048;
    const int* bc = WSP(int, MO_BLKCNT);
    __syncthreads();
    for (int i = C.tid; i < C.G * 8; i += 512) cnt[i] = bc[i];
    if (C.tid < 8) tot[32 + C.tid] = 0;
    __syncthreads();
    { const int e = C.wave; float t = 0.f, mine = 0.f;
      for (int k = C.lane; k < C.G; k += 64) { const float v = (float)cnt[k * 8 + e]; t += v; mine += (k < C.bid) ? v : 0.f; }
      t = wave_sum(t); mine = wave_sum(mine);
      if (C.lane == 0) { tot[e] = (int)t; tot[8 + e] = (int)mine; } }
    __syncthreads();
    if (C.tid == 0) { int base = 0; for (int e = 0; e < 8; ++e) { const int nt = (tot[e] + 255) >> 8; tot[16 + e] = base; tot[24 + e] = nt; base += nt * 256; } tot[40] = base >> 8; }
    __syncthreads();
    int* slot_tok = WSP(int, MO_SLOTTOK); int* tok_slot = WSP(int, MO_TOKSLOT); const int* sel = WSP(int, MO_SEL);
    { LAS int* wc = tot + 48;
      int e0 = 0, e1 = 0; const int mtok = C.bid * (M / 256) + C.tid;
      if (C.tid < 128) { const int s = sel[mtok]; e0 = s & 255; e1 = s >> 8; }
      const unsigned long long lt = (1ull << C.lane) - 1ull; int r0 = 0, r1 = 0;
      if (C.wave < 2) {
#pragma unroll
          for (int e = 0; e < 8; ++e) { const unsigned long long b0 = __ballot(e0 == e), b1 = __ballot(e1 == e);
              if (e0 == e) r0 = __popcll(b0 & lt); if (e1 == e) r1 = __popcll(b1 & lt);
              if (C.lane == 0) { wc[(C.wave * 2 + 0) * 8 + e] = __popcll(b0); wc[(C.wave * 2 + 1) * 8 + e] = __popcll(b1); } } }
      __syncthreads();
      if (C.tid < 128) { const int w = C.wave;
          const int s0 = tot[16 + e0] + tot[8 + e0] + (w == 1 ? wc[(0 * 2 + 0) * 8 + e0] : 0) + r0;
          const int s1 = tot[16 + e1] + tot[8 + e1] + wc[(0 * 2 + 0) * 8 + e1] + wc[(1 * 2 + 0) * 8 + e1] + (w == 1 ? wc[(0 * 2 + 1) * 8 + e1] : 0) + r1;
          slot_tok[s0] = mtok; slot_tok[s1] = mtok; tok_slot[2 * mtok] = s0; tok_slot[2 * mtok + 1] = s1; tot[64 + 2 * C.tid] = s0; tot[64 + 2 * C.tid + 1] = s1; } }
    __syncthreads();
    { const unsigned char* X = WSP(unsigned char, WS_XN8); unsigned char* G = WSP(unsigned char, WS_XG8);
      u32x4 v[M / 256 / NWAVES];
#pragma unroll
      for (int i = 0; i < M / 256 / NWAVES; ++i) { const int m = C.bid * (M / 256) + C.wave + NWAVES * i; v[i] = *((const u32x4*)(X + (size_t)m * D) + C.lane); }
#pragma unroll
      for (int i = 0; i < M / 256 / NWAVES; ++i) { const int r = C.wave + NWAVES * i; const int s0 = tot[64 + 2 * r], s1 = tot[64 + 2 * r + 1];
          *((u32x4*)(G + (size_t)s0 * D) + C.lane) = v[i]; *((u32x4*)(G + (size_t)s1 * D) + C.lane) = v[i]; } }
    if (C.bid < 8) {
        { const int e = C.bid; const int lo = tot[16 + e] + tot[e], hi = tot[16 + e] + tot[24 + e] * 256; for (int s = lo + C.tid; s < hi; s += 512) slot_tok[s] = 0;
            for (int i = C.tid; i < (hi - lo) * 64; i += 512) *((u32x4*)(WSP(unsigned char, WS_XG8) + (size_t)(lo + (i >> 6)) * D) + (i & 63)) = (u32x4){0u, 0u, 0u, 0u}; } }
    if (C.bid == 0) {
        int* texp = WSP(int, MO_TEXP);
        for (int t = C.tid; t < 512; t += 512) { int e = 0; for (int k = 0; k < 8; ++k) if (t * 256 >= tot[16 + k]) e = k; texp[t] = e; }
        if (C.tid == 0) __hip_atomic_store((gu32*)(WSP(unsigned, WS_CTL) + CW_NT), (unsigned)tot[40], RLX_AGENT);
    }
}

#ifdef DBG_CHECK
__device__ __forceinline__ void dbg_attn_check(const Ctx& C) {
    const half_t* P = WSP(half_t, WS_PROJ); const half_t* O = WSP(half_t, WS_O); float* acc = (float*)(WSP(unsigned, WS_CTL) + 256);
    for (int i = C.gw; i < 2048; i += C.NGW) {
#ifdef DBG_J
        const int s = ((i * 97 + 13) & 255) + 256 * DBG_J, h = i % 6, b = (i / 6) & 7, j = s >> 8; const size_t row = (size_t)b * SEQ + s; const int d = C.lane;
#else
        const int s = (i * 97 + 13) & 4095, h = i % 6, b = (i / 6) & 7, j = s >> 8; const size_t row = (size_t)b * SEQ + s; const int d = C.lane;
#endif
        const float qd = (float)P[row * NPROJ + h * 64 + d];
        const float* km = WSP(float, WS_KMEAN) + (size_t)(b * NH + h) * 16 * 64;
        float v1 = -INFINITY, v2 = -INFINITY, v3 = -INFINITY; int i1 = -1, i2 = -1, i3 = -1;
        for (int n = 0; n < j; ++n) { const float g = wave_sum(qd * km[n * 64 + d]);
            if (g > v1) { v3 = v2; i3 = i2; v2 = v1; i2 = i1; v1 = g; i1 = n; } else if (g > v2) { v3 = v2; i3 = i2; v2 = g; i2 = n; } else if (g > v3) { v3 = g; i3 = n; } }
        float m = -INFINITY, l = 0.f, od = 0.f;
        for (int pass = 0; pass < 2; ++pass)
            for (int blk = 0; blk <= j; ++blk) { if (blk < j && blk != i1 && blk != i2 && blk != i3) continue;
                const int kend = (blk == j) ? (s - blk * 256) : 255;
                for (int kk = 0; kk <= kend; ++kk) { const size_t kr = ((size_t)b * SEQ + blk * 256 + kk) * NPROJ + h * 64 + d;
                    const float sc = wave_sum(qd * (float)P[kr + COL_K]);
                    if (pass == 0) m = fmaxf(m, sc); else { const float p = exp2f(sc - m); l += p; od += p * (float)P[kr + COL_V]; } } }
        od /= l; const float mine = (float)O[row * D + h * 64 + d];
        const float e = wave_sum((od - mine) * (od - mine)), r = wave_sum(od * od);
        if (C.lane == 0) { atomicAdd(acc, e / r); atomicAdd(acc + 1, 1.f); }
    }
}
__device__ __forceinline__ void dbg_attn_check2(const Ctx& C, int l) {
    const half_t* P = WSP(half_t, WS_PROJ); const half_t* O = WSP(half_t, WS_O); float* acc = (float*)(WSP(unsigned, WS_CTL) + 256);
    const float* gain = WSP(float, PAR_GAIN) + (size_t)l * D;
    for (int i = C.gw; i < 512; i += C.NGW) {
        const int s = (i * 97 + 13) & 4095, b = i & 7, j = s >> 8; const size_t row = (size_t)b * SEQ + s; const int d = C.lane;
        float oh[6]; float ss = 0.f;
#pragma unroll
        for (int h = 0; h < 6; ++h) {
            const float qd = (float)P[row * NPROJ + h * 64 + d];
            const float* km = WSP(float, WS_KMEAN) + (size_t)(b * NH + h) * 16 * 64;
            float v1 = -INFINITY, v2 = -INFINITY, v3 = -INFINITY; int i1 = -1, i2 = -1, i3 = -1;
            for (int n = 0; n < j; ++n) { const float g = wave_sum(qd * km[n * 64 + d]);
                if (g > v1) { v3 = v2; i3 = i2; v2 = v1; i2 = i1; v1 = g; i1 = n; } else if (g > v2) { v3 = v2; i3 = i2; v2 = g; i2 = n; } else if (g > v3) { v3 = g; i3 = n; } }
            float m = -INFINITY, lsum = 0.f, od = 0.f;
            for (int pass = 0; pass < 2; ++pass)
                for (int blk = 0; blk <= j; ++blk) { if (blk < j && blk != i1 && blk != i2 && blk != i3) continue;
                    const int kend = (blk == j) ? (s - blk * 256) : 255;
                    for (int kk = 0; kk <= kend; ++kk) { const size_t kr = ((size_t)b * SEQ + blk * 256 + kk) * NPROJ + h * 64 + d;
                        const float sc = wave_sum(qd * (float)P[kr + COL_K]);
                        if (pass == 0) m = fmaxf(m, sc); else { const float p = exp2f(sc - m); lsum += p; od += p * (float)P[kr + COL_V]; } } }
            oh[h] = od / lsum; ss += oh[h] * oh[h];
        }
        const float msq_ = wave_sum(ss) * (1.f / 384.f); const float rstd = 1.f / sqrtf(msq_ + EPS); float e = 0.f, r = 0.f;
#ifdef DBG_MS
        if (C.lane == 0) { atomicAdd(acc + 6, msq_ * DBG_MS); atomicAdd(acc + 7, 1.f); }
#endif
#ifdef DBG_RHO
        { float sm = 0.f, so = 0.f, smo = 0.f;
#pragma unroll
          for (int h = 0; h < 6; ++h) { const float mv = (float)O[row * D + h * 64 + d]; sm += mv * mv; so += oh[h] * oh[h]; smo += mv * oh[h]; }
          sm = wave_sum(sm); so = wave_sum(so); smo = wave_sum(smo);
          if (C.lane == 0) { atomicAdd(acc + 6, smo * smo / (sm * so)); atomicAdd(acc + 7, 1.f); } }
#endif
#pragma unroll
        for (int h = 0; h < 6; ++h) {
#ifdef DBG_RAW
            const float want = oh[h],
#else
            const float want = oh[h] * rstd * gain[h * 64 + d],
#endif
            mine = (float)O[row * D + h * 64 + d]; const float eh = wave_sum((want - mine) * (want - mine)), rh = wave_sum(want * want); if (C.lane == 0) { atomicAdd(acc + 2 * (h >> 1 > 1 ? 1 : h >> 1 == 1 ? 2 : 0), eh); atomicAdd(acc + 2 * (h >> 1 > 1 ? 1 : h >> 1 == 1 ? 2 : 0) + 1, rh); } }
        (void)e; (void)r;
    }
}
__device__ __forceinline__ void dbg_meansq(const Ctx& C, int c0) {
    const half_t* O = WSP(half_t, WS_O); float* acc = (float*)(WSP(unsigned, WS_CTL) + 256);
    for (int i = C.gw; i < 4096; i += C.NGW) { const size_t row = ((size_t)i * 7919 + 3) % M; float s = 0.f;
        for (int k = 0; k < 6; ++k) { const float v = (float)O[row * D + c0 + C.lane + 64 * k]; s += v * v; }
        s = wave_sum(s); if (C.lane == 0) { atomicAdd(acc, s); atomicAdd(acc + 1, 384.f); } }
}
__device__ __forceinline__ void dbg_out_check(const Ctx& C, int l, const float* xin, const float* xres) {
    const half_t* O = WSP(half_t, WS_O); float* acc = (float*)(WSP(unsigned, WS_CTL) + 256);
    const float* W = KARG(float, I_W_OUT) + (size_t)l * D * D; const float* mod = WSP(float, WS_MOD) + (size_t)l * 8 * 6144;
    for (int i = C.gw; i < 256 * 16; i += C.NGW) {
        const int cg = i & 15, sr = i >> 4; const size_t row = ((size_t)sr * 12347 + 101) % M; const int n = cg * 64 + C.lane, b = (int)(row >> 12);
        float a = 0.f;
        for (int k = 0; k < D; ++k) a += (float)O[row * D + k] * W[(size_t)k * D + n];
        const float want = xin[row * D + n] + mod[(size_t)b * 6144 + 2048 + n] * a, mine = xres[row * D + n];
        const float e = wave_sum((want - mine) * (want - mine)), r = wave_sum((want - xin[row * D + n]) * (want - xin[row * D + n]));
        if (C.lane == 0) { atomicAdd(acc, e); atomicAdd(acc + 1, r); }
    }
}
__device__ __forceinline__ float fp8_dec(unsigned char b) { return __builtin_amdgcn_cvt_f32_fp8((int)b, 0); }
__device__ __forceinline__ void dbg_moeup_check(const Ctx& C) {
    const unsigned char* X = WSP(unsigned char, WS_XG8); const unsigned char* Wt = WSP(unsigned char, WS_MGU); const unsigned char* H = WSP(unsigned char, WS_HID); const int* texp = WSP(int, MO_TEXP);
    float* acc = (float*)(WSP(unsigned, WS_CTL) + 256);
    for (int i = C.gw; i < 4096; i += C.NGW) { const int s = (i * 131 + 7) & 16383, j = (i * 977 + 5) % FFE, e = texp[s >> 8];
        const int tile = j >> 7, w = j & 127; const unsigned char* wg = Wt + ((size_t)e * 2 * FFE + tile * 256 + w) * D; const unsigned char* wu = wg + (size_t)128 * D;
        float g = 0.f, u = 0.f;
        for (int k = DBG_K0 + C.lane; k < DBG_K1; k += 64) { const float x = fp8_dec(X[(size_t)s * D + k]); g += x * fp8_dec(wg[k]); u += x * fp8_dec(wu[k]); }
        for (int o = 1; o < 64; o <<= 1) { g += __shfl_xor(g, o); u += __shfl_xor(u, o); }
        g *= (1.f / 32.f); u *= (1.f / 32.f);
        const float want = siluf_(g) * u, mine = fp8_dec(H[(size_t)s * FFE + j]);
        if (C.lane == 0) { atomicAdd(acc, (want - mine) * (want - mine)); atomicAdd(acc + 1, want * want); } }
}
__device__ __forceinline__ f32x4 dbg_mfma8(v8i_t a, v8i_t b) { f32x4 c = {0.f, 0.f, 0.f, 0.f}; asm volatile("s_nop 15\n\ts_nop 15\n\tv_mfma_f32_16x16x128_f8f6f4 %0, %1, %2, %0\n\ts_nop 15\n\ts_nop 15" : "+v"(c) : "v"(a), "v"(b)); return c; }
__device__ __forceinline__ void dbg_mfma_probe(const Ctx& C) {
    if (C.bid != 0 || C.wave != 0) return;
    float* acc = (float*)(WSP(unsigned, WS_CTL) + 256); const int fq = C.lane >> 4; const int ONE = 0x38383838;
    v8i_t all1; for (int r = 0; r < 8; ++r) all1[r] = ONE;
    v8i_t r0 = {ONE, 0, 0, 0, 0, 0, 0, 0}, r1 = {0, ONE, 0, 0, 0, 0, 0, 0}, r4 = {0, 0, 0, 0, ONE, 0, 0, 0}, z = {0, 0, 0, 0, 0, 0, 0, 0};
    v8i_t g0 = fq == 0 ? all1 : z, g1 = fq == 1 ? all1 : z;
    const float d1 = dbg_mfma8(all1, all1)[0], d2 = dbg_mfma8(r0, r0)[0], d3 = dbg_mfma8(r0, r1)[0], d4 = dbg_mfma8(g0, g0)[0], d5 = dbg_mfma8(g0, g1)[0], d6 = dbg_mfma8(r0, r4)[0];
    v8i_t b0 = {0x38, 0, 0, 0, 0, 0, 0, 0}, b1 = {0x3800, 0, 0, 0, 0, 0, 0, 0};
    const float d7 = dbg_mfma8(b0, b0)[0], d8 = dbg_mfma8(b0, b1)[0];
    v8i_t arow3 = (C.lane & 15) == 3 ? all1 : z, bcol5 = (C.lane & 15) == 5 ? all1 : z;
    const f32x4 e1 = dbg_mfma8(arow3, all1), e2 = dbg_mfma8(all1, bcol5);
    const float e2l5 = __builtin_bit_cast(float, __builtin_amdgcn_readlane(__builtin_bit_cast(int, e2[0]), 5)), e2l4 = __builtin_bit_cast(float, __builtin_amdgcn_readlane(__builtin_bit_cast(int, e2[0]), 4));
    const float e1l17 = __builtin_bit_cast(float, __builtin_amdgcn_readlane(__builtin_bit_cast(int, e1[3]), 17));
    float wsv = (float)C.lane; asm volatile("" : "+v"(wsv)); const float ws_total = wave_sum(wsv); const float x1 = xor_lane<1>(wsv), x16 = xor_lane<16>(wsv);
    float h32 = wsv; h32 += xor_lane<1>(h32); h32 += xor_lane<2>(h32); h32 += xor_lane<4>(h32); h32 += xor_lane<8>(h32); h32 += xor_lane<16>(h32);
    if (C.lane == 0) {
#if DBG_PROBE == 6
        atomicAdd(acc, DBG_PSEL == 0 ? ws_total : DBG_PSEL == 1 ? x1 + 100.f * x16 : h32);
        atomicAdd(acc + 1, 0.f);
#elif DBG_PROBE == 66
        { }
#elif DBG_PROBE == 5
        { float one = 1.0f; asm volatile("" : "+v"(one)); const int enc = __builtin_amdgcn_cvt_pk_fp8_f32(one, one, 0, false) & 0xff; int b38 = 0x38; asm volatile("" : "+v"(b38)); const float dec = __builtin_amdgcn_cvt_f32_fp8(b38, 0);
          atomicAdd(acc, (enc == 0x38 ? 1.f : enc == 0x40 ? 2.f : 3.f) + (dec == 1.0f ? 10.f : dec == 0.5f ? 20.f : 30.f)); }
#elif DBG_PROBE == 4
        atomicAdd(acc, (e1[3] == 128.f ? 1.f : 0.f) + (e1[0] == 0.f ? 2.f : 0.f) + (e2l5 == 128.f ? 4.f : 0.f) + (e2l4 == 0.f ? 8.f : 0.f) + (e1l17 == 0.f ? 16.f : 0.f));
#elif DBG_PROBE == 0
        atomicAdd(acc, d1);
#elif DBG_PROBE == 1
        atomicAdd(acc, (d2 == 16.f ? 1.f : 0.f) + (d3 == 0.f ? 2.f : 0.f) + (d4 == 32.f ? 4.f : 0.f) + (d5 == 0.f ? 8.f : 0.f) + (d6 == 0.f ? 16.f : 0.f) + (d7 == 4.f ? 32.f : 0.f));
#elif DBG_PROBE == 2
        atomicAdd(acc, d2 + 100.f * d4);
#else
        atomicAdd(acc, d7 + 10.f * d8 + 100.f * d3 + 1000.f * d5);
#endif
        atomicAdd(acc + 1, 100.f); }
}
__device__ __forceinline__ void dbg_proj_check(const Ctx& C, int l) {
    const half_t* P = WSP(half_t, WS_PROJ); const half_t* X = WSP(half_t, WS_XN); float* acc = (float*)(WSP(unsigned, WS_CTL) + 256);
    const float* W = KARG(float, I_W_IN) + (size_t)l * D * NPROJ; const int* pos = KARG(int, I_POS);
    for (int i = C.gw; i < 256 * 34; i += C.NGW) {
        const int grp = i % 34, sr = i / 34; const size_t row = ((size_t)sr * 12347 + 101) % M; const int d = C.lane, col = grp * 64 + d;
        float a = 0.f;
        for (int k = 0; k < D; ++k) a += (float)X[row * D + k] * W[(size_t)k * NPROJ + col];
        float outv = a;
        if (grp < 12) { const float partner = __shfl_xor(a, 32); const int fi = d & 31; const float ang = (float)pos[row] * powf(10000.f, -(float)fi / 32.f); const float cs = cosf(ang), sn = sinf(ang);
            outv = (d < 32) ? a * cs - partner * sn : a * cs + partner * sn; if (grp < 6) outv *= C2; }
        const float mine = (float)P[row * NPROJ + col];
        const float e = wave_sum((outv - mine) * (outv - mine)), r = wave_sum(outv * outv); const int sel = grp < 6 ? 0 : grp < 12 ? 1 : grp < 18 ? 2 : 3;
        if (C.lane == 0) { atomicAdd(acc + 2 * sel, e); atomicAdd(acc + 2 * sel + 1, r); }
    }
}
__device__ __forceinline__ void dbg_emit(const Ctx& C, float* out) {
    const float* acc = (const float*)(WSP(unsigned, WS_CTL) + 256); float worst = 0.f;
#ifndef DBG_SEL
    for (int k = 0; k < 4; ++k) { const float e = __hip_atomic_load(acc + 2 * k, RLX_AGENT), r = __hip_atomic_load(acc + 2 * k + 1, RLX_AGENT); if (r > 0.f) worst = fmaxf(worst, e / r); }
#else
    { const float e = __hip_atomic_load(acc + 2 * DBG_SEL, RLX_AGENT), r = __hip_atomic_load(acc + 2 * DBG_SEL + 1, RLX_AGENT); worst = e / fmaxf(r, 1e-30f); }
#endif
#ifdef DBG_BUCKET
    const float c = worst > 0.f ? 2.f + 2.f * floorf(log10f(worst)) : 0.f;
#else
    const float c = sqrtf(100.f * worst);
#endif
    for (size_t i = (size_t)C.bid * 512 + C.tid; i < (size_t)M * D; i += (size_t)C.G * 512) out[i] = c;
}
#endif

#ifdef DBG_SNAP
#define DBG_EXTRA_WS (20u << 20)
#else
#define DBG_EXTRA_WS 0
#endif
#ifndef MK_N_LAUNCHES
#define MK_N_LAUNCHES 1
#endif
constexpr int NPHASE = 2 + 8 + (4 + 2 + 2 * MOE_NCHUNK + 1);

__global__ void __launch_bounds__(NWAVES * 64, 2) mk_fwd(Args A_unused) {
    extern __shared__ __attribute__((aligned(16))) unsigned char lds_raw[];
    Ctx C0; { Ctx& C = C0; C.lds = (LAS unsigned char*)lds_raw; C.tid = threadIdx.x; C.lane = C.tid & 63; C.wave = __builtin_amdgcn_readfirstlane(C.tid >> 6);
    C.G = gridDim.x; C.bid = blockIdx.x; C.gw = C.bid * NWAVES + C.wave; C.NGW = C.G * NWAVES; C.ws = (unsigned char*)karg(I_WS); }
    const Ctx& C = C0;
    volatile LAS unsigned* MISC = (volatile LAS unsigned*)(C.lds + MISC_OFF);
    unsigned* ctl = (unsigned*)(GAS unsigned*)((unsigned long long)C.ws + WS_CTL);
    for (int u = C.tid; u < (LDS_BYTES - LDSCTL_OFF) / 4; u += NWAVES * 64) ((LAS unsigned*)(C.lds + LDSCTL_OFF))[u] = 0u;
    __syncthreads();
    XcdBarrier bar = xcd_barrier_post(ctl + CW_BAR, MISC + 8);
    const int lo = A_unused.ph_lo, hi = A_unused.ph_hi; int pid = 0;
#define OPAQUE_CTX(Cn, Co) Ctx Cn = Co; { unsigned long long w_ = (unsigned long long)Cn.ws; unsigned l_ = (unsigned)(uintptr_t)Cn.lds; unsigned z_ = 0u; asm volatile("" : "+v"(z_)); Cn.lane = (int)__builtin_amdgcn_mbcnt_hi(~0u, __builtin_amdgcn_mbcnt_lo(~0u, z_)); Cn.tid = Cn.wave * 64 + Cn.lane; \
    asm volatile("" : "+s"(Cn.wave), "+s"(Cn.bid), "+s"(Cn.gw), "+s"(w_), "+s"(l_)); Cn.ws = (unsigned char*)w_; Cn.lds = (LAS unsigned char*)(uintptr_t)l_; }
#define WSQ(Cx, T, off) ((T*)(GAS T*)((unsigned long long)Cx.ws + (off)))
#ifndef DBG_REPMASK
#define DBG_REPMASK 0ull
#endif
#define PH_BEGIN if (lo <= pid && pid < hi) { const int nrep_ = ((DBG_REPMASK >> pid) & 1ull) ? 2 : 1; for (int rep_ = 0; rep_ < nrep_; ++rep_) { OPAQUE_CTX(C, C0)
#define PH_END if (rep_ + 1 < nrep_) { XcdBarrier b3_ = bar; asm volatile("" : "+s"(b3_.bar)); xcd_barrier(b3_); } } } if (lo <= pid && pid + 1 < hi) { XcdBarrier b2_ = bar; asm volatile("" : "+s"(b2_.bar)); xcd_barrier(b2_); } ++pid;
    half_t* xres = WSP(half_t, WS_RES);
    float* mod = WSP(float, WS_MOD);

#if defined(DBG_CHECK) && DBG_CHECK == 11
    PH_BEGIN dbg_mfma_probe(C); PH_END  PH_BEGIN dbg_emit(C, (float*)(GAS float*)(unsigned long long)karg(I_OUT)); PH_END
#endif
    PH_BEGIN p0_prologue(C); PH_END
    PH_BEGIN row_pass_xn<false>(C, KARG(float, I_X), WSP(float, PAR_N1G), mod + 0, mod + 1024, WSP(half_t, WS_XN), nullptr, nullptr); PH_END

    for (int l = 0; l < 2; ++l) {
        const float* modl = mod + (size_t)l * 8 * 6144;
        PH_BEGIN
            pg8::Gemm g{WSP(half_t, WS_XN), WSP(half_t, WS_WIN) + (size_t)l * NPROJ_PAD * D, M, NPROJ_PAD, D, nullptr}; pg8::StaticOrder S; S.init(M, NPROJ_PAD, C.G, C.bid);
            EpiProj E{WSP(half_t, WS_PROJ), WSP(float, WS_ROPE_C), WSP(float, WS_ROPE_S)};
            pg8::gemm_phase<EpiProj, pg8::StaticOrder, true, true, false>(C.lds, g, S, E, C.wave);
        PH_END
#if defined(DBG_CHECK) && DBG_CHECK == 2
        if (l == 0) { PH_BEGIN dbg_proj_check(C, l); PH_END  PH_BEGIN dbg_emit(C, (float*)(GAS float*)(unsigned long long)karg(I_OUT)); PH_END }
#endif
        PH_BEGIN
#ifndef DBG_PREPREP
#define DBG_PREPREP 0
#endif
            kmean_items(C);
            for (int pr_ = 0; pr_ < ((DBG_PREPREP & 1) ? 2 : 1); ++pr_)
            for (int u = C.bid; u < BATCH * NCH; u += C.G) { OPAQUE_CTX(Cu, C) lru_prep_unit(Cu, l, u / NCH, u % NCH); }
            for (int pr_ = 0; pr_ < ((DBG_PREPREP & 2) ? 2 : 1); ++pr_)
            for (int u = C.bid; u < BATCH * NCH; u += C.G) { OPAQUE_CTX(Cu, C) s5_unit<false>(Cu, l, u / NCH, u % NCH); }
        PH_END
        PH_BEGIN
            unsigned* qw = ctl + (l == 0 ? CW_Q0 : CW_Q1) + 320 * rep_;
            constexpr int NATT = BATCH * NH * 16, NSC = BATCH * NCH;
            unsigned nxt_ = 0u; if (C.tid == 0) nxt_ = __hip_atomic_fetch_add(qw, 1u, RLX_AGENT);
            for (;;) {
                __syncthreads();
                if (C.tid == 0) MISC[0] = nxt_;
                __syncthreads();
#ifndef DBG_MIXREP
#define DBG_MIXREP 0
#endif
                constexpr int RA = (DBG_MIXREP & 1) ? 2 : 1, RS = (DBG_MIXREP & 2) ? 2 : 1, RL = (DBG_MIXREP & 4) ? 2 : 1;
                int idx = (int)MISC[0];
                if (idx >= RA * NATT + (RS + RL) * NSC) break;
                if (C.tid == 0) nxt_ = __hip_atomic_fetch_add(qw, 1u, RLX_AGENT);
                if (idx < RA * NATT) idx %= NATT; else { idx -= RA * NATT; if (idx < RS * NSC) idx = NATT + idx % NSC; else idx = NATT + NSC + (idx - RS * NSC) % NSC; }
                OPAQUE_CTX(Cu, C)
                if (idx < NATT) { const int j = 15 - idx / (BATCH * NH), bh = idx % (BATCH * NH), b = bh / NH, h = bh % NH;
                    attn_body::attn_unit<8>(b, h, j, WSQ(Cu, half_t, WS_PROJ), WSQ(Cu, half_t, WS_PROJ) + COL_K, WSQ(Cu, half_t, WS_PROJ) + COL_V, WSQ(Cu, half_t, WS_O), WSQ(Cu, float, WS_KMEAN) + (size_t)bh * 16 * 64, WSQ(Cu, float, WS_SSQ), (LAS char*)Cu.lds, Cu.wave); }
                else if (idx < NATT + NSC) { const int u = idx - NATT; s5_unit<true>(Cu, l, u / NCH, u % NCH); }
                else { const int u = idx - NATT - NSC; lru_final_unit(Cu, l, u / NCH, u % NCH); }
            }
        PH_END
#if defined(DBG_CHECK) && DBG_CHECK == 1
        if (l == 0) { PH_BEGIN dbg_attn_check(C); PH_END  PH_BEGIN dbg_emit(C, (float*)(GAS float*)(unsigned long long)karg(I_OUT)); PH_END }
#endif
#if defined(DBG_CHECK) && DBG_CHECK == 5
        if (l == 0) { PH_BEGIN dbg_attn_check2(C, l); PH_END  PH_BEGIN dbg_emit(C, (float*)(GAS float*)(unsigned long long)karg(I_OUT)); PH_END }
#endif
#if defined(DBG_CHECK) && DBG_CHECK == 4
        if (l == 0) { PH_BEGIN dbg_meansq(C, DBG_C0); PH_END  PH_BEGIN dbg_emit(C, (float*)(GAS float*)(unsigned long long)karg(I_OUT)); PH_END }
#endif
#if defined(DBG_CHECK) && DBG_CHECK == 3
        if (l == 0) { PH_BEGIN dbg_attn_check2(C, l); PH_END  PH_BEGIN dbg_emit(C, (float*)(GAS float*)(unsigned long long)karg(I_OUT)); PH_END }
#endif
        PH_BEGIN
            pg8::Gemm g{WSP(half_t, WS_O), WSP(half_t, WS_WOUT) + (size_t)l * D * D, M, D, D, nullptr, WSP(float, WS_SSQ), 6}; pg8::StaticOrder S; S.init(M, D, C.G, C.bid);
            if (l == 0) { EpiResidT<float> E{KARG(float, I_X), xres, modl + 2048, 1.f}; pg8::gemm_phase<EpiResidT<float>, pg8::StaticOrder, true, true, false>(C.lds, g, S, E, C.wave); }
            else { EpiResidT<half_t> E{xres, xres, modl + 2048, 1.f}; pg8::gemm_phase<EpiResidT<half_t>, pg8::StaticOrder, true, true, false>(C.lds, g, S, E, C.wave); }
        PH_END
#if defined(DBG_CHECK) && DBG_CHECK == 6
        if (l == 0) { PH_BEGIN dbg_out_check(C, l, KARG(float, I_X), xres); PH_END  PH_BEGIN dbg_emit(C, (float*)(GAS float*)(unsigned long long)karg(I_OUT)); PH_END }
#endif
        if (l == 0) {
            PH_BEGIN row_pass_xn<false, DENSE_FP8 != 0>(C, xres, WSP(float, PAR_N2G), modl + 3072, modl + 4096, WSP(half_t, WS_XN), nullptr, nullptr); PH_END
            PH_BEGIN
#if DENSE_FP8
                pg8::Gemm g{WSP(unsigned char, WS_XN), WSP(unsigned char, WS_WGU), M, 2 * FF, D, nullptr, nullptr, 0}; pg8::StaticOrder S; S.init(M, 2 * FF, C.G, C.bid);
                EpiSwiglu8 E{WSP(unsigned char, WS_HID), FF, 1.f / 32.f};
                pg8::gemm_phase<EpiSwiglu8, pg8::StaticOrder, true, true, false, true>(C.lds, g, S, E, C.wave);
#else
                pg8::Gemm g{WSP(half_t, WS_XN), WSP(half_t, WS_WGU), M, 2 * FF, D, nullptr, nullptr, 0}; pg8::StaticOrder S; S.init(M, 2 * FF, C.G, C.bid);
                EpiSwiglu E{WSP(half_t, WS_HID), FF};
                pg8::gemm_phase<EpiSwiglu, pg8::StaticOrder, true, true, false>(C.lds, g, S, E, C.wave);
#endif
            PH_END
            PH_BEGIN
#if DENSE_FP8
                pg8::Gemm g{WSP(unsigned char, WS_HID), WSP(unsigned char, WS_WD), M, D, FF, nullptr, nullptr, 0}; pg8::StaticOrder S; S.init(M, D, C.G, C.bid);
                EpiResidT<half_t> E{xres, xres, modl + 5120, 1.f / 64.f};
                pg8::gemm_phase<EpiResidT<half_t>, pg8::StaticOrder, true, true, false, true>(C.lds, g, S, E, C.wave);
#else
                pg8::Gemm g{WSP(half_t, WS_HID), WSP(half_t, WS_WD), M, D, FF, nullptr, nullptr, 0}; pg8::StaticOrder S; S.init(M, D, C.G, C.bid);
                EpiResidT<half_t> E{xres, xres, modl + 5120, 1.f};
                pg8::gemm_phase<EpiResidT<half_t>, pg8::StaticOrder, true, true, false>(C.lds, g, S, E, C.wave);
#endif
            PH_END
            PH_BEGIN row_pass_xn<false>(C, xres, WSP(float, PAR_N1G) + D, mod + 8 * 6144 + 0, mod + 8 * 6144 + 1024, WSP(half_t, WS_XN), nullptr, nullptr); PH_END
        } else {
            PH_BEGIN
                LAS unsigned* lcnt = (LAS unsigned*)C.lds;
                __syncthreads(); if (C.tid < 8) lcnt[C.tid] = 0u; __syncthreads();
                row_pass_xn<true>(C, xres, WSP(float, PAR_N2G) + D, modl + 3072, modl + 4096, (half_t*)WSP(unsigned char, WS_XN8), WSP(float, PAR_ROUTER), lcnt);
                __syncthreads(); if (C.tid < 8) WSP(int, MO_BLKCNT)[C.bid * 8 + C.tid] = (int)lcnt[C.tid];
            PH_END
            PH_BEGIN moe_lists(C); PH_END
            for (int ch = 0; ch < MOE_NCHUNK; ++ch) {
                PH_BEGIN
                    const int NT = (int)__hip_atomic_load((gu32*)(ctl + CW_NT), RLX_AGENT); const int nt0 = NT > MOE_REG_TILES ? NT - MOE_REG_TILES : NT; const int t0 = ch == 0 ? 0 : nt0; const int nt = ch == 0 ? nt0 : NT - nt0;
#ifdef DBG_MOE_UP_COPY
                    if (nt > 0) { const int* st = WSP(int, MO_SLOTTOK) + t0 * 256; half_t* H = WSP(half_t, WS_HID); const half_t* X = WSP(half_t, WS_XN);
                        for (size_t i = (size_t)C.bid * 512 + C.tid; i < (size_t)nt * 256 * FFE; i += (size_t)C.G * 512) { const int r = (int)(i / FFE), k = (int)(i % FFE); H[i] = X[(size_t)st[r] * D + (k & 1023)] * (half_t)0.05f; } }
                    if (false) {
#else
                    if (nt > 0) {
#endif
#ifdef DBG_NOGATHER
                        pg8::Gemm g{WSP(half_t, WS_XN) + (size_t)((t0 * 256) % 16384) * D, WSP(half_t, WS_MGU), nt * 256, 2 * FFE, D, nullptr};
                        pg8::MoeOrder S; S.so.init(nt * 256, 2 * FFE, C.G, C.bid); S.texp = WSP(int, MO_TEXP) + t0; S.nNe = 2 * FFE / 256;
                        EpiSwiglu E{WSP(half_t, WS_HID), FFE};
                        pg8::gemm_phase<EpiSwiglu, pg8::MoeOrder, true, true, false>(C.lds, g, S, E, C.wave);
#else
                        int T = 0;
                        if (ch == 1 && nt0 > MOE_REG_TILES) {
                            const int ntt = nt0 - MOE_REG_TILES; T = ntt * 4;
                            pg8::Gemm g{WSP(unsigned char, WS_HID) + (size_t)MOE_REG_TILES * 256 * FFE, WSP(unsigned char, WS_MD), ntt * 256, D, FFE, nullptr, nullptr, 0};
                            pg8::MoeOrder S; S.so.init(ntt * 256, D, C.G, C.bid); S.texp = WSP(int, MO_TEXP) + MOE_REG_TILES; S.nNe = D / 256;
                            EpiY E{WSP(half_t, WS_Y) + (size_t)MOE_REG_TILES * 256 * D, 1.f / 64.f};
                            pg8::gemm_phase<EpiY, pg8::MoeOrder, true, true, false, true>(C.lds, g, S, E, C.wave);
                        }
                        pg8::Gemm g{WSP(unsigned char, WS_XG8) + (size_t)t0 * 256 * D, WSP(unsigned char, WS_MGU), nt * 256, 2 * FFE, D, nullptr, nullptr, 0};
                        pg8::MoeSkewOrder S; S.so.init(nt * 256, 2 * FFE, C.G, C.bid); S.texp = WSP(int, MO_TEXP) + t0; S.nNe = 2 * FFE / 256; S.T = T;
                        EpiSwiglu8 E{WSP(unsigned char, WS_HID), FFE, 1.f / 32.f};
                        pg8::gemm_phase<EpiSwiglu8, pg8::MoeSkewOrder, true, true, false, true>(C.lds, g, S, E, C.wave);
#endif
                    }
                PH_END
#if defined(DBG_CHECK) && DBG_CHECK == 10
                if (ch == 0) { PH_BEGIN dbg_moeup_check(C); PH_END  PH_BEGIN dbg_emit(C, (float*)(GAS float*)(unsigned long long)karg(I_OUT)); PH_END }
#endif
                PH_BEGIN
                    const int NT = (int)__hip_atomic_load((gu32*)(ctl + CW_NT), RLX_AGENT); const int nt0 = NT > MOE_REG_TILES ? NT - MOE_REG_TILES : NT; const int t0 = ch == 0 ? 0 : nt0; const int nt = ch == 0 ? nt0 : NT - nt0;
#ifdef DBG_MOE_DOWN_COPY
                    if (nt > 0) { const half_t* H = WSP(half_t, WS_HID); half_t* Yc = WSP(half_t, WS_Y) + (size_t)t0 * 256 * D;
                        for (size_t i = (size_t)C.bid * 512 + C.tid; i < (size_t)nt * 256 * D; i += (size_t)C.G * 512) { const int r = (int)(i / D), k = (int)(i % D); Yc[i] = H[(size_t)r * FFE + k] + H[(size_t)r * FFE + 1024 + k] + H[(size_t)r * FFE + 2048 + k]; } }
                    if (false) {
#else
                    if (nt > 0) {
#endif
                        const int ntr = nt > MOE_REG_TILES ? MOE_REG_TILES : nt;
                        pg8::Gemm g{WSP(unsigned char, WS_HID), WSP(unsigned char, WS_MD), ntr * 256, D, FFE, nullptr, nullptr, 0};
                        pg8::MoeOrder S; S.so.init(ntr * 256, D, C.G, C.bid); S.texp = WSP(int, MO_TEXP) + t0; S.nNe = D / 256;
                        EpiY E{WSP(half_t, WS_Y) + (size_t)t0 * 256 * D, 1.f / 64.f};
                        pg8::gemm_phase<EpiY, pg8::MoeOrder, true, true, false, true>(C.lds, g, S, E, C.wave);
                    }
                PH_END
            }
            PH_BEGIN row_pass_final(C, xres, (float*)(GAS float*)(unsigned long long)karg(I_OUT), modl + 5120, WSP(float, PAR_FG)); PH_END
        }
    }
#ifdef DBG_EXTRABAR
    for (int eb_ = 0; eb_ < DBG_EXTRABAR; ++eb_) { XcdBarrier b4_ = bar; asm volatile("" : "+s"(b4_.bar)); xcd_barrier(b4_); }
#endif
#ifdef DBG_SNAP
    constexpr size_t SNAP_OFF = 553 * MiB, SNAP_N = 4u << 20;
#ifndef DBG_IDX
#define DBG_IDX(i) ((i) * DBG_STRIDE)
#endif
#if DBG_SRC_MIB < 0
    const unsigned* dsrc = (const unsigned*)xres;
#else
    const unsigned* dsrc = WSP(unsigned, (size_t)DBG_SRC_MIB * MiB);
#endif
    PH_BEGIN { unsigned* snap = WSP(unsigned, SNAP_OFF); for (size_t i = (size_t)C.bid * 512 + C.tid; i < SNAP_N; i += (size_t)C.G * 512) snap[i] = dsrc[DBG_IDX(i)]; } PH_END
    PH_BEGIN if (C.bid == 0 && C.tid == 0) { __hip_atomic_store(ctl + CW_Q0, 0u, RLX_AGENT); __hip_atomic_store(ctl + CW_Q1, 0u, RLX_AGENT); } PH_END
    PH_BEGIN { const unsigned* snap = WSP(unsigned, SNAP_OFF); float* acc = (float*)(ctl + 256); float cnt = 0.f;
               for (size_t i = (size_t)C.bid * 512 + C.tid; i < SNAP_N; i += (size_t)C.G * 512) cnt += (snap[i] != dsrc[DBG_IDX(i)]) ? 1.f : 0.f;
               cnt = wave_sum(cnt); if (C.lane == 0 && cnt > 0.f) atomicAdd(acc, cnt);
               if (C.bid == 0 && C.tid == 0) atomicAdd(acc + 1, 1.f); } PH_END
    PH_BEGIN dbg_emit(C, (float*)(GAS float*)(unsigned long long)karg(I_OUT)); PH_END
#endif
#undef PH_BEGIN
#undef PH_END
}

extern "C" void kernel_launch(void* const* d_in, const int* in_sizes, int n_in, void* d_out, int out_size, void* d_ws, size_t ws_size, hipStream_t stream) {
    static int grid = 0;
    if (grid == 0) {
        if (n_in != 35 || in_sizes[0] != M * D || out_size != M * D || ws_size < WS_END + DBG_EXTRA_WS) { fprintf(stderr, "kernel_launch: unexpected problem (n_in %d, in0 %d, out %d, ws %zu < %zu)\n", n_in, n_in > 0 ? in_sizes[0] : -1, out_size, ws_size, (size_t)WS_END); grid = -1; return; }
        int dev = 0, cus = 0, per_cu = 0;
        if (hipGetDevice(&dev) != hipSuccess || hipDeviceGetAttribute(&cus, hipDeviceAttributeMultiprocessorCount, dev) != hipSuccess) { grid = -1; return; }
        if (hipFuncSetAttribute((const void*)mk_fwd, hipFuncAttributeMaxDynamicSharedMemorySize, LDS_BYTES) != hipSuccess) { fprintf(stderr, "kernel_launch: hipFuncSetAttribute failed\n"); grid = -1; return; }
        if (hipOccupancyMaxActiveBlocksPerMultiprocessor(&per_cu, (const void*)mk_fwd, NWAVES * 64, LDS_BYTES) != hipSuccess || per_cu < 1) { fprintf(stderr, "kernel_launch: occupancy query says %d blocks per CU\n", per_cu); grid = -1; (void)hipGetLastError(); return; }
        (void)hipGetLastError();
        if (cus < 256) { fprintf(stderr, "kernel_launch: needs 256 CUs\n"); grid = -1; return; }
        grid = 256;
    }
    if (grid < 0) return;
    if (hipMemsetAsync((char*)d_ws + WS_CTL, 0, CTL_ZERO_BYTES, stream) != hipSuccess) return;
    Args a{};
    for (int i = 0; i < 35; ++i) a.in[i] = d_in[i];
    a.out = (float*)d_out; a.ws = (unsigned char*)d_ws;
#ifndef DBG_PH_HI
#define DBG_PH_HI NPHASE
#endif
#if MK_N_LAUNCHES == 1
    a.ph_lo = 0; a.ph_hi = DBG_PH_HI;
    hipLaunchKernelGGL(mk_fwd, dim3(grid), dim3(NWAVES * 64), LDS_BYTES, stream, a);
#else
#ifdef DBG_PHLIST
    { static const int plist[] = {DBG_PHLIST}; for (int i = 0; i < (int)(sizeof(plist) / sizeof(int)); ++i) { a.ph_lo = plist[i]; a.ph_hi = plist[i] + 1; hipLaunchKernelGGL(mk_fwd, dim3(grid), dim3(NWAVES * 64), LDS_BYTES, stream, a); } }
#else
    for (int p = 0; p < DBG_PH_HI; ++p) { a.ph_lo = p; a.ph_hi = p + 1; hipLaunchKernelGGL(mk_fwd, dim3(grid), dim3(NWAVES * 64), LDS_BYTES, stream, a); }
#endif
#endif
}
```

```cpp
#include <hip/hip_runtime.h>
#include <cstdio>
#include <cstdint>
#include <cmath>

#ifndef DENSE_FP8
#define DENSE_FP8 1
#endif
#define GAS __attribute__((address_space(1)))
#define LAS __attribute__((address_space(3)))
typedef _Float16 half_t;
typedef _Float16 h8 __attribute__((ext_vector_type(8)));
typedef _Float16 h4 __attribute__((ext_vector_type(4)));
typedef _Float16 h2 __attribute__((ext_vector_type(2)));
typedef float f32x4 __attribute__((ext_vector_type(4)));
typedef float f32x2 __attribute__((ext_vector_type(2)));
typedef float f32x16 __attribute__((ext_vector_type(16)));
typedef unsigned u32x4 __attribute__((ext_vector_type(4)));
typedef unsigned u32x2 __attribute__((ext_vector_type(2)));
typedef short s16x8 __attribute__((ext_vector_type(8)));
typedef short s16x4 __attribute__((ext_vector_type(4)));
typedef int v8i_t __attribute__((ext_vector_type(8)));

constexpr int BATCH = 8, SEQ = 4096, M = BATCH * SEQ, D = 1024, NH = 6, HD = 64;
constexpr int NPROJ = 2176, NPROJ_PAD = 2304;
constexpr int COL_K = 384, COL_V = 768, COL_XR = 1152, COL_GT = 1536, COL_U = 1920;
constexpr int FF = 2816, FFE = 3584, NE = 8;
constexpr int LRU_W = 384, S5_W = 256, S5_G = 16, S5_P = 64;
constexpr int CH_T = 64, NCH = SEQ / CH_T;
constexpr float EPS = 1e-6f;
constexpr float C2 = 0.125f * 1.4426950408889634f;
constexpr int MOE_CH_TILES = 136;
constexpr int MOE_REG_TILES = 128;
constexpr int MOE_MAX_TILES = 264;
constexpr int MOE_NCHUNK = 2;
constexpr int MOE_SLOTS = MOE_MAX_TILES * 256;

__device__ __forceinline__ unsigned pk_fp8x4(float a, float b, float c, float d) { int w = __builtin_amdgcn_cvt_pk_fp8_f32(a, b, 0, false); w = __builtin_amdgcn_cvt_pk_fp8_f32(c, d, w, true); return (unsigned)w; }
__device__ __forceinline__ unsigned pkh(float lo, float hi) { f32x2 v = {lo, hi}; h2 h = __builtin_convertvector(v, h2); return __builtin_bit_cast(unsigned, h); }
__device__ __forceinline__ float sigmoidf_(float x) { return __builtin_amdgcn_rcpf(1.f + __expf(-x)); }
__device__ __forceinline__ float siluf_(float x) { return x * sigmoidf_(x); }
__device__ __forceinline__ float gelu_tanh(float x) { const float y = 0.7978845608028654f * (x + 0.044715f * x * x * x); const float t = 1.f - 2.f * __builtin_amdgcn_rcpf(1.f + __expf(2.f * y)); return 0.5f * x * (1.f + t); }
template <int O> __device__ __forceinline__ float xor_lane(float v) {
    if constexpr (O < 32) return __builtin_bit_cast(float, __builtin_amdgcn_ds_swizzle(__builtin_bit_cast(int, v), 0x1f | (O << 10)));
    else { unsigned z_ = 0u; asm volatile("" : "+v"(z_)); const int lane = (int)__builtin_amdgcn_mbcnt_hi(~0u, __builtin_amdgcn_mbcnt_lo(~0u, z_));
        return __builtin_bit_cast(float, __builtin_amdgcn_ds_bpermute((lane ^ 32) << 2, __builtin_bit_cast(int, v))); }
}
#define DPP_ADD(v, ctrl, rmask) ((v) + __builtin_bit_cast(float, __builtin_amdgcn_update_dpp(0, __builtin_bit_cast(int, (v)), (ctrl), (rmask), 0xf, true)))
__device__ __forceinline__ float wave_sum(float v) {
    v = DPP_ADD(v, 0xB1, 0xf);
    v = DPP_ADD(v, 0x4E, 0xf);
    v = DPP_ADD(v, 0x141, 0xf);
    v = DPP_ADD(v, 0x140, 0xf);
    v = DPP_ADD(v, 0x142, 0xa);
    v = DPP_ADD(v, 0x143, 0xc);
    return __builtin_bit_cast(float, __builtin_amdgcn_readlane(__builtin_bit_cast(int, v), 63));
}
#define LDS_WAIT() asm volatile("s_waitcnt lgkmcnt(0)" ::: "memory")
#define VM_WAIT() asm volatile("s_waitcnt vmcnt(0)" ::: "memory")

namespace pg8 {
constexpr int BM = 256, BK = 64, HALF = 128, HTB = HALF * BK * 2, STAGE_BYTES = 8 * HTB, NXCD = 8, WGM = 8;
__host__ __device__ __forceinline__ int lds_byte(int r, int c) { const int st = (r >> 4) * 2 + (c >> 5), rr = r & 15, cc = c & 31, ob = rr * 64 + cc * 2; return st * 1024 + (ob ^ (((ob >> 9) & 1) << 5)); }
__host__ __device__ __forceinline__ void stage_rc(int b, int& R, int& C) { const int st = b / 1024, sb = b % 1024, swz = sb ^ (((sb >> 9) & 1) << 5); R = (st >> 1) * 16 + swz / 64; C = (st & 1) * 32 + (swz % 64) / 2; }
__host__ __device__ __forceinline__ int perm32(int rho) { const int n = rho >> 4, i = rho & 15; return 8 * (i >> 2) + 4 * n + (i & 3); }

struct Unit { int pm, pn, pb; };
struct Gemm { const void* A; const void* Bt; int M, N, K; const int* gidx; const float* ssq; int midk; };

struct StaticOrder {
    int nM, nN, nwg, G, c;
    __host__ __device__ void init(int M_, int N_, int G_, int c_) { nM = M_ / BM; nN = N_ / BM; nwg = nM * nN; G = G_; c = c_; }
    __host__ __device__ bool next(int i, Unit& u) const { return at((long)i * G + c, u); }
    __host__ __device__ bool at(long L, Unit& u) const {
        if (L >= nwg) return false;
        int wgid = (int)L; { const int q = nwg / NXCD, r = nwg % NXCD, xcd = wgid % NXCD, off = wgid / NXCD; wgid = (xcd < r ? xcd * (q + 1) : r * (q + 1) + (xcd - r) * q) + off; }
        const int nig = WGM * nN, gid = wgid / nig, fm = gid * WGM, gsz = (nM - fm) < WGM ? (nM - fm) : WGM;
        u.pm = fm + ((wgid % nig) % gsz); u.pn = (wgid % nig) / gsz; u.pb = u.pn; return true;
    }
};
struct MoeOrder {
    StaticOrder so; const int* texp; int nNe;
#ifdef DBG_NOTEXP
    __device__ bool next(int i, Unit& u) const { if (!so.next(i, u)) return false; u.pb = (u.pm & 7) * nNe + u.pn; return true; }
#else
    __device__ bool next(int i, Unit& u) const { if (!so.next(i, u)) return false; const int e = texp[u.pm]; u.pb = e * nNe + u.pn; return true; }
#endif
};

struct MoeSkewOrder {
    static constexpr int LATE = 3;
    StaticOrder so; const int* texp; int nNe, T;
    __device__ bool next(int i, Unit& u) const {
        const int c = so.c, G = so.G; long L;
        if (c < T) L = (long)LATE * (G - T) + (long)i * G + c;
        else L = i < LATE ? (long)i * (G - T) + (c - T) : (long)LATE * (G - T) + (long)(i - LATE) * G + c;
        if (!so.at(L, u)) return false; const int e = texp[u.pm]; u.pb = e * nNe + u.pn; return true; }
};

template <class Epi, class Sched, bool ALIGN_EPI, bool SP2, bool GATHER, bool FP8 = false>
__device__ __forceinline__ void gemm_phase(LAS unsigned char* lds, const Gemm g, const Sched& S, const Epi& E, int wave_) {
    unsigned z_ = 0u; asm volatile("" : "+v"(z_)); int tid_ = wave_ * 64 + (int)__builtin_amdgcn_mbcnt_hi(~0u, __builtin_amdgcn_mbcnt_lo(~0u, z_));
    const int tid = tid_, wid = wave_, lane = tid & 63, wr = wid >> 2, wc = wid & 3, fr = lane & 15, fq = lane >> 4;
    constexpr int EB = FP8 ? 1 : 2;
    int K_ = g.K; asm volatile("" : "+s"(K_));
    const int K = K_, nt = K * EB / (BK * 2);
    unsigned voffA[2], voffB[2]; int RA[2], CA[2];
#pragma unroll
    for (int i = 0; i < 2; ++i) { int R, C; stage_rc(tid * 16 + i * 8192, R, C); const int Rb = Epi::PERM ? ((R & ~31) + perm32(R & 31)) : R;
        voffA[i] = (unsigned)(R * K * EB + C * 2); voffB[i] = (unsigned)(Rb * K * EB + C * 2); RA[i] = R; CA[i] = C; }
    const size_t kstep = (size_t)(BK * 2);
    const size_t hstep = (size_t)HALF * K * EB;
    const size_t tstep = 2 * hstep;
    const unsigned ldsw = (unsigned)wid * 1024u;
    const int aoff = lds_byte(wr * 64 + fr, fq * 8), boff = lds_byte(wc * 32 + fr, fq * 8);
    const int aoff8a = lds_byte(wr * 64 + fr, 16 * fq), boff8a = lds_byte(wc * 32 + fr, 16 * fq); constexpr int aoff8b = 16, boff8b = 16;
    unsigned offC[2][2], offN[2][2];
#define PG8_SA(b, h) (((b) * 2 + (h)) * HTB)
#define PG8_SB(b, h) ((4 + (b) * 2 + (h)) * HTB)
#define PG8_GLDS(gp, lp) __builtin_amdgcn_global_load_lds((const unsigned*)(gp), (LAS unsigned*)(lp), 16, 0, 0)
#define PG8_STAGE(bufoff, gbase, voff) do { _Pragma("unroll") for (int _i = 0; _i < 2; ++_i) PG8_GLDS((const char*)(gbase) + (voff)[_i], lds + (bufoff) + ldsw + _i * 8192); } while (0)
#define PG8_STAGE_A(bufoff, gbase, hh, nx) do { if constexpr (GATHER) { _Pragma("unroll") for (int _i = 0; _i < 2; ++_i) { const unsigned _o = (nx) ? offN[hh][_i] : offC[hh][_i]; PG8_GLDS((const char*)(gbase) + _o, lds + (bufoff) + ldsw + _i * 8192); } } \
        else { PG8_STAGE(bufoff, (gbase) + (hh) * hstep, voffA); } } while (0)
#define PG8_LD32(p0, p1) __builtin_bit_cast(v8i_t, __builtin_shufflevector(*(const LAS u32x4*)(p0), *(const LAS u32x4*)(p1), 0, 1, 2, 3, 4, 5, 6, 7))
#define PG8_LDA(dst, b, h) do { if constexpr (FP8) { _Pragma("unroll") for (int m = 0; m < 4; ++m) dst##8[m] = PG8_LD32(lds + PG8_SA(b, h) + aoff8a + m * 2048, lds + PG8_SA(b, h) + aoff8a + aoff8b + m * 2048); } \
        else { _Pragma("unroll") for (int m = 0; m < 4; ++m) _Pragma("unroll") for (int k = 0; k < 2; ++k) dst[m][k] = *(const LAS h8*)(lds + PG8_SA(b, h) + aoff + m * 2048 + k * 1024); } } while (0)
#define PG8_LDB(dst, b, h) do { if constexpr (FP8) { _Pragma("unroll") for (int n = 0; n < 2; ++n) dst##8[n] = PG8_LD32(lds + PG8_SB(b, h) + boff8a + n * 2048, lds + PG8_SB(b, h) + boff8a + boff8b + n * 2048); } \
        else { _Pragma("unroll") for (int n = 0; n < 2; ++n) _Pragma("unroll") for (int k = 0; k < 2; ++k) dst[n][k] = *(const LAS h8*)(lds + PG8_SB(b, h) + boff + n * 2048 + k * 1024); } } while (0)
#define PG8_MMA(ai, bj, At, Bt) do { __builtin_amdgcn_s_setprio(1); if constexpr (FP8) { _Pragma("unroll") for (int m = 0; m < 4; ++m) _Pragma("unroll") for (int n = 0; n < 2; ++n) \
        asm volatile("v_mfma_f32_16x16x128_f8f6f4 %0, %1, %2, %0" : "+v"(acc[ai][bj][m][n]) : "v"(Bt##8[n]), "v"(At##8[m])); PG8_FP8_PAD } \
        else { _Pragma("unroll") for (int m = 0; m < 4; ++m) _Pragma("unroll") for (int n = 0; n < 2; ++n) _Pragma("unroll") for (int k = 0; k < 2; ++k) \
        acc[ai][bj][m][n] = __builtin_amdgcn_mfma_f32_16x16x32_f16(Bt[n][k], At[m][k], acc[ai][bj][m][n], 0, 0, 0); } __builtin_amdgcn_s_setprio(0); } while (0)
#ifdef DBG_DRAIN
#define PG8_WAIT_V(n) asm volatile("s_waitcnt vmcnt(0)" ::: "memory")
#else
#define PG8_WAIT_V(n) asm volatile("s_waitcnt vmcnt(" #n ")" ::: "memory")
#endif
#ifdef DBG_FP8PAD
#define PG8_FP8_PAD asm volatile("s_nop 15\n\ts_nop 15\n\ts_nop 15\n\ts_nop 15\n\ts_nop 15" ::: "memory");
#else
#define PG8_FP8_PAD
#endif
#define PG8_WAIT_L(n) asm volatile("s_waitcnt lgkmcnt(" #n ")" ::: "memory")
#define PG8_BAR __builtin_amdgcn_s_barrier()
#define PG8_SCHED __builtin_amdgcn_sched_barrier(0)
#define PG8_GOFF(dst, u_) do { if constexpr (GATHER) { _Pragma("unroll") for (int _h = 0; _h < 2; ++_h) _Pragma("unroll") for (int _i = 0; _i < 2; ++_i) \
        dst[_h][_i] = (unsigned)(((const GAS int*)g.gidx)[(u_).pm * BM + _h * HALF + RA[_i]] * K * EB + CA[_i] * 2); } } while (0)
    Unit cur, nxt; int ui = 0;
    if (!S.next(0, cur)) return;
    f32x4 acc[2][2][4][2];
#pragma unroll
    for (int a = 0; a < 2; ++a)
#pragma unroll
        for (int b = 0; b < 2; ++b)
#pragma unroll
            for (int m = 0; m < 4; ++m)
#pragma unroll
                for (int n = 0; n < 2; ++n) acc[a][b][m][n] = (f32x4){0.f, 0.f, 0.f, 0.f};
    h8 At[4][2], B0[2][2], B1[2][2];
    v8i_t At8[4], B08[2], B18[2];
    PG8_GOFF(offC, cur);
#pragma unroll
    for (int _h = 0; _h < 2; ++_h)
#pragma unroll
        for (int _i = 0; _i < 2; ++_i) offN[_h][_i] = offC[_h][_i];
    const char* cA = GATHER ? (const char*)g.A : (const char*)g.A + (size_t)cur.pm * tstep; const char* cB = (const char*)g.Bt + (size_t)cur.pb * tstep;
    if constexpr (SP2) {
        PG8_STAGE(PG8_SB(0, 0), cB, voffB); PG8_STAGE(PG8_SB(0, 1), cB + hstep, voffB); PG8_STAGE_A(PG8_SA(0, 0), cA, 0, false); PG8_STAGE_A(PG8_SA(0, 1), cA, 1, false);
        if (wr == 1) PG8_BAR;
        PG8_WAIT_V(2); PG8_BAR;
        PG8_STAGE(PG8_SB(1, 0), cB + kstep, voffB); PG8_STAGE_A(PG8_SA(1, 0), cA + kstep, 0, false); PG8_STAGE(PG8_SB(1, 1), cB + hstep + kstep, voffB);
        PG8_WAIT_V(6); PG8_BAR;
    } else {
        PG8_STAGE(PG8_SB(0, 0), cB, voffB); PG8_STAGE_A(PG8_SA(0, 0), cA, 0, false); PG8_STAGE(PG8_SB(0, 1), cB + hstep, voffB); PG8_STAGE_A(PG8_SA(0, 1), cA, 1, false);
        if (wr == 1) PG8_BAR;
        PG8_WAIT_V(4); PG8_BAR;
        PG8_STAGE(PG8_SB(1, 0), cB + kstep, voffB); PG8_STAGE_A(PG8_SA(1, 0), cA + kstep, 0, false); PG8_STAGE(PG8_SB(1, 1), cB + hstep + kstep, voffB);
        PG8_WAIT_V(6); PG8_BAR;
    }
    for (;;) {
        const bool has_next = S.next(ui + 1, nxt);
        if (g.ssq) {
            LAS float* RS = (LAS float*)(lds + 131072 + 2048);
            if (tid < BM) { const float* sp = g.ssq + (size_t)(cur.pm * BM + tid) * 8; const f32x4 s0 = *(const f32x4*)sp, s1 = *(const f32x4*)(sp + 4);
                RS[tid] = 1.f / sqrtf(((s0[0] + s0[1]) + (s0[2] + s0[3]) + (s1[0] + s1[1])) * (1.f / 384.f) + 1e-6f); } }
        const char* nA = has_next ? (GATHER ? (const char*)g.A : (const char*)g.A + (size_t)nxt.pm * tstep) : cA; const char* nB = has_next ? (const char*)g.Bt + (size_t)nxt.pb * tstep : cB;
#pragma nounroll
        for (int t = 0; t < nt; t += 2) {
#ifndef DBG_NOHOOK
            if (g.ssq && t == g.midk)
#else
            if (false)
#endif
            {
#pragma unroll
                for (int ai = 0; ai < 2; ++ai)
#pragma unroll
                    for (int m = 0; m < 4; ++m) { const float rs = ((const LAS float*)(lds + 131072 + 2048))[ai * HALF + wr * 64 + m * 16 + fr];
#pragma unroll
                        for (int bj = 0; bj < 2; ++bj)
#pragma unroll
                            for (int n = 0; n < 2; ++n) acc[ai][bj][m][n] = acc[ai][bj][m][n] * rs; } }
            const bool last = (t == nt - 2);
            const char* a1 = cA + (size_t)(t + 1) * kstep;
            const char* a2 = last ? nA : cA + (size_t)(t + 2) * kstep; const char* b2 = last ? nB : cB + (size_t)(t + 2) * kstep;
            const char* a3 = a2 + kstep; const char* b3 = b2 + kstep;
            if constexpr (SP2) {
            PG8_LDB(B0, 0, 0); PG8_LDB(B1, 0, 1); PG8_SCHED; PG8_LDA(At, 0, 0); PG8_STAGE_A(PG8_SA(1, 1), a1, 1, false);
            PG8_WAIT_V(8); PG8_WAIT_L(0); PG8_BAR; PG8_MMA(0, 0, At, B0); PG8_MMA(0, 1, At, B1); PG8_BAR; PG8_SCHED;
            PG8_LDA(At, 0, 1); PG8_STAGE(PG8_SB(0, 0), b2, voffB); PG8_STAGE(PG8_SB(0, 1), b2 + hstep, voffB); PG8_STAGE_A(PG8_SA(0, 0), a2, 0, last);
            PG8_WAIT_V(8); PG8_WAIT_L(0); PG8_BAR; PG8_MMA(1, 0, At, B0); PG8_MMA(1, 1, At, B1); PG8_BAR; PG8_SCHED;
            PG8_LDB(B0, 1, 0); PG8_LDB(B1, 1, 1); PG8_SCHED; PG8_LDA(At, 1, 0); PG8_STAGE_A(PG8_SA(0, 1), a2, 1, last);
            PG8_WAIT_V(8); PG8_WAIT_L(0); PG8_BAR; PG8_MMA(0, 0, At, B0); PG8_MMA(0, 1, At, B1); PG8_BAR; PG8_SCHED;
            PG8_LDA(At, 1, 1); PG8_STAGE(PG8_SB(1, 0), b3, voffB); PG8_STAGE(PG8_SB(1, 1), b3 + hstep, voffB); PG8_STAGE_A(PG8_SA(1, 0), a3, 0, last);
            PG8_WAIT_V(8); PG8_WAIT_L(0); PG8_BAR; PG8_MMA(1, 0, At, B0); PG8_MMA(1, 1, At, B1); PG8_BAR; PG8_SCHED;
            } else {
            PG8_LDB(B0, 0, 0); PG8_SCHED; PG8_LDA(At, 0, 0); PG8_STAGE_A(PG8_SA(1, 1), a1, 1, false);
            PG8_WAIT_L(8); PG8_BAR; PG8_WAIT_L(0); PG8_MMA(0, 0, At, B0); PG8_BAR; PG8_SCHED;
            PG8_LDB(B1, 0, 1); PG8_STAGE(PG8_SB(0, 0), b2, voffB);
            PG8_BAR; PG8_WAIT_L(0); PG8_MMA(0, 1, At, B1); PG8_BAR;
            PG8_LDA(At, 0, 1); PG8_STAGE_A(PG8_SA(0, 0), a2, 0, last);
            PG8_BAR; PG8_WAIT_L(0); PG8_MMA(1, 0, At, B0); PG8_BAR; PG8_SCHED;
            PG8_STAGE(PG8_SB(0, 1), b2 + hstep, voffB);
            PG8_WAIT_V(6); PG8_BAR; PG8_MMA(1, 1, At, B1); PG8_BAR;
            PG8_LDB(B0, 1, 0); PG8_SCHED; PG8_LDA(At, 1, 0); PG8_STAGE_A(PG8_SA(0, 1), a2, 1, last);
            PG8_WAIT_L(8); PG8_BAR; PG8_WAIT_L(0); PG8_MMA(0, 0, At, B0); PG8_BAR; PG8_SCHED;
            PG8_LDB(B1, 1, 1); PG8_STAGE(PG8_SB(1, 0), b3, voffB);
            PG8_BAR; PG8_WAIT_L(0); PG8_MMA(0, 1, At, B1); PG8_BAR;
            PG8_LDA(At, 1, 1); PG8_STAGE_A(PG8_SA(1, 0), a3, 0, last);
            PG8_BAR; PG8_WAIT_L(0); PG8_MMA(1, 0, At, B0); PG8_BAR; PG8_SCHED;
            PG8_STAGE(PG8_SB(1, 1), b3 + hstep, voffB);
            PG8_WAIT_V(6); PG8_BAR; PG8_MMA(1, 1, At, B1); PG8_BAR;
            }
        }
        if constexpr (ALIGN_EPI) { if (wr == 0) PG8_BAR; }
        if constexpr (FP8) asm volatile("s_nop 15\n\ts_nop 15" ::: "memory");
        E(acc, cur, wr, wc, fr, fq);
        if (!has_next) break;
#pragma unroll
        for (int a = 0; a < 2; ++a)
#pragma unroll
            for (int b = 0; b < 2; ++b)
#pragma unroll
                for (int m = 0; m < 4; ++m)
#pragma unroll
                    for (int n = 0; n < 2; ++n) acc[a][b][m][n] = (f32x4){0.f, 0.f, 0.f, 0.f};
        cur = nxt; cA = nA; cB = nB; ++ui;
#pragma unroll
        for (int _h = 0; _h < 2; ++_h)
#pragma unroll
            for (int _i = 0; _i < 2; ++_i) offC[_h][_i] = offN[_h][_i];
        if constexpr (ALIGN_EPI) { if (wr == 1) PG8_BAR; }
    }
    PG8_WAIT_V(0);
    if constexpr (!ALIGN_EPI) { if (wr == 0) PG8_BAR; }
    PG8_BAR;
#undef PG8_SA
#undef PG8_SB
#undef PG8_GLDS
#undef PG8_STAGE
#undef PG8_STAGE_A
#undef PG8_LDA
#undef PG8_LDB
#undef PG8_MMA
#undef PG8_LD32
#undef PG8_WAIT_V
#undef PG8_WAIT_L
#undef PG8_BAR
#undef PG8_SCHED
#undef PG8_GOFF
}
}

namespace attn_body {
constexpr int D_ = 64;
constexpr int PQ = NPROJ;
constexpr int PO = D;
constexpr int NW = 8, QBLK = 32, QB = QBLK * NW, KVBLK = 64;
__device__ __forceinline__ int crow(int r, int hi) { return (r & 3) + 8 * (r >> 2) + 4 * hi; }
__device__ __forceinline__ constexpr int crow0(int r) { return (r & 3) + 8 * (r >> 2); }
#define SBAR() __builtin_amdgcn_sched_barrier(0)
__device__ __forceinline__ void cmask(f32x16& p0, f32x16& p1, int jb, int qrel, int hi) {
    const float NEG = -INFINITY; int kb = 64 * jb + 4 * hi;
    const int lim = qrel - kb;
#pragma unroll
    for (int r = 0; r < 16; ++r) { if (crow0(r) > lim) p0[r] = NEG; if (crow0(r) + 32 > lim) p1[r] = NEG; }
}
__device__ __forceinline__ void killmask(f32x16& p0, f32x16& p1, bool dead) {
    const float NEG = -INFINITY;
#pragma unroll
    for (int r = 0; r < 16; ++r) { p0[r] = dead ? NEG : p0[r]; p1[r] = dead ? NEG : p1[r]; }
}
constexpr int NSLOT = 3, SLOTB = 8192;
constexpr int LDS_K = 0, LDS_V = NSLOT * SLOTB, LDS_WS = 2 * NSLOT * SLOTB, LDS_OST = LDS_WS + NW * 64 * 4, LDS_BYTES = LDS_OST + NW * 4096;
__device__ __forceinline__ void glds16(const void* gsrc, unsigned lds_dst) { unsigned keep;
    asm volatile("s_mov_b32 %0, m0\n\ts_mov_b32 m0, %2\n\ts_nop 0\n\tglobal_load_lds_dwordx4 %1, off\n\ts_mov_b32 m0, %0" : "=&s"(keep) : "v"(gsrc), "s"(lds_dst) : "memory"); }
__device__ __forceinline__ float max3f(float a, float b, float c) { float r; asm("v_max3_f32 %0, %1, %2, %3" : "=v"(r) : "v"(a), "v"(b), "v"(c)); return r; }
__device__ __forceinline__ float max2f(float a, float b) { float r; asm("v_max_f32_e32 %0, %1, %2" : "=v"(r) : "v"(a), "v"(b)); return r; }
__device__ __forceinline__ float fadd_s(float a, float b) { float r; asm("v_add_f32_e32 %0, %1, %2" : "=v"(r) : "v"(a), "v"(b)); return r; }
__device__ __forceinline__ float fsub_s(float a, float b) { float r; asm("v_sub_f32_e32 %0, %1, %2" : "=v"(r) : "v"(a), "v"(b)); return r; }
__device__ __forceinline__ unsigned cvtpk_s(float lo, float hi) { return pkh(lo, hi); }
#define WAIT_BAR(N) asm volatile("s_waitcnt vmcnt(" #N ") lgkmcnt(0)\n\ts_barrier" ::: "memory")
#define MFMA32(a, b, c) __builtin_amdgcn_mfma_f32_32x32x16_f16(__builtin_bit_cast(h8, a), __builtin_bit_cast(h8, b), c, 0, 0, 0)

__device__ __forceinline__ void qkt(f32x16& p0, f32x16& p1, const LAS char* Kslot, const s16x8* qr, const f32x16& negm, int r32, int hi) {
    const LAS char* kb = Kslot + hi * 1024 + r32 * 16;
#pragma unroll
    for (int d0 = 0; d0 < 4; ++d0) {
        const s16x8 b0 = *(const LAS s16x8*)(kb + d0 * 2048);
        const s16x8 b1 = *(const LAS s16x8*)(kb + d0 * 2048 + 512);
        if (d0 == 0) { p0 = MFMA32(b0, qr[0], negm); p1 = MFMA32(b1, qr[0], negm); }
        else { p0 = MFMA32(b0, qr[d0], p0); p1 = MFMA32(b1, qr[d0], p1); } }
}
typedef __attribute__((address_space(3))) const char* lds_cptr;
typedef short v4i16_t __attribute__((ext_vector_type(4)));
__device__ __forceinline__ void kload8(s16x8* kf, lds_cptr kp) {
    kf[0] = *(const LAS s16x8*)(kp);        kf[1] = *(const LAS s16x8*)(kp + 512);
    kf[2] = *(const LAS s16x8*)(kp + 2048); kf[3] = *(const LAS s16x8*)(kp + 2560);
    kf[4] = *(const LAS s16x8*)(kp + 4096); kf[5] = *(const LAS s16x8*)(kp + 4608);
    kf[6] = *(const LAS s16x8*)(kp + 6144); kf[7] = *(const LAS s16x8*)(kp + 6656);
}
__device__ __forceinline__ void kload2(s16x8* kf, lds_cptr kp, int j) { kf[2 * j] = *(const LAS s16x8*)(kp + j * 2048); kf[2 * j + 1] = *(const LAS s16x8*)(kp + j * 2048 + 512); }
__device__ __forceinline__ s16x4 vtr(lds_cptr p) { return __builtin_bit_cast(s16x4, __builtin_amdgcn_ds_read_tr16_b64_v4i16((LAS v4i16_t*)p)); }
__device__ __forceinline__ float rowmax(const f32x16& p0, const f32x16& p1) {
    float a = max3f(p0[0], p0[1], p1[0]), b = max3f(p0[2], p0[3], p1[1]); a = max3f(a, p1[2], p1[3]);
#pragma unroll
    for (int r = 4; r < 16; r += 4) { a = max3f(a, p0[r], p0[r + 1]); b = max3f(b, p0[r + 2], p0[r + 3]); a = max3f(a, p1[r], p1[r + 1]); b = max3f(b, p1[r + 2], p1[r + 3]); }
    const float m = max2f(a, b);
    auto rr = __builtin_amdgcn_permlane32_swap(__float_as_uint(m), __float_as_uint(m), false, false);
    return max2f(__uint_as_float(rr[0]), __uint_as_float(rr[1]));
}
__device__ __forceinline__ void pv(f32x16* o, int vb, s16x8 pa0, s16x8 pa1, s16x8 pa2, s16x8 pa3) {
#pragma unroll
    for (int d0 = 0; d0 < 2; ++d0) { s16x4 lo[4], hi[4];
#pragma unroll
        for (int ks = 0; ks < 4; ++ks) {
            asm volatile("ds_read_b64_tr_b16 %0,%1 offset:%c2" : "=&v"(lo[ks]) : "v"(vb), "i"(d0 * 4096 + ks * 1024) : "memory");
            asm volatile("ds_read_b64_tr_b16 %0,%1 offset:%c2" : "=&v"(hi[ks]) : "v"(vb), "i"(d0 * 4096 + ks * 1024 + 512) : "memory"); }
        asm volatile("s_waitcnt lgkmcnt(0)" ::: "memory"); SBAR();
#define PK(k) (s16x8){lo[k][0], lo[k][1], lo[k][2], lo[k][3], hi[k][0], hi[k][1], hi[k][2], hi[k][3]}
        o[d0] = MFMA32(pa0, PK(0), o[d0]);
        o[d0] = MFMA32(pa1, PK(1), o[d0]);
        o[d0] = MFMA32(pa2, PK(2), o[d0]);
        o[d0] = MFMA32(pa3, PK(3), o[d0]);
#undef PK
    }
}

template <int THRL> __device__ __forceinline__ void attn_unit(int b, int h, int qb, const half_t* Q, const half_t* __restrict__ K, const half_t* __restrict__ V, half_t* O, const float* __restrict__ kmean, float* __restrict__ ssq, LAS char* shm, int wave_) {
    unsigned z_ = 0u; asm volatile("" : "+v"(z_)); int tid_ = wave_ * 64 + (int)__builtin_amdgcn_mbcnt_hi(~0u, __builtin_amdgcn_mbcnt_lo(~0u, z_));
    const int tid = tid_, lane = tid & 63, r32 = lane & 31, hi = lane >> 5; const int wid = wave_;
    const long rowbase = (long)b * SEQ; const int q0 = qb * QB;
    const half_t* Qw = Q + (rowbase + q0 + wid * QBLK) * PQ + h * D_;
    const half_t* Kh = K + rowbase * PQ + h * D_, *Vh = V + rowbase * PQ + h * D_;
    const unsigned lds0 = (unsigned)(uintptr_t)shm;
    LAS float* wsf = (LAS float*)(shm + LDS_WS) + wid * 64; LAS float* wsfh = wsf + 4 * hi;
    const half_t* ksrc = Kh + (long)lane * PQ + wid * 8;
    const half_t* vsrc = Vh + (long)(16 * (wid & 3) + (lane >> 2)) * PQ + (wid >> 2) * 32 + (lane & 3) * 8;
    const unsigned kdst = lds0 + LDS_K + wid * 1024, vdst = lds0 + LDS_V + wid * 1024;
    const int NT = (q0 + QB) / KVBLK;
#define PHYS(t) (((t) < 4) ? (NT - 4 + (t)) : ((t) - 4))
#define DMA_K(t, slot) glds16(ksrc + (long)PHYS(t) * KVBLK * PQ, (unsigned)__builtin_amdgcn_readfirstlane(kdst + (slot)))
#define DMA_V(t, slot) glds16(vsrc + (long)PHYS(t) * KVBLK * PQ, (unsigned)__builtin_amdgcn_readfirstlane(vdst + (slot)))
    const int vb0 = (int)(lds0 + LDS_V) + ((lane >> 4) & 1) * 32 + (lane & 3) * 8 + (4 * hi + ((lane & 15) >> 2)) * 64;
    const LAS char* Kbase = shm + LDS_K; s16x8 kf[8];
    const lds_cptr shm3 = (lds_cptr)shm; const lds_cptr kp0 = shm3 + LDS_K + hi * 1024 + r32 * 16; const lds_cptr vp0 = shm3 + LDS_V + ((lane >> 4) & 1) * 32 + (lane & 3) * 8 + (4 * hi + ((lane & 15) >> 2)) * 64;
    DMA_K(0, 0); DMA_V(0, 0); DMA_K(1, SLOTB);
    s16x8 qr[4];
#pragma unroll
    for (int d0 = 0; d0 < 4; ++d0) qr[d0] = *reinterpret_cast<const s16x8*>(&Qw[(long)r32 * PQ + d0 * 16 + hi * 8]);
    unsigned pmask = 0u;
    if (qb > 0) {
        float v1 = -INFINITY, v2 = -INFINITY, v3 = -INFINITY; int i1 = 0, i2 = 0, i3 = 0;
        for (int n0 = 0; n0 < qb; n0 += 4) {
            f32x4 ka[4][4], kb2[4][4];
#pragma unroll
            for (int u = 0; u < 4; ++u) { const int n = n0 + u < qb ? n0 + u : qb - 1; const float* km = kmean + n * 64 + hi * 8;
#pragma unroll
                for (int d0 = 0; d0 < 4; ++d0) { ka[u][d0] = *(const f32x4*)(km + d0 * 16); kb2[u][d0] = *(const f32x4*)(km + d0 * 16 + 4); } }
#pragma unroll
            for (int u = 0; u < 4; ++u) { const int n = n0 + u; float gsum = 0.f;
#pragma unroll
                for (int d0 = 0; d0 < 4; ++d0) { const h8 qh = __builtin_bit_cast(h8, qr[d0]);
                    gsum += (float)qh[0] * ka[u][d0][0] + (float)qh[1] * ka[u][d0][1] + (float)qh[2] * ka[u][d0][2] + (float)qh[3] * ka[u][d0][3] + (float)qh[4] * kb2[u][d0][0] + (float)qh[5] * kb2[u][d0][1] + (float)qh[6] * kb2[u][d0][2] + (float)qh[7] * kb2[u][d0][3]; }
                { auto rr = __builtin_amdgcn_permlane32_swap(__float_as_uint(gsum), __float_as_uint(gsum), false, false); gsum = __uint_as_float(rr[0]) + __uint_as_float(rr[1]); }
                if (n < qb) {
                    if (gsum > v1) { v3 = v2; i3 = i2; v2 = v1; i2 = i1; v1 = gsum; i1 = n; }
                    else if (gsum > v2) { v3 = v2; i3 = i2; v2 = gsum; i2 = n; }
                    else if (gsum > v3) { v3 = gsum; i3 = n; } } } }
        pmask = 1u << i1; if (qb >= 2) pmask |= 1u << i2; if (qb >= 3) pmask |= 1u << i3;
    }
    float mhat = 0.f, l_reg = 0.f; f32x16 o[2]; o[0] = f32x16{}; o[1] = f32x16{}; f32x16 negm = f32x16{}; asm volatile("" : "+v"(negm));
    const int qrel = wid * QBLK + r32;
#define CMASK(P0, P1, t) do { if ((t) < 4) cmask(P0, P1, (t), qrel, hi); } while (0)
#define SETNEGM(tn) do { const bool dd_ = ((tn) >= 4) && (((pmask >> (((tn) - 4) >> 2)) & 1u) == 0u); const float nv_ = dd_ ? -INFINITY : -mhat; \
      _Pragma("unroll") for (int r = 0; r < 16; ++r) negm[r] = nv_; asm volatile("" : "+v"(negm)); } while (0)
    bool resc = false;
#define START(P0, P1) do { const float rm = rowmax(P0, P1); resc = false; \
    { const float dl = rm; mhat = fadd_s(mhat, dl); \
      _Pragma("unroll") for (int r = 0; r < 16; ++r) { P0[r] = fsub_s(P0[r], dl); P1[r] = fsub_s(P1[r], dl); } \
      _Pragma("unroll") for (int r = 0; r < 16; ++r) negm[r] = -mhat; asm volatile("" : "+v"(negm)); } \
    _Pragma("unroll") for (int r = 0; r < 16; ++r) P0[r] = __builtin_amdgcn_exp2f(P0[r]); } while (0)
#define RESC() do { if (resc) { asm volatile("s_waitcnt lgkmcnt(0)" ::: "memory"); \
      _Pragma("unroll") for (int d_ = 0; d_ < 2; ++d_) _Pragma("unroll") for (int r = 0; r < 16; ++r) o[d_][r] *= wsfh[crow0(r)]; } } while (0)
    f32x16 pA0, pA1, pB0, pB1;
    int sl_prev = 0, sl_cur = 0, sl_next = SLOTB;
#define ROT() do { sl_prev = sl_cur; sl_cur = sl_next; sl_next = (sl_next == (NSLOT - 1) * SLOTB) ? 0 : sl_next + SLOTB; } while (0)
    DMA_K(2, 2 * SLOTB);
    WAIT_BAR(3);
    qkt(pA0, pA1, Kbase, qr, negm, r32, hi); asm volatile("s_nop 15\n\ts_nop 7" : "+v"(pA0), "+v"(pA1)); CMASK(pA0, pA1, 0);
    START(pA0, pA1);
    _Pragma("unroll") for (int r = 0; r < 16; ++r) pA1[r] = __builtin_amdgcn_exp2f(pA1[r]);
    WAIT_BAR(0);
    DMA_K(3, 0); DMA_V(1, SLOTB);
    ROT();
    kload8(kf, kp0 + sl_cur);
    WAIT_BAR(2);
    s16x4 vlo[8], vhi[8]; u32x4 pw0, pw1, pw2, pw3;
#define PKW(P, B) cvtpk_s(P[B], P[B + 1])
#define PAF(k) __builtin_bit_cast(s16x8, pw##k)
#define VFR(i) (s16x8){vlo[i][0], vlo[i][1], vlo[i][2], vlo[i][3], vhi[i][0], vhi[i][1], vhi[i][2], vhi[i][3]}
#define PIN(x) asm volatile("" : "+v"(x))
#define MX3(a, b, c) __builtin_fmaxf(__builtin_fmaxf((a), (b)), (c))
#define GAPA(MF, A0, A1, A2, A3, W0, W1, PW) do { MF; sacc += A0; sacc += A1; sacc += A2; sacc += A3; PIN(sacc); W0; W1; PIN(PW); SBAR(); } while (0)
#define EX(v) __builtin_amdgcn_exp2f(v)
#define GAPB(MF, X, B) do { MF; X[B] = EX(X[B]); X[B + 1] = EX(X[B + 1]); X[B + 2] = EX(X[B + 2]); X[B + 3] = EX(X[B + 3]); PIN(X); SBAR(); } while (0)
#define VRD(i) do { vlo[i] = vtr(vp_ + (((i) >> 2) * 4096 + ((i) & 3) * 1024)); vhi[i] = vtr(vp_ + (((i) >> 2) * 4096 + ((i) & 3) * 1024 + 512)); } while (0)
#define KRD(G, j) do { if (G) { kload2(kf, kp0 + sl_next, j); SBAR(); } } while (0)
#define STEP(C0, C1, P0, P1, t, GK, GV, GL) do { SBAR(); \
    const lds_cptr vp_ = vp0 + sl_prev; \
    VRD(0); SBAR(); float sacc = (P0[0] + P0[1]); \
    GAPA(C0 = MFMA32(kf[0], qr[0], negm), P0[2], P0[3], P0[4], P0[5],     pw0[0] = PKW(P0, 0), pw0[1] = PKW(P0, 2), pw0); \
    VRD(4); SBAR(); GAPA(C1 = MFMA32(kf[1], qr[0], negm), P0[6], P0[7], P0[8], P0[9],     pw0[2] = PKW(P0, 4), pw0[3] = PKW(P0, 6), pw0); \
    VRD(1); SBAR(); GAPA(C0 = MFMA32(kf[2], qr[1], C0),   P0[10], P0[11], P0[12], P0[13], pw1[0] = PKW(P0, 8), pw1[1] = PKW(P0, 10), pw1); \
    VRD(5); SBAR(); GAPA(C1 = MFMA32(kf[3], qr[1], C1),   P0[14], P0[15], P1[0], P1[1],   pw1[2] = PKW(P0, 12), pw1[3] = PKW(P0, 14), pw1); \
    VRD(2); SBAR(); GAPA(C0 = MFMA32(kf[4], qr[2], C0),   P1[2], P1[3], P1[4], P1[5],     pw2[0] = PKW(P1, 0), pw2[1] = PKW(P1, 2), pw2); \
    VRD(6); SBAR(); GAPA(C1 = MFMA32(kf[5], qr[2], C1),   P1[6], P1[7], P1[8], P1[9],     pw2[2] = PKW(P1, 4), pw2[3] = PKW(P1, 6), pw2); \
    VRD(3); SBAR(); GAPA(C0 = MFMA32(kf[6], qr[3], C0),   P1[10], P1[11], P1[12], P1[13], pw3[0] = PKW(P1, 8), pw3[1] = PKW(P1, 10), pw3); \
    VRD(7); SBAR(); GAPA(C1 = MFMA32(kf[7], qr[3], C1),   P1[14], P1[15], 0.f, 0.f,       pw3[2] = PKW(P1, 12), pw3[3] = PKW(P1, 14), pw3); \
    l_reg += sacc; \
    if (GK) { DMA_K((t) + 3, sl_cur); } if (GV) { DMA_V((t) + 1, sl_next); } \
    CMASK(C0, C1, t); \
    { float a = MX3(C0[0], C0[1], C1[0]), b = MX3(C0[2], C0[3], C1[1]); a = MX3(a, C1[2], C1[3]); \
      _Pragma("unroll") for (int r = 4; r < 16; r += 4) { a = MX3(a, C0[r], C0[r + 1]); b = MX3(b, C0[r + 2], C0[r + 3]); a = MX3(a, C1[r], C1[r + 1]); b = MX3(b, C1[r + 2], C1[r + 3]); } \
      float rm = __builtin_fmaxf(a, b); { auto rr = __builtin_amdgcn_permlane32_swap(__float_as_uint(rm), __float_as_uint(rm), false, false); rm = __builtin_fmaxf(__uint_as_float(rr[0]), __uint_as_float(rr[1])); } \
      resc = false; \
      if (__builtin_expect(__any(rm > (float)THRL), 0)) { const float dl = __builtin_fmaxf(rm, 0.f); mhat += dl; \
        _Pragma("unroll") for (int r = 0; r < 16; ++r) { C0[r] -= dl; C1[r] -= dl; } \
        SETNEGM((t) + 1); \
        const float f = __builtin_amdgcn_exp2f(-dl); l_reg *= f; if (hi == 0) wsf[r32] = f; resc = true; } } \
    if (((((t) + 1) & 3) == 0) && (t) + 1 >= 4) SETNEGM((t) + 1); \
    SBAR(); \
    GAPB(o[0] = MFMA32(PAF(0), VFR(0), o[0]), C0, 0); \
    GAPB(o[1] = MFMA32(PAF(0), VFR(4), o[1]), C0, 4); \
    KRD(GL, 0); GAPB(o[0] = MFMA32(PAF(1), VFR(1), o[0]), C0, 8); \
    KRD(GL, 1); GAPB(o[1] = MFMA32(PAF(1), VFR(5), o[1]), C0, 12); \
    KRD(GL, 2); GAPB(o[0] = MFMA32(PAF(2), VFR(2), o[0]), C1, 0); \
    KRD(GL, 3); GAPB(o[1] = MFMA32(PAF(2), VFR(6), o[1]), C1, 4); \
    GAPB(o[0] = MFMA32(PAF(3), VFR(3), o[0]), C1, 8); \
    GAPB(o[1] = MFMA32(PAF(3), VFR(7), o[1]), C1, 12); \
    } while (0)
    int t = 1;
    for (; t + 5 < NT; t += 2) {
        STEP(pB0, pB1, pA0, pA1, t, true, true, true);     WAIT_BAR(2); RESC(); ROT();
        STEP(pA0, pA1, pB0, pB1, t + 1, true, true, true); WAIT_BAR(2); RESC(); ROT();
    }
#define ENDW(tt) do { if ((tt) + 3 < NT) { WAIT_BAR(2); } else if ((tt) + 2 < NT) { WAIT_BAR(1); } else { WAIT_BAR(0); } } while (0)
    for (; t + 1 < NT; t += 2) {
        STEP(pB0, pB1, pA0, pA1, t, (t + 3 < NT), (t + 1 < NT), (t + 1 < NT));           ENDW(t);     RESC(); ROT();
        STEP(pA0, pA1, pB0, pB1, t + 1, (t + 4 < NT), (t + 2 < NT), (t + 2 < NT));       ENDW(t + 1); RESC(); ROT();
    }
    STEP(pB0, pB1, pA0, pA1, NT - 1, false, false, false); RESC();
    { float sacc = pB0[0] + pB0[1]; _Pragma("unroll") for (int r = 2; r < 16; ++r) sacc += pB0[r]; _Pragma("unroll") for (int r = 0; r < 16; ++r) sacc += pB1[r]; l_reg += sacc;
      pw0 = (u32x4){PKW(pB0, 0), PKW(pB0, 2), PKW(pB0, 4), PKW(pB0, 6)}; pw1 = (u32x4){PKW(pB0, 8), PKW(pB0, 10), PKW(pB0, 12), PKW(pB0, 14)}; pw2 = (u32x4){PKW(pB1, 0), PKW(pB1, 2), PKW(pB1, 4), PKW(pB1, 6)}; pw3 = (u32x4){PKW(pB1, 8), PKW(pB1, 10), PKW(pB1, 12), PKW(pB1, 14)};
      SBAR(); pv(o, vb0 + sl_cur, PAF(0), PAF(1), PAF(2), PAF(3)); }
#undef PKW
#undef PAF
#undef VFR
#undef PIN
#undef MX3
#undef GAPA
#undef GAPB
#undef EX
#undef VRD
#undef KRD
#undef STEP
#undef ENDW
    { auto rr = __builtin_amdgcn_permlane32_swap(__float_as_uint(l_reg), __float_as_uint(l_reg), false, false); l_reg = __uint_as_float(rr[0]) + __uint_as_float(rr[1]); }
    if (hi == 0) wsf[32 + r32] = l_reg; asm volatile("s_waitcnt lgkmcnt(0)" ::: "memory");
    float rli[16];
#pragma unroll
    for (int r = 0; r < 16; ++r) rli[r] = __builtin_amdgcn_rcpf(wsfh[32 + crow0(r)]);
    half_t* Ow = O + (rowbase + q0 + wid * QBLK) * PO + h * D_;
    { LAS half_t* stg = (LAS half_t*)(shm + LDS_OST) + wid * 2048; LAS half_t* stgl = stg + hi * 256 + r32;
#pragma unroll
      for (int r = 0; r < 16; ++r) {
#pragma unroll
        for (int d0 = 0; d0 < 2; ++d0) stgl[crow0(r) * 64 + d0 * 32] = (half_t)(o[d0][r] * rli[r]); }
      asm volatile("s_waitcnt lgkmcnt(0)" ::: "memory");
#pragma unroll
      for (int i = 0; i < 4; ++i) { const int row = i * 8 + (lane >> 3), ch = lane & 7; const u32x4 v = *(const LAS u32x4*)(stg + row * 64 + ch * 8); *(u32x4*)(Ow + (long)row * PO + ch * 8) = v;
          const h8 hv = __builtin_bit_cast(h8, v); float s2 = 0.f;
#pragma unroll
          for (int e = 0; e < 8; ++e) s2 += (float)hv[e] * (float)hv[e];
          s2 += xor_lane<1>(s2); s2 += xor_lane<2>(s2); s2 += xor_lane<4>(s2);
#ifndef DBG_NOSSQW
          if (ch == 0) ssq[(rowbase + q0 + wid * QBLK + row) * 8 + h] = s2;
#endif
          } }
    asm volatile("s_waitcnt lgkmcnt(0)\n\ts_barrier" ::: "memory");
#undef DMA_K
#undef DMA_V
#undef PHYS
#undef CMASK
#undef SETNEGM
#undef START
#undef RESC
#undef ROT
}
#undef SBAR
#undef WAIT_BAR
#undef MFMA32
}

constexpr size_t MiB = 1u << 20;
constexpr size_t WS_CTL = 0, CTL_ZERO_BYTES = 1 * MiB;
constexpr size_t WS_MOD = 1 * MiB;
constexpr size_t WS_KMEAN = 1 * MiB + 512 * 1024;
constexpr size_t WS_S5E = 2 * MiB;
constexpr size_t WS_ROPE_C = 6 * MiB, WS_ROPE_S = 10 * MiB;
constexpr size_t WS_SMALL = 14 * MiB;
constexpr size_t SM_ABAR = WS_SMALL, SM_ABART = SM_ABAR + 16384, SM_BBT = SM_ABART + 16384, SM_CMT = SM_BBT + 262144, SM_GLUT = SM_CMT + 131072,
                 SM_WAT = SM_GLUT + 262144, SM_WXT = SM_WAT + 98304, SM_SP = SM_WXT + 98304, SM_END = SM_SP + 4096;
constexpr size_t PAR_CONVW = SM_END, PAR_CONVB = PAR_CONVW + 2 * 4 * 384 * 4, PAR_BA = PAR_CONVB + 2 * 384 * 4, PAR_BX = PAR_BA + 2 * 384 * 4, PAR_S5D = PAR_BX + 2 * 384 * 4, PAR_GLUB = PAR_S5D + 2 * 256 * 4,
                 PAR_GAIN = PAR_GLUB + 2 * 256 * 4, PAR_N1G = PAR_GAIN + 2 * 1024 * 4, PAR_N2G = PAR_N1G + 2 * 1024 * 4, PAR_ROUTER = PAR_N2G + 2 * 1024 * 4, PAR_FG = PAR_ROUTER + 1024 * 8 * 4, PAR_END = PAR_FG + 1024 * 4;
static_assert(PAR_END <= 16 * MiB, "small params");
constexpr size_t WS_MOE = 16 * MiB;
constexpr size_t MO_SEL = WS_MOE, MO_WSEL = MO_SEL + 131072, MO_TOKSLOT = MO_WSEL + 262144, MO_SLOTTOK = MO_TOKSLOT + 262144, MO_TEXP = MO_SLOTTOK + 294912, MO_BLKCNT = MO_TEXP + 4096, MO_END = MO_BLKCNT + 8192;
static_assert(MO_END <= 18 * MiB && MOE_SLOTS * 4 <= 294912, "moe tables");
#ifndef DBG_NOKSCALE
#define DBG_NOKSCALE 0
#endif
constexpr size_t WS_SSQ = 20 * MiB;
constexpr size_t WS_WIN = 32 * MiB, WS_WOUT = 41 * MiB, WS_WGU = 45 * MiB, WS_WD = 56 * MiB, WS_MGU = 62 * MiB, WS_MD = 118 * MiB;
constexpr size_t WS_RES = 146 * MiB;
constexpr size_t WS_XN8 = 210 * MiB;
constexpr size_t WS_XG8 = 242 * MiB;
constexpr size_t WS_XN = 210 * MiB;
constexpr size_t WS_PROJ = 274 * MiB;
constexpr size_t WS_O = 410 * MiB;
constexpr size_t WS_PR = 474 * MiB;
constexpr size_t WS_HID = 308 * MiB;
constexpr size_t WS_Y = 427 * MiB;
constexpr size_t WS_END = 559 * MiB;
static_assert(WS_WIN + 2ull * NPROJ_PAD * D * 2 <= WS_WOUT && WS_WOUT + 2ull * D * D * 2 <= WS_WGU && WS_WGU + 2ull * FF * D * 2 <= WS_WD && WS_WD + (size_t)D * FF * 2 <= WS_MGU &&
              WS_MGU + 8ull * 2 * FFE * D <= WS_MD && WS_MD + 8ull * D * FFE <= WS_RES && WS_RES + (size_t)M * D * 2 <= WS_XN8 && WS_XN8 + (size_t)M * D <= WS_XG8 && WS_XG8 + (size_t)MOE_SLOTS * D <= WS_HID && WS_XN + (size_t)M * D * 2 <= WS_PROJ && WS_PROJ + (size_t)M * NPROJ * 2 <= WS_O &&
              WS_O + (size_t)M * D * 2 <= WS_PR && WS_PR + (size_t)M * LRU_W * 4 <= WS_END && WS_XN + (size_t)M * D * 2 <= WS_HID && WS_HID + (size_t)M * FF * 2 <= WS_END && WS_HID + (size_t)MOE_CH_TILES * 256 * FFE * 1 <= WS_Y &&
              WS_Y + (size_t)MOE_SLOTS * D * 2 <= WS_END && (size_t)M * LRU_W * 4 <= (size_t)M * D * 2, "d_ws map");
constexpr int CW_TMO = 0, CW_CODE = 1, CW_Q0 = 64, CW_Q1 = 128, CW_NT = 192, CW_BAR = 4096;

constexpr int RING_BYTES = 131072;
constexpr int LDSCTL_OFF = RING_BYTES, MISC_OFF = LDSCTL_OFF + 320;
constexpr int LDS_BYTES = 147456;
constexpr int NWAVES = 8;

typedef GAS unsigned gu32;
#define RLX_AGENT __ATOMIC_RELAXED, __HIP_MEMORY_SCOPE_AGENT

#define XB_TMO      128
#define XB_XCNT(j)  (256  + 64 * (j))
#define XB_XSUB(j)  (1280 + 64 * (j))
#define XB_XGEN(j)  (2304 + 64 * (j))
#define XB_TOP      3328
#define XB_TOPGEN   3392
#define XCD_BAR_WORDS 3456
#define XB_SPIN_CAP (1u << 18)
__device__ __forceinline__ unsigned xb_ld(unsigned* p)              { return __hip_atomic_load(p, __ATOMIC_RELAXED, __HIP_MEMORY_SCOPE_AGENT); }
__device__ __forceinline__ unsigned xb_add(unsigned* p, unsigned v) { return __hip_atomic_fetch_add(p, v, __ATOMIC_RELAXED, __HIP_MEMORY_SCOPE_AGENT); }
__device__ __forceinline__ unsigned xb_xcc_id() { return (unsigned)__builtin_amdgcn_s_getreg((3 << 11) | 20) & 0xFu; }
#define XB_SPIN(cond, bar) do { unsigned _sp = 0; while (cond) { __builtin_amdgcn_s_sleep(1); \
    if ((++_sp & 255u) == 0u) { if (xb_ld(&(bar)[XB_TMO])) break; if (_sp > XB_SPIN_CAP) { atomicAdd(&(bar)[XB_TMO], 1u); break; } } } } while (0)
struct XcdBarrier { unsigned* bar; unsigned x; volatile LAS unsigned* st; };
__device__ __forceinline__ XcdBarrier xcd_barrier_post(unsigned* bar, volatile LAS unsigned* st) {
    XcdBarrier b; b.bar = bar; b.x = xb_xcc_id(); b.st = st;
    if (threadIdx.x == 0) (void)xb_add(&bar[XB_XCNT(b.x)], 1u);
    return b;
}
__device__ __forceinline__ void xcd_barrier_complete(unsigned* bar, unsigned x, unsigned& nloc, unsigned& nx) {
    const unsigned G = gridDim.x * gridDim.y * gridDim.z;
    unsigned sum, cnt, mine, sp = 0u;
    for (;;) {
        sum = 0u; cnt = 0u; mine = 0u;
#pragma unroll
        for (unsigned j = 0; j < 16; ++j) { const unsigned c = xb_ld(&bar[XB_XCNT(j)]); sum += c; cnt += (c > 0u) ? 1u : 0u; mine = (j == x) ? c : mine; }
        if (sum == G) break;
        __builtin_amdgcn_s_sleep(1);
        if ((++sp & 255u) == 0u) { if (xb_ld(&bar[XB_TMO])) break; if (sp > XB_SPIN_CAP) { atomicAdd(&bar[XB_TMO], 1u); break; } }
    }
    nloc = mine > 0u ? mine : 1u; nx = cnt > 0u ? cnt : 1u;
}
__device__ __forceinline__ void xcd_barrier(const XcdBarrier& b) {
    asm volatile("s_waitcnt vmcnt(0)" ::: "memory");
    __syncthreads();
    if (threadIdx.x == 0) {
        unsigned* bar = b.bar;
        __builtin_amdgcn_s_waitcnt(0);
        unsigned nloc = b.st[0], nx = b.st[1];
        if (nloc == 0u) { xcd_barrier_complete(bar, b.x, nloc, nx); b.st[0] = nloc; b.st[1] = nx; }
        const unsigned old = xb_add(&bar[XB_XSUB(b.x)], 1u);
        const unsigned gen = old / nloc;
        if (old + 1u == (gen + 1u) * nloc) {
            __builtin_amdgcn_fence(__ATOMIC_RELEASE, "agent");
            asm volatile("s_waitcnt vmcnt(0)" ::: "memory");
            const unsigned og = xb_add(&bar[XB_TOP], 1u);
            const unsigned tg = og / nx;
            if (og + 1u == (tg + 1u) * nx) xb_add(&bar[XB_TOPGEN], 1u);
            else XB_SPIN(xb_ld(&bar[XB_TOPGEN]) == tg, bar);
            __builtin_amdgcn_fence(__ATOMIC_ACQUIRE, "agent");
            xb_add(&bar[XB_XGEN(b.x)], 1u);
            asm volatile("s_waitcnt vmcnt(0)" ::: "memory");
        } else {
            XB_SPIN(xb_ld(&bar[XB_XGEN(b.x)]) == gen, bar);
            __builtin_amdgcn_fence(__ATOMIC_ACQUIRE, "agent");
            asm volatile("s_waitcnt vmcnt(0)" ::: "memory");
        }
    }
    __syncthreads();
}

struct Args {
    const void* in[35]; float* out; unsigned char* ws; int ph_lo, ph_hi;
};
enum ArgIdx { I_X = 0, I_C, I_POS, I_W_IN, I_CONV_W, I_CONV_B, I_W_A, I_B_A, I_W_X, I_B_X, I_LAM, I_S5_LRE, I_S5_LIM, I_S5_LDT, I_S5_BRE, I_S5_BIM, I_S5_CRE, I_S5_CIM, I_S5_D, I_GLU_W, I_GLU_B,
              I_MIX_GAIN, I_W_OUT, I_NORM1_G, I_NORM2_G, I_ADA_W, I_ADA_B, I_FFN_WG, I_FFN_WU, I_FFN_WD, I_ROUTER_W, I_MOE_WG, I_MOE_WU, I_MOE_WD, I_FINAL_G, I_OUT, I_WS };
__device__ __forceinline__ const void* karg(int i) {
    const __attribute__((address_space(4))) char* kp = (const __attribute__((address_space(4))) char*)__builtin_amdgcn_kernarg_segment_ptr();
    int off = 8 * i; asm volatile("" : "+s"(off));
    typedef const void* cvp_t;
    return *(const __attribute__((address_space(4))) cvp_t*)(kp + off);
}
#define KARG(T, i) ((const T*)(const GAS T*)(unsigned long long)karg(i))

using pg8::Unit;
struct EpiProj {
    static constexpr bool PERM = true;
    half_t* P; const float* rc; const float* rs;
    __device__ __forceinline__ void operator()(const f32x4 (&acc)[2][2][4][2], const Unit& u, int wr, int wc, int fr, int fq) const {
        const int i0 = 16 * (wc & 1) + 4 * fq;
#pragma unroll
        for (int ai = 0; ai < 2; ++ai)
#pragma unroll
            for (int m = 0; m < 4; ++m) {
                const int row = u.pm * 256 + ai * 128 + wr * 64 + m * 16 + fr;
                const f32x4 cv = *(const f32x4*)(rc + (size_t)row * 32 + i0), sv = *(const f32x4*)(rs + (size_t)row * 32 + i0);
#pragma unroll
                for (int bj = 0; bj < 2; ++bj) {
                    const int grp = u.pn * 4 + 2 * bj + (wc >> 1);
                    if (grp < 34) {
                        const f32x4 x1 = acc[ai][bj][m][0], x2 = acc[ai][bj][m][1]; f32x4 o1, o2;
                        if (grp < 12) { o1 = x1 * cv - x2 * sv; o2 = x2 * cv + x1 * sv; if (grp < 6) { o1 = o1 * C2; o2 = o2 * C2; } }
                        else { o1 = x1; o2 = x2; }
                        half_t* dst = P + (size_t)row * NPROJ + grp * 64 + i0;
                        u32x2 w1, w2; w1.x = pkh(o1[0], o1[1]); w1.y = pkh(o1[2], o1[3]); w2.x = pkh(o2[0], o2[1]); w2.y = pkh(o2[2], o2[3]);
                        *(u32x2*)dst = w1; *(u32x2*)(dst + 32) = w2;
                    }
                }
            }
    }
};
__device__ __forceinline__ f32x4 unpk4(u32x2 a) { const h4 h = __builtin_bit_cast(h4, a); return (f32x4){(float)h[0], (float)h[1], (float)h[2], (float)h[3]}; }
template <typename XI>
struct EpiResidT {
    static constexpr bool PERM = true;
    const XI* xin; half_t* xout; const float* gate; float osc;
    __device__ __forceinline__ void operator()(const f32x4 (&acc)[2][2][4][2], const Unit& u, int wr, int wc, int fr, int fq) const {
        const int b = u.pm >> 4; const float* gb = gate + (size_t)b * 6144;
#pragma unroll
        for (int bj = 0; bj < 2; ++bj) {
            const int col = u.pn * 256 + bj * 128 + wc * 32 + 8 * fq; const f32x4 gv0 = *(const f32x4*)(gb + col) * osc, gv1 = *(const f32x4*)(gb + col + 4) * osc;
#pragma unroll
            for (int ai = 0; ai < 2; ++ai)
#pragma unroll
                for (int m = 0; m < 4; ++m) { const size_t off = (size_t)(u.pm * 256 + ai * 128 + wr * 64 + m * 16 + fr) * D + col;
                    f32x4 x0, x1;
                    if constexpr (sizeof(XI) == 4) { x0 = *(const f32x4*)(xin + off); x1 = *(const f32x4*)(xin + off + 4); }
                    else { const u32x4 xv = *(const u32x4*)(xin + off); u32x2 lo2, hi2; lo2.x = xv.x; lo2.y = xv.y; hi2.x = xv.z; hi2.y = xv.w; x0 = unpk4(lo2); x1 = unpk4(hi2); }
                    const f32x4 r0 = x0 + gv0 * acc[ai][bj][m][0], r1 = x1 + gv1 * acc[ai][bj][m][1];
                    u32x4 w; w.x = pkh(r0[0], r0[1]); w.y = pkh(r0[2], r0[3]); w.z = pkh(r1[0], r1[1]); w.w = pkh(r1[2], r1[3]);
                    *(u32x4*)(xout + off) = w; }
        }
    }
};
struct EpiSwiglu {
    static constexpr bool PERM = true;
    half_t* H; int ldh;
    __device__ __forceinline__ void operator()(const f32x4 (&acc)[2][2][4][2], const Unit& u, int wr, int wc, int fr, int fq) const {
#pragma unroll
        for (int ai = 0; ai < 2; ++ai)
#pragma unroll
            for (int m = 0; m < 4; ++m) {
                const int row = u.pm * 256 + ai * 128 + wr * 64 + m * 16 + fr;
                const f32x4 g0 = acc[ai][0][m][0], g1 = acc[ai][0][m][1], u0 = acc[ai][1][m][0], u1 = acc[ai][1][m][1];
                u32x4 w; w.x = pkh(siluf_(g0[0]) * u0[0], siluf_(g0[1]) * u0[1]); w.y = pkh(siluf_(g0[2]) * u0[2], siluf_(g0[3]) * u0[3]);
                w.z = pkh(siluf_(g1[0]) * u1[0], siluf_(g1[1]) * u1[1]); w.w = pkh(siluf_(g1[2]) * u1[2], siluf_(g1[3]) * u1[3]);
                *(u32x4*)(H + (size_t)row * ldh + u.pn * 128 + wc * 32 + 8 * fq) = w;
            }
    }
};
struct EpiSwiglu8 {
    static constexpr bool PERM = true;
    unsigned char* H; int ldh; float osc;
    __device__ __forceinline__ void operator()(const f32x4 (&acc)[2][2][4][2], const Unit& u, int wr, int wc, int fr, int fq) const {
#pragma unroll
        for (int ai = 0; ai < 2; ++ai)
#pragma unroll
            for (int m = 0; m < 4; ++m) {
                const int row = u.pm * 256 + ai * 128 + wr * 64 + m * 16 + fr;
                const f32x4 g0 = acc[ai][0][m][0] * osc, g1 = acc[ai][0][m][1] * osc, u0 = acc[ai][1][m][0] * osc, u1 = acc[ai][1][m][1] * osc;
                u32x2 w; w.x = pk_fp8x4(siluf_(g0[0]) * u0[0], siluf_(g0[1]) * u0[1], siluf_(g0[2]) * u0[2], siluf_(g0[3]) * u0[3]);
                w.y = pk_fp8x4(siluf_(g1[0]) * u1[0], siluf_(g1[1]) * u1[1], siluf_(g1[2]) * u1[2], siluf_(g1[3]) * u1[3]);
                *(u32x2*)(H + (size_t)row * ldh + u.pn * 128 + wc * 32 + 8 * fq) = w;
            }
    }
};
struct EpiY {
    static constexpr bool PERM = true;
    half_t* Y; float osc;
    __device__ __forceinline__ void operator()(const f32x4 (&acc)[2][2][4][2], const Unit& u, int wr, int wc, int fr, int fq) const {
#pragma unroll
        for (int ai = 0; ai < 2; ++ai)
#pragma unroll
            for (int m = 0; m < 4; ++m) {
                const int row = u.pm * 256 + ai * 128 + wr * 64 + m * 16 + fr;
#pragma unroll
                for (int bj = 0; bj < 2; ++bj) { const f32x4 v0 = acc[ai][bj][m][0] * osc, v1 = acc[ai][bj][m][1] * osc;
                    u32x4 w; w.x = pkh(v0[0], v0[1]); w.y = pkh(v0[2], v0[3]); w.z = pkh(v1[0], v1[1]); w.w = pkh(v1[2], v1[3]);
                    *(u32x4*)(Y + (size_t)row * D + u.pn * 256 + bj * 128 + wc * 32 + 8 * fq) = w; }
            }
    }
};

__device__ __forceinline__ int map_row(int kind, int c) {
    if (kind == 0) return c;
    if (kind == 1) { const int grp = c >> 6, d = c & 63, n = d >> 5, i = d & 31, wcl = i >> 4, fq = (i >> 2) & 3, e = i & 3, pn = grp >> 2, hl = grp & 3, bj = hl >> 1, wc = 2 * (hl & 1) + wcl;
        return pn * 256 + 128 * bj + 32 * wc + 8 * fq + 4 * n + e; }
    const int tile = c >> 7, w = c & 127; return tile * 256 + (kind == 3 ? 128 : 0) + w;
}
__device__ __forceinline__ void p0_transpose_item(const float* W, int K, int N, half_t* WT, int kind, LAS half_t* scr, int item, int lane, const float* kscale = nullptr) {
    const int nblk = N / 64, kb = item / nblk, nb = item % nblk, k0 = 64 * kb, n0 = 64 * nb;
    const int n4 = lane & 15, kr = lane >> 4;
    f32x4 v[16];
#pragma unroll
    for (int i = 0; i < 16; ++i) v[i] = *(const f32x4*)(W + (size_t)(k0 + 4 * i + kr) * N + n0 + 4 * n4);
    if (kscale && !DBG_NOKSCALE) {
#pragma unroll
        for (int i = 0; i < 16; ++i) v[i] = v[i] * kscale[k0 + 4 * i + kr]; }
#pragma unroll
    for (int i = 0; i < 16; ++i) {
#pragma unroll
        for (int j = 0; j < 4; ++j) scr[(4 * n4 + j) * 72 + 4 * i + kr] = (half_t)v[i][j]; }
    LDS_WAIT(); asm volatile("" ::: "memory");
#pragma unroll
    for (int r = 0; r < 8; ++r) { const int idx = r * 64 + lane, n = idx >> 3, c = idx & 7;
        const u32x4 o = *(const LAS u32x4*)(scr + n * 72 + 8 * c);
        *(u32x4*)(WT + (size_t)map_row(kind, n0 + n) * K + k0 + 8 * c) = o; }
    LDS_WAIT(); asm volatile("" ::: "memory");
}
__device__ __forceinline__ void p0_transpose_item_fp8(const float* W, int K, int N, unsigned char* WT, int kind, float wscale, LAS unsigned char* scr, int item, int lane) {
    const int nblk = N / 32, kb = item / nblk, nb = item % nblk, k0 = 128 * kb, n0 = 32 * nb;
    const int n4 = lane & 7, kr = lane >> 3;
    LAS unsigned* sd = (LAS unsigned*)scr;
    f32x4 v[16];
#pragma unroll
    for (int i = 0; i < 16; ++i) v[i] = *(const f32x4*)(W + (size_t)(k0 + 32 * (i >> 2) + 4 * kr + (i & 3)) * N + n0 + 4 * n4);
#pragma unroll
    for (int ii = 0; ii < 4; ++ii) {
#pragma unroll
        for (int j = 0; j < 4; ++j) sd[(4 * n4 + j) * 33 + 8 * ii + kr] = pk_fp8x4(v[4 * ii][j] * wscale, v[4 * ii + 1][j] * wscale, v[4 * ii + 2][j] * wscale, v[4 * ii + 3][j] * wscale); }
    LDS_WAIT(); asm volatile("" ::: "memory");
#pragma unroll
    for (int r = 0; r < 4; ++r) { const int idx = r * 64 + lane, n = idx >> 3, c = idx & 7;
        u32x4 o; o.x = sd[n * 33 + 4 * c]; o.y = sd[n * 33 + 4 * c + 1]; o.z = sd[n * 33 + 4 * c + 2]; o.w = sd[n * 33 + 4 * c + 3];
        *(u32x4*)(WT + (size_t)map_row(kind, n0 + n) * K + k0 + 16 * c) = o; }
    LDS_WAIT(); asm volatile("" ::: "memory");
}
__device__ __forceinline__ void sincos_d(double a, double& s, double& c) {
    const double q = rint(a * 0.63661977236758134308), y = a - q * 1.57079632679489661923, y2 = y * y;
    const double sy = y * (1.0 + y2 * (-1.0 / 6 + y2 * (1.0 / 120 + y2 * (-1.0 / 5040 + y2 * (1.0 / 362880 + y2 * (-1.0 / 39916800 + y2 * (1.0 / 6227020800.0)))))));
    const double cy = 1.0 + y2 * (-0.5 + y2 * (1.0 / 24 + y2 * (-1.0 / 720 + y2 * (1.0 / 40320 + y2 * (-1.0 / 3628800 + y2 * (1.0 / 479001600.0))))));
    const int qi = ((int)(long long)q) & 3;
    s = (qi == 0) ? sy : (qi == 1) ? cy : (qi == 2) ? -sy : -cy;
    c = (qi == 0) ? cy : (qi == 1) ? -sy : (qi == 2) ? -cy : sy;
}

struct Ctx {
    LAS unsigned char* lds; int tid, lane, wave, G, bid, gw, NGW;
    unsigned char* ws;
};
#define WSP(T, off) ((T*)(GAS T*)((unsigned long long)C.ws + (off)))

__device__ __forceinline__ void p0_prologue(const Ctx& C) {
    LAS half_t* scr = (LAS half_t*)(C.lds + C.wave * 16384);
    constexpr int I_IN = (D / 64) * (NPROJ / 64), I_OUT = (D / 64) * (D / 64), I_FG = (D / 64) * (FF / 64), I_FD = (FF / 64) * (D / 64), I_MG = (D / 64) * (FFE / 64), I_MD = (FFE / 64) * (D / 64);
    constexpr int NITEMS = 2 * I_IN + 2 * I_OUT + 2 * I_FG + I_FD + 16 * I_MG + 8 * I_MD;
#ifndef DBG_P0MASK
#define DBG_P0MASK 0x7f
#endif
#ifndef DBG_ITEM_LO
#define DBG_ITEM_LO 0
#define DBG_ITEM_HI NITEMS
#endif
    if (DBG_P0MASK & 64) for (int it = C.bid; it < 2 * 96; it += C.G) {
        __syncthreads();
        LAS float* sc = (LAS float*)C.lds; LAS float* red = (LAS float*)(C.lds + 32768);
        for (int i = C.tid; i < BATCH * D; i += 512) sc[i] = siluf_(KARG(float, I_C)[i]);
        __syncthreads();
        const int l = it / 96, n = (it % 96) * 64 + C.lane; float acc[8];
#pragma unroll
        for (int b = 0; b < 8; ++b) acc[b] = 0.f;
        const float* wp = KARG(float, I_ADA_W) + ((size_t)l * D + C.wave * 128) * 6144 + n;
#pragma unroll 8
        for (int k = 0; k < 128; ++k) { const float wv = wp[(size_t)k * 6144];
#pragma unroll
            for (int b = 0; b < 8; ++b) acc[b] += sc[b * D + C.wave * 128 + k] * wv; }
#pragma unroll
        for (int b = 0; b < 8; ++b) red[(C.wave * 8 + b) * 64 + C.lane] = acc[b];
        __syncthreads();
        { const int b = C.wave; float s = KARG(float, I_ADA_B)[(size_t)l * 6144 + n];
#pragma unroll
          for (int w = 0; w < 8; ++w) s += red[(w * 8 + b) * 64 + C.lane];
          WSP(float, WS_MOD)[((size_t)l * 8 + b) * 6144 + n] = s; }
        __syncthreads();
    }
    constexpr int NMODB = 2 * 96, LATE = 3;
    if (DBG_P0MASK & 1) for (int rnd = (C.bid < NMODB ? LATE : 0); ; ++rnd) {
        const int it = rnd < LATE ? rnd * ((C.G - NMODB) * NWAVES) + (C.gw - NMODB * NWAVES) : LATE * ((C.G - NMODB) * NWAVES) + (rnd - LATE) * C.NGW + C.gw;
        if (it >= NITEMS) break;
        int r = it; if (it < DBG_ITEM_LO || it >= DBG_ITEM_HI) continue;
        if (r < 2 * I_IN) { const int l = r / I_IN; p0_transpose_item(KARG(float, I_W_IN) + (size_t)l * D * NPROJ, D, NPROJ, WSP(half_t, WS_WIN) + (size_t)l * NPROJ_PAD * D, 1, scr, r % I_IN, C.lane); continue; } r -= 2 * I_IN;
        if (r < 2 * I_OUT) { const int l = r / I_OUT; p0_transpose_item(KARG(float, I_W_OUT) + (size_t)l * D * D, D, D, WSP(half_t, WS_WOUT) + (size_t)l * D * D, 0, scr, r % I_OUT, C.lane, KARG(float, I_MIX_GAIN) + (size_t)l * D); continue; } r -= 2 * I_OUT;
#if DENSE_FP8
        if (r < I_FG) { p0_transpose_item_fp8(KARG(float, I_FFN_WG), D, FF, WSP(unsigned char, WS_WGU), 2, 32.f, (LAS unsigned char*)scr, r, C.lane); continue; } r -= I_FG;
        if (r < I_FG) { p0_transpose_item_fp8(KARG(float, I_FFN_WU), D, FF, WSP(unsigned char, WS_WGU), 3, 32.f, (LAS unsigned char*)scr, r, C.lane); continue; } r -= I_FG;
        if (r < I_FD) { p0_transpose_item_fp8(KARG(float, I_FFN_WD), FF, D, WSP(unsigned char, WS_WD), 0, 64.f, (LAS unsigned char*)scr, r, C.lane); continue; } r -= I_FD;
#else
        if (r < I_FG) { p0_transpose_item(KARG(float, I_FFN_WG), D, FF, WSP(half_t, WS_WGU), 2, scr, r, C.lane); continue; } r -= I_FG;
        if (r < I_FG) { p0_transpose_item(KARG(float, I_FFN_WU), D, FF, WSP(half_t, WS_WGU), 3, scr, r, C.lane); continue; } r -= I_FG;
        if (r < I_FD) { p0_transpose_item(KARG(float, I_FFN_WD), FF, D, WSP(half_t, WS_WD), 0, scr, r, C.lane); continue; } r -= I_FD;
#endif
        if (r < 8 * I_MG) { const int e = r / I_MG; p0_transpose_item_fp8(KARG(float, I_MOE_WG) + (size_t)e * D * FFE, D, FFE, WSP(unsigned char, WS_MGU) + (size_t)e * 2 * FFE * D, 2, 32.f, (LAS unsigned char*)scr, r % I_MG, C.lane); continue; } r -= 8 * I_MG;
        if (r < 8 * I_MG) { const int e = r / I_MG; p0_transpose_item_fp8(KARG(float, I_MOE_WU) + (size_t)e * D * FFE, D, FFE, WSP(unsigned char, WS_MGU) + (size_t)e * 2 * FFE * D, 3, 32.f, (LAS unsigned char*)scr, r % I_MG, C.lane); continue; } r -= 8 * I_MG;
        { const int e = r / I_MD; p0_transpose_item_fp8(KARG(float, I_MOE_WD) + (size_t)e * FFE * D, FFE, D, WSP(unsigned char, WS_MD) + (size_t)e * D * FFE, 0, 64.f, (LAS unsigned char*)scr, r % I_MD, C.lane); }
    }
    const int gt = C.bid * 512 + C.tid, NTH = C.G * 512;
    if (DBG_P0MASK & 2) for (int i = gt; i < 2 * 128 * D / 8; i += NTH) { const int l = i / (128 * D / 8), r = i % (128 * D / 8);
        *(u32x4*)(WSP(half_t, WS_WIN) + (size_t)l * NPROJ_PAD * D + (size_t)NPROJ * D + (size_t)r * 8) = (u32x4){0u, 0u, 0u, 0u}; }
    if (DBG_P0MASK & 4) for (int i = gt; i < M * 32; i += NTH) { const int row = i >> 5, fi = i & 31;
        const double inv = exp2(-(double)fi * (13.287712379549449 / 32.0));
        double s, c; sincos_d((double)KARG(int, I_POS)[row] * inv, s, c);
        WSP(float, WS_ROPE_C)[i] = (float)c; WSP(float, WS_ROPE_S)[i] = (float)s; }
    if (DBG_P0MASK & 8) for (int i = gt; i < 2 * S5_G * S5_P * 16; i += NTH) { const int q = i >> 4, h = i & 15, lg = q >> 6, p = q & 63;
        const double dt = exp((double)KARG(float, I_S5_LDT)[lg]), lr = KARG(float, I_S5_LRE)[q], li = KARG(float, I_S5_LIM)[q];
        const double mag = exp(lr * dt); double s, c; sincos_d(li * dt, s, c);
        const double are = mag * c, aim = mag * s, den = lr * lr + li * li, nr = are - 1.0, ni = aim;
        const double cre = (nr * lr + ni * li) / den, cim = (ni * lr - nr * li) / den;
        if (h == 0) { WSP(float, SM_ABAR)[2 * q] = (float)are; WSP(float, SM_ABAR)[2 * q + 1] = (float)aim;
            const double magT = exp(lr * dt * CH_T); double sT, cT; sincos_d(li * dt * CH_T, sT, cT);
            WSP(float, SM_ABART)[2 * q] = (float)(magT * cT); WSP(float, SM_ABART)[2 * q + 1] = (float)(magT * sT); }
        half_t* bbt = WSP(half_t, SM_BBT) + (size_t)lg * 128 * 32;
        const double br = KARG(float, I_S5_BRE)[(size_t)q * 16 + h], bi = KARG(float, I_S5_BIM)[(size_t)q * 16 + h];
        bbt[(2 * p) * 32 + h] = (half_t)(float)(cre * br - cim * bi); bbt[(2 * p + 1) * 32 + h] = (half_t)(float)(cre * bi + cim * br);
        bbt[(2 * p) * 32 + 16 + h] = (half_t)0.f; bbt[(2 * p + 1) * 32 + 16 + h] = (half_t)0.f;
        half_t* cmt = WSP(half_t, SM_CMT) + (size_t)lg * 16 * 128;
        cmt[h * 128 + 2 * p] = (half_t)KARG(float, I_S5_CRE)[((size_t)lg * 16 + h) * 64 + p]; cmt[h * 128 + 2 * p + 1] = (half_t)(-KARG(float, I_S5_CIM)[((size_t)lg * 16 + h) * 64 + p]);
    }
    if (DBG_P0MASK & 16) for (int i = gt; i < 2 * 256 * 256; i += NTH) { const int l = i >> 16, n = (i >> 8) & 255, k = i & 255; WSP(half_t, SM_GLUT)[i] = (half_t)KARG(float, I_GLU_W)[((size_t)l * 256 + k) * 256 + n]; }
    for (int i = gt; i < 2 * 6 * 64 * 64; i += NTH) { const int lh = i >> 12, j = (i >> 6) & 63, ii = i & 63;
        WSP(half_t, SM_WAT)[i] = (half_t)KARG(float, I_W_A)[((size_t)lh * 64 + ii) * 64 + j]; WSP(half_t, SM_WXT)[i] = (half_t)KARG(float, I_W_X)[((size_t)lh * 64 + ii) * 64 + j]; }
    for (int i = gt; i < 2 * LRU_W; i += NTH) WSP(float, SM_SP)[i] = (float)log1p(exp(-(double)KARG(float, I_LAM)[i]));
#define CPY(dst_off, src, n) for (int i = gt; i < (n); i += NTH) WSP(float, dst_off)[i] = (src)[i];
    CPY(PAR_CONVW, KARG(float, I_CONV_W), 2 * 4 * 384) CPY(PAR_CONVB, KARG(float, I_CONV_B), 2 * 384) CPY(PAR_BA, KARG(float, I_B_A), 2 * 384) CPY(PAR_BX, KARG(float, I_B_X), 2 * 384) CPY(PAR_S5D, KARG(float, I_S5_D), 2 * 256) CPY(PAR_GLUB, KARG(float, I_GLU_B), 2 * 256)
    CPY(PAR_GAIN, KARG(float, I_MIX_GAIN), 2 * 1024) CPY(PAR_N1G, KARG(float, I_NORM1_G), 2 * 1024) CPY(PAR_N2G, KARG(float, I_NORM2_G), 2 * 1024) CPY(PAR_ROUTER, KARG(float, I_ROUTER_W), 1024 * 8) CPY(PAR_FG, KARG(float, I_FINAL_G), 1024)
#undef CPY
}

template <typename XI> __device__ __forceinline__ f32x4 ldrow4(const XI* xin, int m, int lane, int j) {
    if constexpr (sizeof(XI) == 4) return ((const f32x4*)(xin + (size_t)m * D) + lane)[64 * j];
    else return unpk4(((const u32x2*)(xin + (size_t)m * D) + lane)[64 * j]);
}
template <bool ROUTER, bool FP8OUT = ROUTER, typename XI = half_t>
__device__ __forceinline__ void row_pass_xn(const Ctx& C, const XI* xin, const float* g, const float* shift0, const float* scale0, half_t* XN, const float* router_w, LAS unsigned* lcnt) {
    constexpr int RPW = M / (256 * NWAVES);
    const int m0 = C.gw * RPW, b = m0 >> 12;
    const float* shb = shift0 + (size_t)b * 6144; const float* scb = scale0 + (size_t)b * 6144;
    f32x4 gs[4], sh[4];
#pragma unroll
    for (int j = 0; j < 4; ++j) { const int col = 4 * C.lane + 256 * j; gs[j] = *(const f32x4*)(g + col) * (*(const f32x4*)(scb + col) + 1.f); sh[j] = *(const f32x4*)(shb + col); }
    f32x4 rw[ROUTER ? 16 : 1][2];
    if constexpr (ROUTER) {
#pragma unroll
        for (int j = 0; j < 4; ++j)
#pragma unroll
            for (int cc = 0; cc < 4; ++cc) { const int col = 4 * C.lane + 256 * j + cc; rw[4 * j + cc][0] = *(const f32x4*)(router_w + (size_t)col * 8); rw[4 * j + cc][1] = *(const f32x4*)(router_w + (size_t)col * 8 + 4); } }
    constexpr int RG = ROUTER ? 4 : 8;
    for (int mg = m0; mg < m0 + RPW; mg += RG) {
      f32x4 vv[RG][4];
#pragma unroll
      for (int r = 0; r < RG; ++r)
#pragma unroll
        for (int j = 0; j < 4; ++j) vv[r][j] = ldrow4(xin, mg + r, C.lane, j);
#pragma unroll
      for (int r = 0; r < RG; ++r) { const int m = mg + r;
        f32x4 v[4]; float ss = 0.f;
#pragma unroll
        for (int j = 0; j < 4; ++j) { v[j] = vv[r][j]; ss += (v[j].x * v[j].x + v[j].y * v[j].y) + (v[j].z * v[j].z + v[j].w * v[j].w); }
        const float rstd = 1.f / sqrtf(wave_sum(ss) * (1.f / D) + EPS);
        u32x2* o8 = (u32x2*)(XN + (size_t)m * D) + C.lane;
#pragma unroll
        for (int j = 0; j < 4; ++j) { v[j] = v[j] * rstd * gs[j] + sh[j];
            if constexpr (FP8OUT) ((unsigned*)((unsigned char*)XN + (size_t)m * D) + C.lane)[64 * j] = pk_fp8x4(v[j].x, v[j].y, v[j].z, v[j].w);
            else { u32x2 w; w.x = pkh(v[j].x, v[j].y); w.y = pkh(v[j].z, v[j].w); o8[64 * j] = w; } }
        if constexpr (ROUTER) {
            float lg[8];
#pragma unroll
            for (int e = 0; e < 8; ++e) lg[e] = 0.f;
#pragma unroll
            for (int j = 0; j < 4; ++j)
#pragma unroll
                for (int cc = 0; cc < 4; ++cc) { const f32x4 r0 = rw[4 * j + cc][0], r1 = rw[4 * j + cc][1]; const float hv = v[j][cc];
                    lg[0] += hv * r0.x; lg[1] += hv * r0.y; lg[2] += hv * r0.z; lg[3] += hv * r0.w; lg[4] += hv * r1.x; lg[5] += hv * r1.y; lg[6] += hv * r1.z; lg[7] += hv * r1.w; }
#pragma unroll
            for (int e = 0; e < 8; ++e) lg[e] = wave_sum(lg[e]);
            int e0 = 0; float t0 = lg[0];
#pragma unroll
            for (int e = 1; e < 8; ++e) if (lg[e] > t0) { t0 = lg[e]; e0 = e; }
            int e1 = -1; float t1 = -INFINITY;
#pragma unroll
            for (int e = 0; e < 8; ++e) if (e != e0 && lg[e] > t1) { t1 = lg[e]; e1 = e; }
            const float w0 = 1.f / (1.f + expf(t1 - t0));
            if (C.lane == 0) { WSP(int, MO_SEL)[m] = e0 | (e1 << 8); WSP(float, MO_WSEL)[2 * m] = w0; WSP(float, MO_WSEL)[2 * m + 1] = 1.f - w0;
                __hip_atomic_fetch_add(&lcnt[e0], 1u, __ATOMIC_RELAXED, __HIP_MEMORY_SCOPE_WORKGROUP); __hip_atomic_fetch_add(&lcnt[e1], 1u, __ATOMIC_RELAXED, __HIP_MEMORY_SCOPE_WORKGROUP); }
        }
      }
    }
}
__device__ __forceinline__ void row_pass_final(const Ctx& C, const half_t* xin, float* xout, const float* gate2_0, const float* fg) {
    constexpr int RPW = M / (256 * NWAVES);
    const int m0 = C.gw * RPW, b = m0 >> 12;
    int ts = 0; float wsv = 0.f;
    if (C.lane < 2 * RPW) { ts = WSP(int, MO_TOKSLOT)[2 * m0 + C.lane]; wsv = WSP(float, MO_WSEL)[2 * m0 + C.lane]; }
    f32x4 gg[4], fgv[4];
#pragma unroll
    for (int j = 0; j < 4; ++j) { const int col = 4 * C.lane + 256 * j; gg[j] = *(const f32x4*)(gate2_0 + (size_t)b * 6144 + col); fgv[j] = *(const f32x4*)(fg + col); }
    const half_t* Y = WSP(half_t, WS_Y);
    constexpr int FG = 4;
    for (int mg = 0; mg < RPW; mg += FG) {
        u32x2 xr[FG][4], ya[FG][4], yc[FG][4]; float w0[FG], w1[FG];
#pragma unroll
        for (int r = 0; r < FG; ++r) { const int s0 = __builtin_amdgcn_readlane(ts, 2 * (mg + r)), s1 = __builtin_amdgcn_readlane(ts, 2 * (mg + r) + 1);
            w0[r] = __builtin_bit_cast(float, __builtin_amdgcn_readlane(__builtin_bit_cast(int, wsv), 2 * (mg + r))); w1[r] = __builtin_bit_cast(float, __builtin_amdgcn_readlane(__builtin_bit_cast(int, wsv), 2 * (mg + r) + 1));
            const u32x2* y0 = (const u32x2*)(Y + (size_t)s0 * D) + C.lane; const u32x2* y1 = (const u32x2*)(Y + (size_t)s1 * D) + C.lane; const u32x2* xp = (const u32x2*)(xin + (size_t)(m0 + mg + r) * D) + C.lane;
#pragma unroll
            for (int j = 0; j < 4; ++j) { xr[r][j] = xp[64 * j]; ya[r][j] = y0[64 * j]; yc[r][j] = y1[64 * j]; } }
#pragma unroll
        for (int r = 0; r < FG; ++r) { f32x4* xo = (f32x4*)(xout + (size_t)(m0 + mg + r) * D) + C.lane;
            f32x4 v[4]; float ss = 0.f;
#pragma unroll
            for (int j = 0; j < 4; ++j) { v[j] = unpk4(xr[r][j]) + gg[j] * (unpk4(ya[r][j]) * w0[r] + unpk4(yc[r][j]) * w1[r]); ss += (v[j].x * v[j].x + v[j].y * v[j].y) + (v[j].z * v[j].z + v[j].w * v[j].w); }
            const float rstd = 1.f / sqrtf(wave_sum(ss) * (1.f / D) + EPS);
#pragma unroll
            for (int j = 0; j < 4; ++j) xo[64 * j] = v[j] * rstd * fgv[j]; }
    }
}
__device__ __forceinline__ void row_pass_attnorm(const Ctx& C, half_t* O, const float* gain) {
    constexpr int RPW = M / (256 * NWAVES);
    for (int m = C.gw * RPW; m < C.gw * RPW + RPW && m < M; ++m) {
        u32x2* o8 = (u32x2*)(O + (size_t)m * D) + C.lane;
        f32x4 v0, v1 = {0.f, 0.f, 0.f, 0.f};
        v0 = unpk4(o8[0]);
        if (C.lane < 32) v1 = unpk4(o8[64]);
        const float ss = (v0.x * v0.x + v0.y * v0.y) + (v0.z * v0.z + v0.w * v0.w) + (v1.x * v1.x + v1.y * v1.y) + (v1.z * v1.z + v1.w * v1.w);
#ifdef DBG_ATTSCALE
        const float rstd = DBG_ATTSCALE / sqrtf(wave_sum(ss) * (1.f / 384.f) + EPS);
#else
        const float rstd = 1.f / sqrtf(wave_sum(ss) * (1.f / 384.f) + EPS);
#endif
        { const f32x4 gg = *(const f32x4*)(gain + 4 * C.lane); const f32x4 r = v0 * rstd * gg; u32x2 w; w.x = pkh(r.x, r.y); w.y = pkh(r.z, r.w); o8[0] = w; }
        if (C.lane < 32) { const f32x4 gg = *(const f32x4*)(gain + 256 + 4 * C.lane); const f32x4 r = v1 * rstd * gg; u32x2 w; w.x = pkh(r.x, r.y); w.y = pkh(r.z, r.w); o8[64] = w; }
#ifdef DBG_KEEP
        { const u32x2 z = {0u, 0u};
          if (!(DBG_KEEP & 1)) { o8[0] = z; if (C.lane < 32) o8[64] = z; }
          if (!(DBG_KEEP & 2)) { if (C.lane >= 32) o8[64] = z; o8[128] = z; }
          if (!(DBG_KEEP & 4)) { o8[192] = z; } }
#endif
    }
}

__device__ __forceinline__ f32x4 mm16(const LAS half_t* Ap, int lda, const half_t* Bt, int ldb, int ksteps, f32x4 acc, int lane) {
    const int ar = lane & 15, kq = lane >> 4;
    for (int ks = 0; ks < ksteps; ++ks) { const h8 a = *(const LAS h8*)(Ap + ar * lda + ks * 32 + kq * 8); const h8 b = *(const h8*)(Bt + (size_t)ar * ldb + ks * 32 + kq * 8);
        acc = __builtin_amdgcn_mfma_f32_16x16x32_f16(a, b, acc, 0, 0, 0); }
    return acc;
}

__device__ __forceinline__ f32x4 mm16t(const LAS half_t* Ap, int lda, const half_t* Bt, int ldb, int ksteps, f32x4 acc, int lane) {
    const int ar = lane & 15, kq = lane >> 4;
    for (int ks = 0; ks < ksteps; ++ks) { const h8 a = *(const LAS h8*)(Ap + ar * lda + ks * 32 + kq * 8); const h8 b = *(const h8*)(Bt + (size_t)ar * ldb + ks * 32 + kq * 8);
        acc = __builtin_amdgcn_mfma_f32_16x16x32_f16(b, a, acc, 0, 0, 0); }
    return acc;
}
__device__ __forceinline__ void kmean_items(const Ctx& C) {
    const half_t* P = WSP(half_t, WS_PROJ); const int dch = C.lane & 7, rg = C.lane >> 3;
    for (int it = C.bid + C.G * C.wave; it < BATCH * NH * 16; it += C.NGW) { const int n = it & 15, bh = it >> 4, h = bh % NH, b = bh / NH;
        const half_t* kp = P + ((size_t)b * SEQ + n * 256 + rg) * NPROJ + COL_K + h * 64 + dch * 8; float s[8];
#pragma unroll
        for (int k = 0; k < 8; ++k) s[k] = 0.f;
#pragma unroll
        for (int r = 0; r < 32; ++r) { const h8 v = *(const h8*)(kp + (size_t)(8 * r) * NPROJ);
#pragma unroll
            for (int k = 0; k < 8; ++k) s[k] += (float)v[k]; }
#pragma unroll
        for (int k = 0; k < 8; ++k) { s[k] += xor_lane<8>(s[k]); s[k] += xor_lane<16>(s[k]); s[k] += xor_lane<32>(s[k]); }
        if (rg == 0) { float* o = WSP(float, WS_KMEAN) + (size_t)it * 64 + dch * 8; *(f32x4*)o = (f32x4){s[0], s[1], s[2], s[3]} * (1.f / 256.f); *(f32x4*)(o + 4) = (f32x4){s[4], s[5], s[6], s[7]} * (1.f / 256.f); } }
}
__device__ __forceinline__ void lru_prep_unit(const Ctx& C, int l, int b, int c) {
    constexpr int LDX = 392;
    LAS half_t* XC = (LAS half_t*)C.lds;
    LAS float* PRE = (LAS float*)(C.lds + 65536) + C.wave * 2048;
    const half_t* P = WSP(half_t, WS_PROJ); const size_t row0 = (size_t)b * SEQ + c * CH_T;
    const int h = C.wave < 6 ? C.wave : 0, ch = h * 64 + C.lane; const int ar = C.lane & 15, kq = C.lane >> 4; const bool act = C.wave < 6;
    const half_t* wat = WSP(half_t, SM_WAT) + ((size_t)l * 6 + h) * 4096; const half_t* wxt = WSP(half_t, SM_WXT) + ((size_t)l * 6 + h) * 4096;
    h8 wa[4][2], wx[4][2];
#pragma unroll
    for (int nt = 0; nt < 4; ++nt)
#pragma unroll
        for (int ks = 0; ks < 2; ++ks) { wa[nt][ks] = *(const h8*)(wat + (size_t)(nt * 16 + ar) * 64 + ks * 32 + kq * 8); wx[nt][ks] = *(const h8*)(wxt + (size_t)(nt * 16 + ar) * 64 + ks * 32 + kq * 8); }
    const float ba = WSP(float, PAR_BA)[l * LRU_W + ch], bx = WSP(float, PAR_BX)[l * LRU_W + ch], sp = WSP(float, SM_SP)[l * LRU_W + ch];
    __syncthreads();
    for (int i = C.tid; i < 67 * 48; i += 512) { const int r = i / 48, cc = i % 48; u32x4 v = {0u, 0u, 0u, 0u};
        if (c > 0 || r >= 3) v = *(const u32x4*)(P + (row0 + r - 3) * NPROJ + COL_XR + cc * 8);
        *(LAS u32x4*)(XC + r * LDX + cc * 8) = v; }
    __syncthreads();
    if (C.tid < LRU_W) { const int cch = C.tid; const float* cw = WSP(float, PAR_CONVW) + (size_t)l * 4 * LRU_W + cch; const float w0 = cw[0], w1 = cw[LRU_W], w2 = cw[2 * LRU_W], w3 = cw[3 * LRU_W], cb = WSP(float, PAR_CONVB)[l * LRU_W + cch];
        float x3 = (float)XC[66 * LDX + cch], x2 = (float)XC[65 * LDX + cch], x1 = (float)XC[64 * LDX + cch];
#pragma unroll 8
        for (int t = CH_T - 1; t >= 0; --t) { const float x0 = (float)XC[t * LDX + cch]; XC[(t + 3) * LDX + cch] = (half_t)(w0 * x0 + w1 * x1 + w2 * x2 + w3 * x3 + cb); x3 = x2; x2 = x1; x1 = x0; } }
    __syncthreads();
    float hl = 0.f, pr = 1.f; unsigned* HP = WSP(unsigned, WS_PR);
    for (int sc = 0; sc < 4; ++sc) {
        if (act) {
            const h8 a0 = *(const LAS h8*)(XC + (sc * 16 + 3 + ar) * LDX + h * 64 + kq * 8), a1 = *(const LAS h8*)(XC + (sc * 16 + 3 + ar) * LDX + h * 64 + 32 + kq * 8);
#pragma unroll
            for (int nt = 0; nt < 4; ++nt) { const f32x4 z = {0.f, 0.f, 0.f, 0.f};
                f32x4 ra = __builtin_amdgcn_mfma_f32_16x16x32_f16(wa[nt][0], a0, z, 0, 0, 0); ra = __builtin_amdgcn_mfma_f32_16x16x32_f16(wa[nt][1], a1, ra, 0, 0, 0);
                f32x4 rx = __builtin_amdgcn_mfma_f32_16x16x32_f16(wx[nt][0], a0, z, 0, 0, 0); rx = __builtin_amdgcn_mfma_f32_16x16x32_f16(wx[nt][1], a1, rx, 0, 0, 0);
                *(LAS f32x4*)(PRE + ar * 64 + nt * 16 + 4 * kq) = ra; *(LAS f32x4*)(PRE + 1024 + ar * 64 + nt * 16 + 4 * kq) = rx; } }
        __syncthreads();
        if (act) {
            float pa[16], px[16]; half_t xv[16];
#pragma unroll
            for (int tt = 0; tt < 16; ++tt) { pa[tt] = PRE[tt * 64 + C.lane]; px[tt] = PRE[1024 + tt * 64 + C.lane]; xv[tt] = XC[(sc * 16 + tt + 3) * LDX + ch]; }
#pragma unroll
            for (int tt = 0; tt < 16; ++tt) { const int t = sc * 16 + tt;
                const float rg = sigmoidf_(pa[tt] + ba), ig = sigmoidf_(px[tt] + bx), xcv = (float)xv[tt];
                const float a = __expf(-8.f * rg * sp); const float mult = __builtin_amdgcn_sqrtf(fmaxf((1.f - a) * (1.f + a), 0.f));
                hl = a * hl + mult * ig * xcv; pr *= a;
                HP[(row0 + t) * LRU_W + ch] = pkh(hl, pr); } }
        LDS_WAIT();
    }
    if (act) WSP(f32x2, WS_XN)[((size_t)b * NCH + c) * LRU_W + ch] = (f32x2){hl, pr};
}
__device__ __forceinline__ void lru_final_unit(const Ctx& C, int l, int b, int c) {
    LAS float* CAR = (LAS float*)C.lds;
    const unsigned* HP = WSP(unsigned, WS_PR); const half_t* P = WSP(half_t, WS_PROJ); const size_t row0 = (size_t)b * SEQ + c * CH_T;
    const bool hasB = C.lane < 32; const int cA = 4 * C.lane, cB = 256 + 4 * (C.lane & 31);
    u32x4 hpA[8], hpB[8]; u32x2 gtA[8], gtB[8];
#pragma unroll
    for (int r = 0; r < 8; ++r) { const size_t row = row0 + C.wave * 8 + r;
        hpA[r] = *(const u32x4*)(HP + row * LRU_W + cA); gtA[r] = *(const u32x2*)(P + row * NPROJ + COL_GT + cA);
        hpB[r] = *(const u32x4*)(HP + row * LRU_W + cB); gtB[r] = *(const u32x2*)(P + row * NPROJ + COL_GT + cB); }
    __syncthreads();
    if (C.tid < LRU_W) { const int ch = C.tid; float carry = 0.f; const f32x2* L0 = WSP(f32x2, WS_XN) + (size_t)b * NCH * LRU_W + ch;
        const f32x2* Z0 = WSP(f32x2, WS_CTL + 524288) + ch;
        const int nbat = (c + 31) / 32; int jb = c - nbat * 32;
        for (int bt = 0; bt < nbat; ++bt, jb += 32) { f32x2 ev[32];
#pragma unroll
            for (int u = 0; u < 32; ++u) { const int j = jb + u; const f32x2* s0 = j >= 0 ? L0 + (size_t)j * LRU_W : Z0; ev[u] = *s0; }
#pragma unroll
            for (int u = 0; u < 32; ++u) carry = ev[u].y * carry + ev[u].x; }
        CAR[ch] = carry; }
    __syncthreads();
    const f32x4 carA = *(const LAS f32x4*)(CAR + cA), carB = *(const LAS f32x4*)(CAR + cB);
    half_t* O = WSP(half_t, WS_O);
#pragma unroll
    for (int r = 0; r < 8; ++r) { const size_t row = row0 + C.wave * 8 + r;
        const h8 pa = __builtin_bit_cast(h8, hpA[r]), pb = __builtin_bit_cast(h8, hpB[r]);
        const f32x4 ga = unpk4(gtA[r]), gb = unpk4(gtB[r]);
        f32x4 oa = (f32x4){(float)pa[0], (float)pa[2], (float)pa[4], (float)pa[6]} + (f32x4){(float)pa[1], (float)pa[3], (float)pa[5], (float)pa[7]} * carA;
        f32x4 ob = (f32x4){(float)pb[0], (float)pb[2], (float)pb[4], (float)pb[6]} + (f32x4){(float)pb[1], (float)pb[3], (float)pb[5], (float)pb[7]} * carB;
        oa = (f32x4){oa.x * gelu_tanh(ga.x), oa.y * gelu_tanh(ga.y), oa.z * gelu_tanh(ga.z), oa.w * gelu_tanh(ga.w)};
        ob = (f32x4){ob.x * gelu_tanh(gb.x), ob.y * gelu_tanh(gb.y), ob.z * gelu_tanh(gb.z), ob.w * gelu_tanh(gb.w)};
        if (!hasB) ob = (f32x4){0.f, 0.f, 0.f, 0.f};
        const float ss = (oa.x * oa.x + oa.y * oa.y) + (oa.z * oa.z + oa.w * oa.w) + (ob.x * ob.x + ob.y * ob.y) + (ob.z * ob.z + ob.w * ob.w);
        const float rstd = 1.f / sqrtf(wave_sum(ss) * (1.f / 384.f) + EPS);
        { const f32x4 q = oa * rstd; u32x2 w; w.x = pkh(q.x, q.y); w.y = pkh(q.z, q.w); *(u32x2*)(O + row * D + 384 + cA) = w; }
        if (hasB) { const f32x4 q = ob * rstd; u32x2 w; w.x = pkh(q.x, q.y); w.y = pkh(q.z, q.w); *(u32x2*)(O + row * D + 384 + cB) = w; } }
}
template <bool FINAL>
__device__ __forceinline__ void s5_unit(const Ctx& C, int l, int b, int c) {
    constexpr int LDU = 264, LDB = 136;
    LAS half_t* UT = (LAS half_t*)C.lds;
    LAS half_t* SCR = (LAS half_t*)(C.lds + 34816) + C.wave * (2 * 16 * LDB);
    const half_t* P = WSP(half_t, WS_PROJ); const size_t row0 = (size_t)b * SEQ + c * CH_T;
    __syncthreads();
    for (int i = C.tid; i < 64 * 32; i += 512) { const int t = i >> 5, cc = i & 31; *(LAS u32x4*)(UT + t * LDU + cc * 8) = *(const u32x4*)(P + (row0 + t) * NPROJ + COL_U + cc * 8); }
    const int ar = C.lane & 15, kq = C.lane >> 4, p = C.lane;
    float xre[2] = {0.f, 0.f}, xim[2] = {0.f, 0.f};
    if constexpr (FINAL) {
        constexpr int FB = 32; float tre[2], tim[2]; const f32x2* E0 = WSP(f32x2, WS_S5E) + ((size_t)b * NCH * 16 + C.wave) * 64 + p;
#pragma unroll
        for (int gi = 0; gi < 2; ++gi) { const int lg = l * 16 + C.wave + 8 * gi; tre[gi] = WSP(float, SM_ABART)[2 * (lg * 64 + p)]; tim[gi] = WSP(float, SM_ABART)[2 * (lg * 64 + p) + 1]; }
        const f32x2* Z0 = WSP(f32x2, WS_CTL + 524288) + p;
        const int nbat = (c + FB - 1) / FB; int jb = c - nbat * FB;
        for (int bt = 0; bt < nbat; ++bt, jb += FB) { f32x2 ev[2][FB];
#pragma unroll
            for (int u = 0; u < FB; ++u) { const int j = jb + u; const f32x2* s0 = j >= 0 ? E0 + (size_t)j * 16 * 64 : Z0; const f32x2* s1 = j >= 0 ? E0 + (size_t)j * 16 * 64 + 8 * 64 : Z0; ev[0][u] = *s0; ev[1][u] = *s1; }
#pragma unroll
            for (int u = 0; u < FB; ++u) {
#pragma unroll
                for (int gi = 0; gi < 2; ++gi) { const float nre = tre[gi] * xre[gi] - tim[gi] * xim[gi] + ev[gi][u].x, nim = tre[gi] * xim[gi] + tim[gi] * xre[gi] + ev[gi][u].y; xre[gi] = nre; xim[gi] = nim; } } } }
    float are[2], aim[2]; f32x4 dskv[2]; h8 bfr[2][8], cfr[2][4];
#pragma unroll
    for (int gi = 0; gi < 2; ++gi) { const int g = C.wave + 8 * gi, lg = l * 16 + g;
        are[gi] = WSP(float, SM_ABAR)[2 * (lg * 64 + p)]; aim[gi] = WSP(float, SM_ABAR)[2 * (lg * 64 + p) + 1];
        const half_t* bbt = WSP(half_t, SM_BBT) + (size_t)lg * 128 * 32;
#pragma unroll
        for (int nt = 0; nt < 8; ++nt) bfr[gi][nt] = *(const h8*)(bbt + (nt * 16 + ar) * 32 + kq * 8);
        if constexpr (FINAL) { const half_t* cmt = WSP(half_t, SM_CMT) + (size_t)lg * 16 * 128;
#pragma unroll
            for (int ks = 0; ks < 4; ++ks) cfr[gi][ks] = *(const h8*)(cmt + ar * 128 + ks * 32 + kq * 8);
            dskv[gi] = *(const f32x4*)(WSP(float, PAR_S5D) + l * S5_W + g * 16 + 4 * kq); } }
    __syncthreads();
    for (int sc = 0; sc < 4; ++sc) {
#pragma unroll
        for (int gi = 0; gi < 2; ++gi) { const int g = C.wave + 8 * gi; LAS half_t* S = SCR + gi * (16 * LDB);
            h8 af = {}; if (kq < 2) af = *(const LAS h8*)(UT + (sc * 16 + ar) * LDU + g * 16 + kq * 8);
#pragma unroll
            for (int nt = 0; nt < 8; ++nt) { const f32x4 z = {0.f, 0.f, 0.f, 0.f}; const f32x4 r = __builtin_amdgcn_mfma_f32_16x16x32_f16(bfr[gi][nt], af, z, 0, 0, 0);
                u32x2 w; w.x = pkh(r[0], r[1]); w.y = pkh(r[2], r[3]); *(LAS u32x2*)(S + ar * LDB + nt * 16 + 4 * kq) = w; } }
        __syncthreads();
        { unsigned bw[2][16];
#pragma unroll
          for (int gi = 0; gi < 2; ++gi)
#pragma unroll
            for (int tt = 0; tt < 16; ++tt) bw[gi][tt] = ((const LAS unsigned*)(SCR + gi * (16 * LDB)))[tt * (LDB / 2) + p];
#pragma unroll
          for (int tt = 0; tt < 16; ++tt)
#pragma unroll
            for (int gi = 0; gi < 2; ++gi) { const h2 bu = __builtin_bit_cast(h2, bw[gi][tt]); const float bre = (float)bu[0], bim = (float)bu[1];
                const float nre = are[gi] * xre[gi] - aim[gi] * xim[gi] + bre, nim = are[gi] * xim[gi] + aim[gi] * xre[gi] + bim; xre[gi] = nre; xim[gi] = nim;
                if constexpr (FINAL) bw[gi][tt] = pkh(xre[gi], xim[gi]); }
          if constexpr (FINAL) {
#pragma unroll
            for (int gi = 0; gi < 2; ++gi)
#pragma unroll
              for (int tt = 0; tt < 16; ++tt) ((LAS unsigned*)(SCR + gi * (16 * LDB)))[tt * (LDB / 2) + p] = bw[gi][tt]; } }
        if constexpr (FINAL) {
            __syncthreads();
#pragma unroll
            for (int gi = 0; gi < 2; ++gi) { const int g = C.wave + 8 * gi; LAS half_t* S = SCR + gi * (16 * LDB);
                f32x4 y = {0.f, 0.f, 0.f, 0.f};
#pragma unroll
                for (int ks = 0; ks < 4; ++ks) { const h8 a = *(const LAS h8*)(S + ar * LDB + ks * 32 + kq * 8); y = __builtin_amdgcn_mfma_f32_16x16x32_f16(cfr[gi][ks], a, y, 0, 0, 0); }
                LAS u32x2* up = (LAS u32x2*)(UT + (sc * 16 + ar) * LDU + g * 16 + 4 * kq); const f32x4 uv = unpk4(*up); const f32x4 yv = y + dskv[gi] * uv;
                u32x2 w; w.x = pkh(gelu_tanh(yv.x), gelu_tanh(yv.y)); w.y = pkh(gelu_tanh(yv.z), gelu_tanh(yv.w)); *up = w; }
        }
        __syncthreads();
    }
    if constexpr (!FINAL) {
#pragma unroll
        for (int gi = 0; gi < 2; ++gi) WSP(f32x2, WS_S5E)[(((size_t)b * NCH + c) * 16 + C.wave + 8 * gi) * 64 + p] = (f32x2){xre[gi], xim[gi]}; }
    if constexpr (FINAL) {
        LAS float* OT = (LAS float*)(C.lds + 34816);
        const half_t* glut = WSP(half_t, SM_GLUT) + (size_t)l * 65536;
        h8 gf[2][8];
#pragma unroll
        for (int j = 0; j < 2; ++j)
#pragma unroll
            for (int ks = 0; ks < 8; ++ks) gf[j][ks] = *(const h8*)(glut + (size_t)((2 * C.wave + j) * 16 + ar) * 256 + ks * 32 + kq * 8);
#pragma unroll
        for (int j = 0; j < 2; ++j) { const int nt = 2 * C.wave + j; const f32x4 gb = *(const f32x4*)(WSP(float, PAR_GLUB) + l * S5_W + nt * 16 + 4 * kq);
#pragma unroll
            for (int mt = 0; mt < 4; ++mt) { f32x4 r = {0.f, 0.f, 0.f, 0.f};
#pragma unroll
                for (int ks = 0; ks < 8; ++ks) { const h8 a = *(const LAS h8*)(UT + (mt * 16 + ar) * LDU + ks * 32 + kq * 8); r = __builtin_amdgcn_mfma_f32_16x16x32_f16(gf[j][ks], a, r, 0, 0, 0); }
                const int t = mt * 16 + ar; const f32x4 yv = unpk4(*(const LAS u32x2*)(UT + t * LDU + nt * 16 + 4 * kq)); r = r + gb;
                *(LAS f32x4*)(OT + t * 260 + nt * 16 + 4 * kq) = (f32x4){yv.x * sigmoidf_(r.x), yv.y * sigmoidf_(r.y), yv.z * sigmoidf_(r.z), yv.w * sigmoidf_(r.w)}; } }
        __syncthreads();
        half_t* O = WSP(half_t, WS_O);
        for (int rr = 0; rr < 8; ++rr) { const int t = C.wave * 8 + rr; const f32x4 v = *(const LAS f32x4*)(OT + t * 260 + 4 * C.lane);
            const float ss = wave_sum((v.x * v.x + v.y * v.y) + (v.z * v.z + v.w * v.w)); const float rstd = 1.f / sqrtf(ss * (1.f / 256.f) + EPS);
            const f32x4 r = v * rstd; u32x2 w; w.x = pkh(r.x, r.y); w.y = pkh(r.z, r.w);
            *(u32x2*)(O + (row0 + t) * D + 768 + 4 * C.lane) = w; }
    }
}

__device__ __forceinline__ void moe_gather_rows(const Ctx& C, int nslots) {
    const unsigned char* X = WSP(unsigned char, WS_XN8); unsigned char* G = WSP(unsigned char, WS_XG8); const int* st = WSP(int, MO_SLOTTOK);
    for (int s = C.gw; s < nslots; s += C.NGW) { const int tok = st[s]; *((u32x4*)(G + (size_t)s * D) + C.lane) = *((const u32x4*)(X + (size_t)tok * D) + C.lane); }
}
__device__ __forceinline__ void moe_lists(const Ctx& C) {
    LAS int* cnt = (LAS int*)C.lds;
    LAS int* tot = cnt + 2048;
    const int* bc = WSP(int, MO_BLKCNT);
    u32x4 v[M / 256 / NWAVES];
    { const unsigned char* X = WSP(unsigned char, WS_XN8);
#pragma unroll
      for (int i = 0; i < M / 256 / NWAVES; ++i) { const int m = C.bid * (M / 256) + C.wave + NWAVES * i; v[i] = *((const u32x4*)(X + (size_t)m * D) + C.lane); } }
    __syncthreads();
    for (int i = C.tid; i < C.G * 8; i += 512) cnt[i] = bc[i];
    if (C.tid < 8) tot[32 + C.tid] = 0;
    __syncthreads();
    { const int e = C.wave; float t = 0.f, mine = 0.f;
      for (int k = C.lane; k < C.G; k += 64) { const float v = (float)cnt[k * 8 + e]; t += v; mine += (k < C.bid) ? v : 0.f; }
      t = wave_sum(t); mine = wave_sum(mine);
      if (C.lane == 0) { tot[e] = (int)t; tot[8 + e] = (int)mine; } }
    __syncthreads();
    if (C.tid == 0) { int base = 0; for (int e = 0; e < 8; ++e) { const int nt = (tot[e] + 255) >> 8; tot[16 + e] = base; tot[24 + e] = nt; base += nt * 256; } tot[40] = base >> 8; }
    __syncthreads();
    int* slot_tok = WSP(int, MO_SLOTTOK); int* tok_slot = WSP(int, MO_TOKSLOT); const int* sel = WSP(int, MO_SEL);
    { LAS int* wc = tot + 48;
      int e0 = 0, e1 = 0; const int mtok = C.bid * (M / 256) + C.tid;
      if (C.tid < 128) { const int s = sel[mtok]; e0 = s & 255; e1 = s >> 8; }
      const unsigned long long lt = (1ull << C.lane) - 1ull; int r0 = 0, r1 = 0;
      if (C.wave < 2) {
#pragma unroll
          for (int e = 0; e < 8; ++e) { const unsigned long long b0 = __ballot(e0 == e), b1 = __ballot(e1 == e);
              if (e0 == e) r0 = __popcll(b0 & lt); if (e1 == e) r1 = __popcll(b1 & lt);
              if (C.lane == 0) { wc[(C.wave * 2 + 0) * 8 + e] = __popcll(b0); wc[(C.wave * 2 + 1) * 8 + e] = __popcll(b1); } } }
      __syncthreads();
      if (C.tid < 128) { const int w = C.wave;
          const int s0 = tot[16 + e0] + tot[8 + e0] + (w == 1 ? wc[(0 * 2 + 0) * 8 + e0] : 0) + r0;
          const int s1 = tot[16 + e1] + tot[8 + e1] + wc[(0 * 2 + 0) * 8 + e1] + wc[(1 * 2 + 0) * 8 + e1] + (w == 1 ? wc[(0 * 2 + 1) * 8 + e1] : 0) + r1;
          slot_tok[s0] = mtok; slot_tok[s1] = mtok; tok_slot[2 * mtok] = s0; tok_slot[2 * mtok + 1] = s1; tot[64 + 2 * C.tid] = s0; tot[64 + 2 * C.tid + 1] = s1; } }
    __syncthreads();
    { const unsigned char* X = WSP(unsigned char, WS_XN8); unsigned char* G = WSP(unsigned char, WS_XG8);
#pragma unroll
      for (int i = 0; i < M / 256 / NWAVES; ++i) { const int r = C.wave + NWAVES * i; const int s0 = tot[64 + 2 * r], s1 = tot[64 + 2 * r + 1];
          *((u32x4*)(G + (size_t)s0 * D) + C.lane) = v[i]; *((u32x4*)(G + (size_t)s1 * D) + C.lane) = v[i]; } }
    if (C.bid < 8) {
        { const int e = C.bid; const int lo = tot[16 + e] + tot[e], hi = tot[16 + e] + tot[24 + e] * 256; for (int s = lo + C.tid; s < hi; s += 512) slot_tok[s] = 0;
            for (int i = C.tid; i < (hi - lo) * 64; i += 512) *((u32x4*)(WSP(unsigned char, WS_XG8) + (size_t)(lo + (i >> 6)) * D) + (i & 63)) = (u32x4){0u, 0u, 0u, 0u}; } }
    if (C.bid == 0) {
        int* texp = WSP(int, MO_TEXP);
        for (int t = C.tid; t < 512; t += 512) { int e = 0; for (int k = 0; k < 8; ++k) if (t * 256 >= tot[16 + k]) e = k; texp[t] = e; }
        if (C.tid == 0) __hip_atomic_store((gu32*)(WSP(unsigned, WS_CTL) + CW_NT), (unsigned)tot[40], RLX_AGENT);
    }
}

#ifdef DBG_CHECK
__device__ __forceinline__ void dbg_attn_check(const Ctx& C) {
    const half_t* P = WSP(half_t, WS_PROJ); const half_t* O = WSP(half_t, WS_O); float* acc = (float*)(WSP(unsigned, WS_CTL) + 256);
    for (int i = C.gw; i < 2048; i += C.NGW) {
#ifdef DBG_J
        const int s = ((i * 97 + 13) & 255) + 256 * DBG_J, h = i % 6, b = (i / 6) & 7, j = s >> 8; const size_t row = (size_t)b * SEQ + s; const int d = C.lane;
#else
        const int s = (i * 97 + 13) & 4095, h = i % 6, b = (i / 6) & 7, j = s >> 8; const size_t row = (size_t)b * SEQ + s; const int d = C.lane;
#endif
        const float qd = (float)P[row * NPROJ + h * 64 + d];
        const float* km = WSP(float, WS_KMEAN) + (size_t)(b * NH + h) * 16 * 64;
        float v1 = -INFINITY, v2 = -INFINITY, v3 = -INFINITY; int i1 = -1, i2 = -1, i3 = -1;
        for (int n = 0; n < j; ++n) { const float g = wave_sum(qd * km[n * 64 + d]);
            if (g > v1) { v3 = v2; i3 = i2; v2 = v1; i2 = i1; v1 = g; i1 = n; } else if (g > v2) { v3 = v2; i3 = i2; v2 = g; i2 = n; } else if (g > v3) { v3 = g; i3 = n; } }
        float m = -INFINITY, l = 0.f, od = 0.f;
        for (int pass = 0; pass < 2; ++pass)
            for (int blk = 0; blk <= j; ++blk) { if (blk < j && blk != i1 && blk != i2 && blk != i3) continue;
                const int kend = (blk == j) ? (s - blk * 256) : 255;
                for (int kk = 0; kk <= kend; ++kk) { const size_t kr = ((size_t)b * SEQ + blk * 256 + kk) * NPROJ + h * 64 + d;
                    const float sc = wave_sum(qd * (float)P[kr + COL_K]);
                    if (pass == 0) m = fmaxf(m, sc); else { const float p = exp2f(sc - m); l += p; od += p * (float)P[kr + COL_V]; } } }
        od /= l; const float mine = (float)O[row * D + h * 64 + d];
        const float e = wave_sum((od - mine) * (od - mine)), r = wave_sum(od * od);
        if (C.lane == 0) { atomicAdd(acc, e / r); atomicAdd(acc + 1, 1.f); }
    }
}
__device__ __forceinline__ void dbg_attn_check2(const Ctx& C, int l) {
    const half_t* P = WSP(half_t, WS_PROJ); const half_t* O = WSP(half_t, WS_O); float* acc = (float*)(WSP(unsigned, WS_CTL) + 256);
    const float* gain = WSP(float, PAR_GAIN) + (size_t)l * D;
    for (int i = C.gw; i < 512; i += C.NGW) {
        const int s = (i * 97 + 13) & 4095, b = i & 7, j = s >> 8; const size_t row = (size_t)b * SEQ + s; const int d = C.lane;
        float oh[6]; float ss = 0.f;
#pragma unroll
        for (int h = 0; h < 6; ++h) {
            const float qd = (float)P[row * NPROJ + h * 64 + d];
            const float* km = WSP(float, WS_KMEAN) + (size_t)(b * NH + h) * 16 * 64;
            float v1 = -INFINITY, v2 = -INFINITY, v3 = -INFINITY; int i1 = -1, i2 = -1, i3 = -1;
            for (int n = 0; n < j; ++n) { const float g = wave_sum(qd * km[n * 64 + d]);
                if (g > v1) { v3 = v2; i3 = i2; v2 = v1; i2 = i1; v1 = g; i1 = n; } else if (g > v2) { v3 = v2; i3 = i2; v2 = g; i2 = n; } else if (g > v3) { v3 = g; i3 = n; } }
            float m = -INFINITY, lsum = 0.f, od = 0.f;
            for (int pass = 0; pass < 2; ++pass)
                for (int blk = 0; blk <= j; ++blk) { if (blk < j && blk != i1 && blk != i2 && blk != i3) continue;
                    const int kend = (blk == j) ? (s - blk * 256) : 255;
                    for (int kk = 0; kk <= kend; ++kk) { const size_t kr = ((size_t)b * SEQ + blk * 256 + kk) * NPROJ + h * 64 + d;
                        const float sc = wave_sum(qd * (float)P[kr + COL_K]);
                        if (pass == 0) m = fmaxf(m, sc); else { const float p = exp2f(sc - m); lsum += p; od += p * (float)P[kr + COL_V]; } } }
            oh[h] = od / lsum; ss += oh[h] * oh[h];
        }
        const float msq_ = wave_sum(ss) * (1.f / 384.f); const float rstd = 1.f / sqrtf(msq_ + EPS); float e = 0.f, r = 0.f;
#ifdef DBG_MS
        if (C.lane == 0) { atomicAdd(acc + 6, msq_ * DBG_MS); atomicAdd(acc + 7, 1.f); }
#endif
#ifdef DBG_RHO
        { float sm = 0.f, so = 0.f, smo = 0.f;
#pragma unroll
          for (int h = 0; h < 6; ++h) { const float mv = (float)O[row * D + h * 64 + d]; sm += mv * mv; so += oh[h] * oh[h]; smo += mv * oh[h]; }
          sm = wave_sum(sm); so = wave_sum(so); smo = wave_sum(smo);
          if (C.lane == 0) { atomicAdd(acc + 6, smo * smo / (sm * so)); atomicAdd(acc + 7, 1.f); } }
#endif
#pragma unroll
        for (int h = 0; h < 6; ++h) {
#ifdef DBG_RAW
            const float want = oh[h],
#else
            const float want = oh[h] * rstd * gain[h * 64 + d],
#endif
            mine = (float)O[row * D + h * 64 + d]; const float eh = wave_sum((want - mine) * (want - mine)), rh = wave_sum(want * want); if (C.lane == 0) { atomicAdd(acc + 2 * (h >> 1 > 1 ? 1 : h >> 1 == 1 ? 2 : 0), eh); atomicAdd(acc + 2 * (h >> 1 > 1 ? 1 : h >> 1 == 1 ? 2 : 0) + 1, rh); } }
        (void)e; (void)r;
    }
}
__device__ __forceinline__ void dbg_meansq(const Ctx& C, int c0) {
    const half_t* O = WSP(half_t, WS_O); float* acc = (float*)(WSP(unsigned, WS_CTL) + 256);
    for (int i = C.gw; i < 4096; i += C.NGW) { const size_t row = ((size_t)i * 7919 + 3) % M; float s = 0.f;
        for (int k = 0; k < 6; ++k) { const float v = (float)O[row * D + c0 + C.lane + 64 * k]; s += v * v; }
        s = wave_sum(s); if (C.lane == 0) { atomicAdd(acc, s); atomicAdd(acc + 1, 384.f); } }
}
__device__ __forceinline__ void dbg_out_check(const Ctx& C, int l, const float* xin, const float* xres) {
    const half_t* O = WSP(half_t, WS_O); float* acc = (float*)(WSP(unsigned, WS_CTL) + 256);
    const float* W = KARG(float, I_W_OUT) + (size_t)l * D * D; const float* mod = WSP(float, WS_MOD) + (size_t)l * 8 * 6144;
    for (int i = C.gw; i < 256 * 16; i += C.NGW) {
        const int cg = i & 15, sr = i >> 4; const size_t row = ((size_t)sr * 12347 + 101) % M; const int n = cg * 64 + C.lane, b = (int)(row >> 12);
        float a = 0.f;
        for (int k = 0; k < D; ++k) a += (float)O[row * D + k] * W[(size_t)k * D + n];
        const float want = xin[row * D + n] + mod[(size_t)b * 6144 + 2048 + n] * a, mine = xres[row * D + n];
        const float e = wave_sum((want - mine) * (want - mine)), r = wave_sum((want - xin[row * D + n]) * (want - xin[row * D + n]));
        if (C.lane == 0) { atomicAdd(acc, e); atomicAdd(acc + 1, r); }
    }
}
__device__ __forceinline__ float fp8_dec(unsigned char b) { return __builtin_amdgcn_cvt_f32_fp8((int)b, 0); }
__device__ __forceinline__ void dbg_moeup_check(const Ctx& C) {
    const unsigned char* X = WSP(unsigned char, WS_XG8); const unsigned char* Wt = WSP(unsigned char, WS_MGU); const unsigned char* H = WSP(unsigned char, WS_HID); const int* texp = WSP(int, MO_TEXP);
    float* acc = (float*)(WSP(unsigned, WS_CTL) + 256);
    for (int i = C.gw; i < 4096; i += C.NGW) { const int s = (i * 131 + 7) & 16383, j = (i * 977 + 5) % FFE, e = texp[s >> 8];
        const int tile = j >> 7, w = j & 127; const unsigned char* wg = Wt + ((size_t)e * 2 * FFE + tile * 256 + w) * D; const unsigned char* wu = wg + (size_t)128 * D;
        float g = 0.f, u = 0.f;
        for (int k = DBG_K0 + C.lane; k < DBG_K1; k += 64) { const float x = fp8_dec(X[(size_t)s * D + k]); g += x * fp8_dec(wg[k]); u += x * fp8_dec(wu[k]); }
        for (int o = 1; o < 64; o <<= 1) { g += __shfl_xor(g, o); u += __shfl_xor(u, o); }
        g *= (1.f / 32.f); u *= (1.f / 32.f);
        const float want = siluf_(g) * u, mine = fp8_dec(H[(size_t)s * FFE + j]);
        if (C.lane == 0) { atomicAdd(acc, (want - mine) * (want - mine)); atomicAdd(acc + 1, want * want); } }
}
__device__ __forceinline__ f32x4 dbg_mfma8(v8i_t a, v8i_t b) { f32x4 c = {0.f, 0.f, 0.f, 0.f}; asm volatile("s_nop 15\n\ts_nop 15\n\tv_mfma_f32_16x16x128_f8f6f4 %0, %1, %2, %0\n\ts_nop 15\n\ts_nop 15" : "+v"(c) : "v"(a), "v"(b)); return c; }
__device__ __forceinline__ void dbg_mfma_probe(const Ctx& C) {
    if (C.bid != 0 || C.wave != 0) return;
    float* acc = (float*)(WSP(unsigned, WS_CTL) + 256); const int fq = C.lane >> 4; const int ONE = 0x38383838;
    v8i_t all1; for (int r = 0; r < 8; ++r) all1[r] = ONE;
    v8i_t r0 = {ONE, 0, 0, 0, 0, 0, 0, 0}, r1 = {0, ONE, 0, 0, 0, 0, 0, 0}, r4 = {0, 0, 0, 0, ONE, 0, 0, 0}, z = {0, 0, 0, 0, 0, 0, 0, 0};
    v8i_t g0 = fq == 0 ? all1 : z, g1 = fq == 1 ? all1 : z;
    const float d1 = dbg_mfma8(all1, all1)[0], d2 = dbg_mfma8(r0, r0)[0], d3 = dbg_mfma8(r0, r1)[0], d4 = dbg_mfma8(g0, g0)[0], d5 = dbg_mfma8(g0, g1)[0], d6 = dbg_mfma8(r0, r4)[0];
    v8i_t b0 = {0x38, 0, 0, 0, 0, 0, 0, 0}, b1 = {0x3800, 0, 0, 0, 0, 0, 0, 0};
    const float d7 = dbg_mfma8(b0, b0)[0], d8 = dbg_mfma8(b0, b1)[0];
    v8i_t arow3 = (C.lane & 15) == 3 ? all1 : z, bcol5 = (C.lane & 15) == 5 ? all1 : z;
    const f32x4 e1 = dbg_mfma8(arow3, all1), e2 = dbg_mfma8(all1, bcol5);
    const float e2l5 = __builtin_bit_cast(float, __builtin_amdgcn_readlane(__builtin_bit_cast(int, e2[0]), 5)), e2l4 = __builtin_bit_cast(float, __builtin_amdgcn_readlane(__builtin_bit_cast(int, e2[0]), 4));
    const float e1l17 = __builtin_bit_cast(float, __builtin_amdgcn_readlane(__builtin_bit_cast(int, e1[3]), 17));
    float wsv = (float)C.lane; asm volatile("" : "+v"(wsv)); const float ws_total = wave_sum(wsv); const float x1 = xor_lane<1>(wsv), x16 = xor_lane<16>(wsv);
    float h32 = wsv; h32 += xor_lane<1>(h32); h32 += xor_lane<2>(h32); h32 += xor_lane<4>(h32); h32 += xor_lane<8>(h32); h32 += xor_lane<16>(h32);
    if (C.lane == 0) {
#if DBG_PROBE == 6
        atomicAdd(acc, DBG_PSEL == 0 ? ws_total : DBG_PSEL == 1 ? x1 + 100.f * x16 : h32);
        atomicAdd(acc + 1, 0.f);
#elif DBG_PROBE == 66
        { }
#elif DBG_PROBE == 5
        { float one = 1.0f; asm volatile("" : "+v"(one)); const int enc = __builtin_amdgcn_cvt_pk_fp8_f32(one, one, 0, false) & 0xff; int b38 = 0x38; asm volatile("" : "+v"(b38)); const float dec = __builtin_amdgcn_cvt_f32_fp8(b38, 0);
          atomicAdd(acc, (enc == 0x38 ? 1.f : enc == 0x40 ? 2.f : 3.f) + (dec == 1.0f ? 10.f : dec == 0.5f ? 20.f : 30.f)); }
#elif DBG_PROBE == 4
        atomicAdd(acc, (e1[3] == 128.f ? 1.f : 0.f) + (e1[0] == 0.f ? 2.f : 0.f) + (e2l5 == 128.f ? 4.f : 0.f) + (e2l4 == 0.f ? 8.f : 0.f) + (e1l17 == 0.f ? 16.f : 0.f));
#elif DBG_PROBE == 0
        atomicAdd(acc, d1);
#elif DBG_PROBE == 1
        atomicAdd(acc, (d2 == 16.f ? 1.f : 0.f) + (d3 == 0.f ? 2.f : 0.f) + (d4 == 32.f ? 4.f : 0.f) + (d5 == 0.f ? 8.f : 0.f) + (d6 == 0.f ? 16.f : 0.f) + (d7 == 4.f ? 32.f : 0.f));
#elif DBG_PROBE == 2
        atomicAdd(acc, d2 + 100.f * d4);
#else
        atomicAdd(acc, d7 + 10.f * d8 + 100.f * d3 + 1000.f * d5);
#endif
        atomicAdd(acc + 1, 100.f); }
}
__device__ __forceinline__ void dbg_proj_check(const Ctx& C, int l) {
    const half_t* P = WSP(half_t, WS_PROJ); const half_t* X = WSP(half_t, WS_XN); float* acc = (float*)(WSP(unsigned, WS_CTL) + 256);
    const float* W = KARG(float, I_W_IN) + (size_t)l * D * NPROJ; const int* pos = KARG(int, I_POS);
    for (int i = C.gw; i < 256 * 34; i += C.NGW) {
        const int grp = i % 34, sr = i / 34; const size_t row = ((size_t)sr * 12347 + 101) % M; const int d = C.lane, col = grp * 64 + d;
        float a = 0.f;
        for (int k = 0; k < D; ++k) a += (float)X[row * D + k] * W[(size_t)k * NPROJ + col];
        float outv = a;
        if (grp < 12) { const float partner = __shfl_xor(a, 32); const int fi = d & 31; const float ang = (float)pos[row] * powf(10000.f, -(float)fi / 32.f); const float cs = cosf(ang), sn = sinf(ang);
            outv = (d < 32) ? a * cs - partner * sn : a * cs + partner * sn; if (grp < 6) outv *= C2; }
        const float mine = (float)P[row * NPROJ + col];
        const float e = wave_sum((outv - mine) * (outv - mine)), r = wave_sum(outv * outv); const int sel = grp < 6 ? 0 : grp < 12 ? 1 : grp < 18 ? 2 : 3;
        if (C.lane == 0) { atomicAdd(acc + 2 * sel, e); atomicAdd(acc + 2 * sel + 1, r); }
    }
}
__device__ __forceinline__ void dbg_emit(const Ctx& C, float* out) {
    const float* acc = (const float*)(WSP(unsigned, WS_CTL) + 256); float worst = 0.f;
#ifndef DBG_SEL
    for (int k = 0; k < 4; ++k) { const float e = __hip_atomic_load(acc + 2 * k, RLX_AGENT), r = __hip_atomic_load(acc + 2 * k + 1, RLX_AGENT); if (r > 0.f) worst = fmaxf(worst, e / r); }
#else
    { const float e = __hip_atomic_load(acc + 2 * DBG_SEL, RLX_AGENT), r = __hip_atomic_load(acc + 2 * DBG_SEL + 1, RLX_AGENT); worst = e / fmaxf(r, 1e-30f); }
#endif
#ifdef DBG_BUCKET
    const float c = worst > 0.f ? 2.f + 2.f * floorf(log10f(worst)) : 0.f;
#else
    const float c = sqrtf(100.f * worst);
#endif
    for (size_t i = (size_t)C.bid * 512 + C.tid; i < (size_t)M * D; i += (size_t)C.G * 512) out[i] = c;
}
#endif

#ifdef DBG_SNAP
#define DBG_EXTRA_WS (20u << 20)
#else
#define DBG_EXTRA_WS 0
#endif
#ifndef MK_N_LAUNCHES
#define MK_N_LAUNCHES 1
#endif
constexpr int NPHASE = 2 + 8 + (4 + 2 + 2 * MOE_NCHUNK + 1);

__global__ void __launch_bounds__(NWAVES * 64, 2) mk_fwd(Args A_unused) {
    extern __shared__ __attribute__((aligned(16))) unsigned char lds_raw[];
    Ctx C0; { Ctx& C = C0; C.lds = (LAS unsigned char*)lds_raw; C.tid = threadIdx.x; C.lane = C.tid & 63; C.wave = __builtin_amdgcn_readfirstlane(C.tid >> 6);
    C.G = gridDim.x; C.bid = blockIdx.x; C.gw = C.bid * NWAVES + C.wave; C.NGW = C.G * NWAVES; C.ws = (unsigned char*)karg(I_WS); }
    const Ctx& C = C0;
    volatile LAS unsigned* MISC = (volatile LAS unsigned*)(C.lds + MISC_OFF);
    unsigned* ctl = (unsigned*)(GAS unsigned*)((unsigned long long)C.ws + WS_CTL);
    for (int u = C.tid; u < (LDS_BYTES - LDSCTL_OFF) / 4; u += NWAVES * 64) ((LAS unsigned*)(C.lds + LDSCTL_OFF))[u] = 0u;
    __syncthreads();
    XcdBarrier bar = xcd_barrier_post(ctl + CW_BAR, MISC + 8);
    const int lo = A_unused.ph_lo, hi = A_unused.ph_hi; int pid = 0;
#define OPAQUE_CTX(Cn, Co) Ctx Cn = Co; { unsigned long long w_ = (unsigned long long)Cn.ws; unsigned l_ = (unsigned)(uintptr_t)Cn.lds; unsigned z_ = 0u; asm volatile("" : "+v"(z_)); Cn.lane = (int)__builtin_amdgcn_mbcnt_hi(~0u, __builtin_amdgcn_mbcnt_lo(~0u, z_)); Cn.tid = Cn.wave * 64 + Cn.lane; \
    asm volatile("" : "+s"(Cn.wave), "+s"(Cn.bid), "+s"(Cn.gw), "+s"(w_), "+s"(l_)); Cn.ws = (unsigned char*)w_; Cn.lds = (LAS unsigned char*)(uintptr_t)l_; }
#define WSQ(Cx, T, off) ((T*)(GAS T*)((unsigned long long)Cx.ws + (off)))
#ifndef DBG_REPMASK
#define DBG_REPMASK 0ull
#endif
#define PH_BEGIN if (lo <= pid && pid < hi) { const int nrep_ = ((DBG_REPMASK >> pid) & 1ull) ? 2 : 1; for (int rep_ = 0; rep_ < nrep_; ++rep_) { OPAQUE_CTX(C, C0)
#define PH_END if (rep_ + 1 < nrep_) { XcdBarrier b3_ = bar; asm volatile("" : "+s"(b3_.bar)); xcd_barrier(b3_); } } } if (lo <= pid && pid + 1 < hi) { XcdBarrier b2_ = bar; asm volatile("" : "+s"(b2_.bar)); xcd_barrier(b2_); } ++pid;
    half_t* xres = WSP(half_t, WS_RES);
    float* mod = WSP(float, WS_MOD);

#if defined(DBG_CHECK) && DBG_CHECK == 11
    PH_BEGIN dbg_mfma_probe(C); PH_END  PH_BEGIN dbg_emit(C, (float*)(GAS float*)(unsigned long long)karg(I_OUT)); PH_END
#endif
    PH_BEGIN p0_prologue(C); PH_END
    PH_BEGIN row_pass_xn<false>(C, KARG(float, I_X), WSP(float, PAR_N1G), mod + 0, mod + 1024, WSP(half_t, WS_XN), nullptr, nullptr); PH_END

    for (int l = 0; l < 2; ++l) {
        const float* modl = mod + (size_t)l * 8 * 6144;
        PH_BEGIN
            pg8::Gemm g{WSP(half_t, WS_XN), WSP(half_t, WS_WIN) + (size_t)l * NPROJ_PAD * D, M, NPROJ_PAD, D, nullptr}; pg8::StaticOrder S; S.init(M, NPROJ_PAD, C.G, C.bid);
            EpiProj E{WSP(half_t, WS_PROJ), WSP(float, WS_ROPE_C), WSP(float, WS_ROPE_S)};
            pg8::gemm_phase<EpiProj, pg8::StaticOrder, true, true, false>(C.lds, g, S, E, C.wave);
        PH_END
#if defined(DBG_CHECK) && DBG_CHECK == 2
        if (l == 0) { PH_BEGIN dbg_proj_check(C, l); PH_END  PH_BEGIN dbg_emit(C, (float*)(GAS float*)(unsigned long long)karg(I_OUT)); PH_END }
#endif
        PH_BEGIN
#ifndef DBG_PREPREP
#define DBG_PREPREP 0
#endif
            kmean_items(C);
            for (int pr_ = 0; pr_ < ((DBG_PREPREP & 1) ? 2 : 1); ++pr_)
            for (int u = C.bid; u < BATCH * NCH; u += C.G) { OPAQUE_CTX(Cu, C) lru_prep_unit(Cu, l, u / NCH, u % NCH); }
            for (int pr_ = 0; pr_ < ((DBG_PREPREP & 2) ? 2 : 1); ++pr_)
            for (int u = C.bid; u < BATCH * NCH; u += C.G) { OPAQUE_CTX(Cu, C) s5_unit<false>(Cu, l, u / NCH, u % NCH); }
        PH_END
        PH_BEGIN
            unsigned* qw = ctl + (l == 0 ? CW_Q0 : CW_Q1) + 320 * rep_;
            constexpr int NATT = BATCH * NH * 16, NSC = BATCH * NCH;
            unsigned nxt_ = 0u; if (C.tid == 0) nxt_ = __hip_atomic_fetch_add(qw, 1u, RLX_AGENT);
            for (;;) {
                __syncthreads();
                if (C.tid == 0) MISC[0] = nxt_;
                __syncthreads();
#ifndef DBG_MIXREP
#define DBG_MIXREP 0
#endif
                constexpr int RA = (DBG_MIXREP & 1) ? 2 : 1, RS = (DBG_MIXREP & 2) ? 2 : 1, RL = (DBG_MIXREP & 4) ? 2 : 1;
                int idx = (int)MISC[0];
                if (idx >= RA * NATT + (RS + RL) * NSC) break;
                if (C.tid == 0) nxt_ = __hip_atomic_fetch_add(qw, 1u, RLX_AGENT);
                if (idx < RA * NATT) idx %= NATT; else { idx -= RA * NATT; if (idx < RS * NSC) idx = NATT + idx % NSC; else idx = NATT + NSC + (idx - RS * NSC) % NSC; }
                OPAQUE_CTX(Cu, C)
                if (idx < NATT) { const int j = 15 - idx / (BATCH * NH), bh = idx % (BATCH * NH), b = bh / NH, h = bh % NH;
                    attn_body::attn_unit<8>(b, h, j, WSQ(Cu, half_t, WS_PROJ), WSQ(Cu, half_t, WS_PROJ) + COL_K, WSQ(Cu, half_t, WS_PROJ) + COL_V, WSQ(Cu, half_t, WS_O), WSQ(Cu, float, WS_KMEAN) + (size_t)bh * 16 * 64, WSQ(Cu, float, WS_SSQ), (LAS char*)Cu.lds, Cu.wave); }
                else if (idx < NATT + NSC) { const int u = idx - NATT; s5_unit<true>(Cu, l, u / NCH, u % NCH); }
                else { const int u = idx - NATT - NSC; lru_final_unit(Cu, l, u / NCH, u % NCH); }
            }
        PH_END
#if defined(DBG_CHECK) && DBG_CHECK == 1
        if (l == 0) { PH_BEGIN dbg_attn_check(C); PH_END  PH_BEGIN dbg_emit(C, (float*)(GAS float*)(unsigned long long)karg(I_OUT)); PH_END }
#endif
#if defined(DBG_CHECK) && DBG_CHECK == 5
        if (l == 0) { PH_BEGIN dbg_attn_check2(C, l); PH_END  PH_BEGIN dbg_emit(C, (float*)(GAS float*)(unsigned long long)karg(I_OUT)); PH_END }
#endif
#if defined(DBG_CHECK) && DBG_CHECK == 4
        if (l == 0) { PH_BEGIN dbg_meansq(C, DBG_C0); PH_END  PH_BEGIN dbg_emit(C, (float*)(GAS float*)(unsigned long long)karg(I_OUT)); PH_END }
#endif
#if defined(DBG_CHECK) && DBG_CHECK == 3
        if (l == 0) { PH_BEGIN dbg_attn_check2(C, l); PH_END  PH_BEGIN dbg_emit(C, (float*)(GAS float*)(unsigned long long)karg(I_OUT)); PH_END }
#endif
        PH_BEGIN
            pg8::Gemm g{WSP(half_t, WS_O), WSP(half_t, WS_WOUT) + (size_t)l * D * D, M, D, D, nullptr, WSP(float, WS_SSQ), 6}; pg8::StaticOrder S; S.init(M, D, C.G, C.bid);
            if (l == 0) { EpiResidT<float> E{KARG(float, I_X), xres, modl + 2048, 1.f}; pg8::gemm_phase<EpiResidT<float>, pg8::StaticOrder, true, true, false>(C.lds, g, S, E, C.wave); }
            else { EpiResidT<half_t> E{xres, xres, modl + 2048, 1.f}; pg8::gemm_phase<EpiResidT<half_t>, pg8::StaticOrder, true, true, false>(C.lds, g, S, E, C.wave); }
        PH_END
#if defined(DBG_CHECK) && DBG_CHECK == 6
        if (l == 0) { PH_BEGIN dbg_out_check(C, l, KARG(float, I_X), xres); PH_END  PH_BEGIN dbg_emit(C, (float*)(GAS float*)(unsigned long long)karg(I_OUT)); PH_END }
#endif
        if (l == 0) {
            PH_BEGIN row_pass_xn<false, DENSE_FP8 != 0>(C, xres, WSP(float, PAR_N2G), modl + 3072, modl + 4096, WSP(half_t, WS_XN), nullptr, nullptr); PH_END
            PH_BEGIN
#if DENSE_FP8
                pg8::Gemm g{WSP(unsigned char, WS_XN), WSP(unsigned char, WS_WGU), M, 2 * FF, D, nullptr, nullptr, 0}; pg8::StaticOrder S; S.init(M, 2 * FF, C.G, C.bid);
                EpiSwiglu8 E{WSP(unsigned char, WS_HID), FF, 1.f / 32.f};
                pg8::gemm_phase<EpiSwiglu8, pg8::StaticOrder, true, true, false, true>(C.lds, g, S, E, C.wave);
#else
                pg8::Gemm g{WSP(half_t, WS_XN), WSP(half_t, WS_WGU), M, 2 * FF, D, nullptr, nullptr, 0}; pg8::StaticOrder S; S.init(M, 2 * FF, C.G, C.bid);
                EpiSwiglu E{WSP(half_t, WS_HID), FF};
                pg8::gemm_phase<EpiSwiglu, pg8::StaticOrder, true, true, false>(C.lds, g, S, E, C.wave);
#endif
            PH_END
            PH_BEGIN
#if DENSE_FP8
                pg8::Gemm g{WSP(unsigned char, WS_HID), WSP(unsigned char, WS_WD), M, D, FF, nullptr, nullptr, 0}; pg8::StaticOrder S; S.init(M, D, C.G, C.bid);
                EpiResidT<half_t> E{xres, xres, modl + 5120, 1.f / 64.f};
                pg8::gemm_phase<EpiResidT<half_t>, pg8::StaticOrder, true, true, false, true>(C.lds, g, S, E, C.wave);
#else
                pg8::Gemm g{WSP(half_t, WS_HID), WSP(half_t, WS_WD), M, D, FF, nullptr, nullptr, 0}; pg8::StaticOrder S; S.init(M, D, C.G, C.bid);
                EpiResidT<half_t> E{xres, xres, modl + 5120, 1.f};
                pg8::gemm_phase<EpiResidT<half_t>, pg8::StaticOrder, true, true, false>(C.lds, g, S, E, C.wave);
#endif
            PH_END
            PH_BEGIN row_pass_xn<false>(C, xres, WSP(float, PAR_N1G) + D, mod + 8 * 6144 + 0, mod + 8 * 6144 + 1024, WSP(half_t, WS_XN), nullptr, nullptr); PH_END
        } else {
            PH_BEGIN
                LAS unsigned* lcnt = (LAS unsigned*)C.lds;
                __syncthreads(); if (C.tid < 8) lcnt[C.tid] = 0u; __syncthreads();
                row_pass_xn<true>(C, xres, WSP(float, PAR_N2G) + D, modl + 3072, modl + 4096, (half_t*)WSP(unsigned char, WS_XN8), WSP(float, PAR_ROUTER), lcnt);
                __syncthreads(); if (C.tid < 8) WSP(int, MO_BLKCNT)[C.bid * 8 + C.tid] = (int)lcnt[C.tid];
            PH_END
            PH_BEGIN moe_lists(C); PH_END
            for (int ch = 0; ch < MOE_NCHUNK; ++ch) {
                PH_BEGIN
                    const int NT = (int)__hip_atomic_load((gu32*)(ctl + CW_NT), RLX_AGENT); const int nt0 = NT > MOE_REG_TILES ? NT - MOE_REG_TILES : NT; const int t0 = ch == 0 ? 0 : nt0; const int nt = ch == 0 ? nt0 : NT - nt0;
#ifdef DBG_MOE_UP_COPY
                    if (nt > 0) { const int* st = WSP(int, MO_SLOTTOK) + t0 * 256; half_t* H = WSP(half_t, WS_HID); const half_t* X = WSP(half_t, WS_XN);
                        for (size_t i = (size_t)C.bid * 512 + C.tid; i < (size_t)nt * 256 * FFE; i += (size_t)C.G * 512) { const int r = (int)(i / FFE), k = (int)(i % FFE); H[i] = X[(size_t)st[r] * D + (k & 1023)] * (half_t)0.05f; } }
                    if (false) {
#else
                    if (nt > 0) {
#endif
#ifdef DBG_NOGATHER
                        pg8::Gemm g{WSP(half_t, WS_XN) + (size_t)((t0 * 256) % 16384) * D, WSP(half_t, WS_MGU), nt * 256, 2 * FFE, D, nullptr};
                        pg8::MoeOrder S; S.so.init(nt * 256, 2 * FFE, C.G, C.bid); S.texp = WSP(int, MO_TEXP) + t0; S.nNe = 2 * FFE / 256;
                        EpiSwiglu E{WSP(half_t, WS_HID), FFE};
                        pg8::gemm_phase<EpiSwiglu, pg8::MoeOrder, true, true, false>(C.lds, g, S, E, C.wave);
#else
                        int T = 0;
                        if (ch == 1 && nt0 > MOE_REG_TILES) {
                            const int ntt = nt0 - MOE_REG_TILES; T = ntt * 4;
                            pg8::Gemm g{WSP(unsigned char, WS_HID) + (size_t)MOE_REG_TILES * 256 * FFE, WSP(unsigned char, WS_MD), ntt * 256, D, FFE, nullptr, nullptr, 0};
                            pg8::MoeOrder S; S.so.init(ntt * 256, D, C.G, C.bid); S.texp = WSP(int, MO_TEXP) + MOE_REG_TILES; S.nNe = D / 256;
                            EpiY E{WSP(half_t, WS_Y) + (size_t)MOE_REG_TILES * 256 * D, 1.f / 64.f};
                            pg8::gemm_phase<EpiY, pg8::MoeOrder, true, true, false, true>(C.lds, g, S, E, C.wave);
                        }
                        pg8::Gemm g{WSP(unsigned char, WS_XG8) + (size_t)t0 * 256 * D, WSP(unsigned char, WS_MGU), nt * 256, 2 * FFE, D, nullptr, nullptr, 0};
                        pg8::MoeSkewOrder S; S.so.init(nt * 256, 2 * FFE, C.G, C.bid); S.texp = WSP(int, MO_TEXP) + t0; S.nNe = 2 * FFE / 256; S.T = T;
                        EpiSwiglu8 E{WSP(unsigned char, WS_HID), FFE, 1.f / 32.f};
                        pg8::gemm_phase<EpiSwiglu8, pg8::MoeSkewOrder, true, true, false, true>(C.lds, g, S, E, C.wave);
#endif
                    }
                PH_END
#if defined(DBG_CHECK) && DBG_CHECK == 10
                if (ch == 0) { PH_BEGIN dbg_moeup_check(C); PH_END  PH_BEGIN dbg_emit(C, (float*)(GAS float*)(unsigned long long)karg(I_OUT)); PH_END }
#endif
                PH_BEGIN
                    const int NT = (int)__hip_atomic_load((gu32*)(ctl + CW_NT), RLX_AGENT); const int nt0 = NT > MOE_REG_TILES ? NT - MOE_REG_TILES : NT; const int t0 = ch == 0 ? 0 : nt0; const int nt = ch == 0 ? nt0 : NT - nt0;
#ifdef DBG_MOE_DOWN_COPY
                    if (nt > 0) { const half_t* H = WSP(half_t, WS_HID); half_t* Yc = WSP(half_t, WS_Y) + (size_t)t0 * 256 * D;
                        for (size_t i = (size_t)C.bid * 512 + C.tid; i < (size_t)nt * 256 * D; i += (size_t)C.G * 512) { const int r = (int)(i / D), k = (int)(i % D); Yc[i] = H[(size_t)r * FFE + k] + H[(size_t)r * FFE + 1024 + k] + H[(size_t)r * FFE + 2048 + k]; } }
                    if (false) {
#else
                    if (nt > 0) {
#endif
                        const int ntr = nt > MOE_REG_TILES ? MOE_REG_TILES : nt;
                        pg8::Gemm g{WSP(unsigned char, WS_HID), WSP(unsigned char, WS_MD), ntr * 256, D, FFE, nullptr, nullptr, 0};
                        pg8::MoeOrder S; S.so.init(ntr * 256, D, C.G, C.bid); S.texp = WSP(int, MO_TEXP) + t0; S.nNe = D / 256;
                        EpiY E{WSP(half_t, WS_Y) + (size_t)t0 * 256 * D, 1.f / 64.f};
                        pg8::gemm_phase<EpiY, pg8::MoeOrder, true, true, false, true>(C.lds, g, S, E, C.wave);
                    }
                PH_END
            }
            PH_BEGIN row_pass_final(C, xres, (float*)(GAS float*)(unsigned long long)karg(I_OUT), modl + 5120, WSP(float, PAR_FG)); PH_END
        }
    }
#ifdef DBG_EXTRABAR
    for (int eb_ = 0; eb_ < DBG_EXTRABAR; ++eb_) { XcdBarrier b4_ = bar; asm volatile("" : "+s"(b4_.bar)); xcd_barrier(b4_); }
#endif
#ifdef DBG_SNAP
    constexpr size_t SNAP_OFF = 553 * MiB, SNAP_N = 4u << 20;
#ifndef DBG_IDX
#define DBG_IDX(i) ((i) * DBG_STRIDE)
#endif
#if DBG_SRC_MIB < 0
    const unsigned* dsrc = (const unsigned*)xres;
#else
    const unsigned* dsrc = WSP(unsigned, (size_t)DBG_SRC_MIB * MiB);
#endif
    PH_BEGIN { unsigned* snap = WSP(unsigned, SNAP_OFF); for (size_t i = (size_t)C.bid * 512 + C.tid; i < SNAP_N; i += (size_t)C.G * 512) snap[i] = dsrc[DBG_IDX(i)]; } PH_END
    PH_BEGIN if (C.bid == 0 && C.tid == 0) { __hip_atomic_store(ctl + CW_Q0, 0u, RLX_AGENT); __hip_atomic_store(ctl + CW_Q1, 0u, RLX_AGENT); } PH_END
    PH_BEGIN { const unsigned* snap = WSP(unsigned, SNAP_OFF); float* acc = (float*)(ctl + 256); float cnt = 0.f;
               for (size_t i = (size_t)C.bid * 512 + C.tid; i < SNAP_N; i += (size_t)C.G * 512) cnt += (snap[i] != dsrc[DBG_IDX(i)]) ? 1.f : 0.f;
               cnt = wave_sum(cnt); if (C.lane == 0 && cnt > 0.f) atomicAdd(acc, cnt);
               if (C.bid == 0 && C.tid == 0) atomicAdd(acc + 1, 1.f); } PH_END
    PH_BEGIN dbg_emit(C, (float*)(GAS float*)(unsigned long long)karg(I_OUT)); PH_END
#endif
#undef PH_BEGIN
#undef PH_END
}

extern "C" void kernel_launch(void* const* d_in, const int* in_sizes, int n_in, void* d_out, int out_size, void* d_ws, size_t ws_size, hipStream_t stream) {
    static int grid = 0;
    if (grid == 0) {
        if (n_in != 35 || in_sizes[0] != M * D || out_size != M * D || ws_size < WS_END + DBG_EXTRA_WS) { fprintf(stderr, "kernel_launch: unexpected problem (n_in %d, in0 %d, out %d, ws %zu < %zu)\n", n_in, n_in > 0 ? in_sizes[0] : -1, out_size, ws_size, (size_t)WS_END); grid = -1; return; }
        int dev = 0, cus = 0, per_cu = 0;
        if (hipGetDevice(&dev) != hipSuccess || hipDeviceGetAttribute(&cus, hipDeviceAttributeMultiprocessorCount, dev) != hipSuccess) { grid = -1; return; }
        if (hipFuncSetAttribute((const void*)mk_fwd, hipFuncAttributeMaxDynamicSharedMemorySize, LDS_BYTES) != hipSuccess) { fprintf(stderr, "kernel_launch: hipFuncSetAttribute failed\n"); grid = -1; return; }
        if (hipOccupancyMaxActiveBlocksPerMultiprocessor(&per_cu, (const void*)mk_fwd, NWAVES * 64, LDS_BYTES) != hipSuccess || per_cu < 1) { fprintf(stderr, "kernel_launch: occupancy query says %d blocks per CU\n", per_cu); grid = -1; (void)hipGetLastError(); return; }
        (void)hipGetLastError();
        if (cus < 256) { fprintf(stderr, "kernel_launch: needs 256 CUs\n"); grid = -1; return; }
        grid = 256;
    }
    if (grid < 0) return;
    if (hipMemsetAsync((char*)d_ws + WS_CTL, 0, CTL_ZERO_BYTES, stream) != hipSuccess) return;
    Args a{};
    for (int i = 0; i < 35; ++i) a.in[i] = d_in[i];
    a.out = (float*)d_out; a.ws = (unsigned char*)d_ws;
#ifndef DBG_PH_HI
#define DBG_PH_HI NPHASE
#endif
#if MK_N_LAUNCHES == 1
    a.ph_lo = 0; a.ph_hi = DBG_PH_HI;
    hipLaunchKernelGGL(mk_fwd, dim3(grid), dim3(NWAVES * 64), LDS_BYTES, stream, a);
#else
#ifdef DBG_PHLIST
    { static const int plist[] = {DBG_PHLIST}; for (int i = 0; i < (int)(sizeof(plist) / sizeof(int)); ++i) { a.ph_lo = plist[i]; a.ph_hi = plist[i] + 1; hipLaunchKernelGGL(mk_fwd, dim3(grid), dim3(NWAVES * 64), LDS_BYTES, stream, a); } }
#else
    for (int p = 0; p < DBG_PH_HI; ++p) { a.ph_lo = p; a.ph_hi = p + 1; hipLaunchKernelGGL(mk_fwd, dim3(grid), dim3(NWAVES * 64), LDS_BYTES, stream, a); }
#endif
#endif
}
```

```cpp
#include <hip/hip_runtime.h>
#include <cstdio>
#include <cstdint>
#include <cmath>

#ifndef DENSE_FP8
#define DENSE_FP8 1
#endif
#define GAS __attribute__((address_space(1)))
#define LAS __attribute__((address_space(3)))
typedef _Float16 half_t;
typedef _Float16 h8 __attribute__((ext_vector_type(8)));
typedef _Float16 h4 __attribute__((ext_vector_type(4)));
typedef _Float16 h2 __attribute__((ext_vector_type(2)));
typedef float f32x4 __attribute__((ext_vector_type(4)));
typedef float f32x2 __attribute__((ext_vector_type(2)));
typedef float f32x16 __attribute__((ext_vector_type(16)));
typedef unsigned u32x4 __attribute__((ext_vector_type(4)));
typedef unsigned u32x2 __attribute__((ext_vector_type(2)));
typedef short s16x8 __attribute__((ext_vector_type(8)));
typedef short s16x4 __attribute__((ext_vector_type(4)));
typedef int v8i_t __attribute__((ext_vector_type(8)));

constexpr int BATCH = 8, SEQ = 4096, M = BATCH * SEQ, D = 1024, NH = 6, HD = 64;
constexpr int NPROJ = 2176, NPROJ_PAD = 2304;
constexpr int COL_K = 384, COL_V = 768, COL_XR = 1152, COL_GT = 1536, COL_U = 1920;
constexpr int FF = 2816, FFE = 3584, NE = 8;
constexpr int LRU_W = 384, S5_W = 256, S5_G = 16, S5_P = 64;
constexpr int CH_T = 64, NCH = SEQ / CH_T;
constexpr float EPS = 1e-6f;
constexpr float C2 = 0.125f * 1.4426950408889634f;
constexpr int MOE_CH_TILES = 136;
constexpr int MOE_REG_TILES = 128;
constexpr int MOE_MAX_TILES = 264;
constexpr int MOE_NCHUNK = 2;
constexpr int MOE_SLOTS = MOE_MAX_TILES * 256;

__device__ __forceinline__ unsigned pk_fp8x4(float a, float b, float c, float d) { int w = __builtin_amdgcn_cvt_pk_fp8_f32(a, b, 0, false); w = __builtin_amdgcn_cvt_pk_fp8_f32(c, d, w, true); return (unsigned)w; }
__device__ __forceinline__ unsigned pkh(float lo, float hi) { f32x2 v = {lo, hi}; h2 h = __builtin_convertvector(v, h2); return __builtin_bit_cast(unsigned, h); }
__device__ __forceinline__ float sigmoidf_(float x) { return __builtin_amdgcn_rcpf(1.f + __expf(-x)); }
__device__ __forceinline__ float siluf_(float x) { return x * sigmoidf_(x); }
__device__ __forceinline__ float gelu_tanh(float x) { const float y = 0.7978845608028654f * (x + 0.044715f * x * x * x); const float t = 1.f - 2.f * __builtin_amdgcn_rcpf(1.f + __expf(2.f * y)); return 0.5f * x * (1.f + t); }
template <int O> __device__ __forceinline__ float xor_lane(float v) {
    if constexpr (O < 32) return __builtin_bit_cast(float, __builtin_amdgcn_ds_swizzle(__builtin_bit_cast(int, v), 0x1f | (O << 10)));
    else { unsigned z_ = 0u; asm volatile("" : "+v"(z_)); const int lane = (int)__builtin_amdgcn_mbcnt_hi(~0u, __builtin_amdgcn_mbcnt_lo(~0u, z_));
        return __builtin_bit_cast(float, __builtin_amdgcn_ds_bpermute((lane ^ 32) << 2, __builtin_bit_cast(int, v))); }
}
#define DPP_ADD(v, ctrl, rmask) ((v) + __builtin_bit_cast(float, __builtin_amdgcn_update_dpp(0, __builtin_bit_cast(int, (v)), (ctrl), (rmask), 0xf, true)))
__device__ __forceinline__ float wave_sum(float v) {
    v = DPP_ADD(v, 0xB1, 0xf);
    v = DPP_ADD(v, 0x4E, 0xf);
    v = DPP_ADD(v, 0x141, 0xf);
    v = DPP_ADD(v, 0x140, 0xf);
    v = DPP_ADD(v, 0x142, 0xa);
    v = DPP_ADD(v, 0x143, 0xc);
    return __builtin_bit_cast(float, __builtin_amdgcn_readlane(__builtin_bit_cast(int, v), 63));
}
#define LDS_WAIT() asm volatile("s_waitcnt lgkmcnt(0)" ::: "memory")
#define VM_WAIT() asm volatile("s_waitcnt vmcnt(0)" ::: "memory")

namespace pg8 {
constexpr int BM = 256, BK = 64, HALF = 128, HTB = HALF * BK * 2, STAGE_BYTES = 8 * HTB, NXCD = 8, WGM = 8;
__host__ __device__ __forceinline__ int lds_byte(int r, int c) { const int st = (r >> 4) * 2 + (c >> 5), rr = r & 15, cc = c & 31, ob = rr * 64 + cc * 2; return st * 1024 + (ob ^ (((ob >> 9) & 1) << 5)); }
__host__ __device__ __forceinline__ void stage_rc(int b, int& R, int& C) { const int st = b / 1024, sb = b % 1024, swz = sb ^ (((sb >> 9) & 1) << 5); R = (st >> 1) * 16 + swz / 64; C = (st & 1) * 32 + (swz % 64) / 2; }
__host__ __device__ __forceinline__ int perm32(int rho) { const int n = rho >> 4, i = rho & 15; return 8 * (i >> 2) + 4 * n + (i & 3); }

struct Unit { int pm, pn, pb; };
struct Gemm { const void* A; const void* Bt; int M, N, K; const int* gidx; const float* ssq; int midk; };

struct StaticOrder {
    int nM, nN, nwg, G, c;
    __host__ __device__ void init(int M_, int N_, int G_, int c_) { nM = M_ / BM; nN = N_ / BM; nwg = nM * nN; G = G_; c = c_; }
    __host__ __device__ bool next(int i, Unit& u) const { return at((long)i * G + c, u); }
    __host__ __device__ bool at(long L, Unit& u) const {
        if (L >= nwg) return false;
        int wgid = (int)L; { const int q = nwg / NXCD, r = nwg % NXCD, xcd = wgid % NXCD, off = wgid / NXCD; wgid = (xcd < r ? xcd * (q + 1) : r * (q + 1) + (xcd - r) * q) + off; }
        const int nig = WGM * nN, gid = wgid / nig, fm = gid * WGM, gsz = (nM - fm) < WGM ? (nM - fm) : WGM;
        u.pm = fm + ((wgid % nig) % gsz); u.pn = (wgid % nig) / gsz; u.pb = u.pn; return true;
    }
};
struct MoeOrder {
    StaticOrder so; const int* texp; int nNe;
#ifdef DBG_NOTEXP
    __device__ bool next(int i, Unit& u) const { if (!so.next(i, u)) return false; u.pb = (u.pm & 7) * nNe + u.pn; return true; }
#else
    __device__ bool next(int i, Unit& u) const { if (!so.next(i, u)) return false; const int e = texp[u.pm]; u.pb = e * nNe + u.pn; return true; }
#endif
};

struct MoeSkewOrder {
    static constexpr int LATE = 3;
    StaticOrder so; const int* texp; int nNe, T;
    __device__ bool next(int i, Unit& u) const {
        const int c = so.c, G = so.G; long L;
        if (c < T) L = (long)LATE * (G - T) + (long)i * G + c;
        else L = i < LATE ? (long)i * (G - T) + (c - T) : (long)LATE * (G - T) + (long)(i - LATE) * G + c;
        if (!so.at(L, u)) return false; const int e = texp[u.pm]; u.pb = e * nNe + u.pn; return true; }
};

template <class Epi, class Sched, bool ALIGN_EPI, bool SP2, bool GATHER, bool FP8 = false>
__device__ __forceinline__ void gemm_phase(LAS unsigned char* lds, const Gemm g, const Sched& S, const Epi& E, int wave_) {
    unsigned z_ = 0u; asm volatile("" : "+v"(z_)); int tid_ = wave_ * 64 + (int)__builtin_amdgcn_mbcnt_hi(~0u, __builtin_amdgcn_mbcnt_lo(~0u, z_));
    const int tid = tid_, wid = wave_, lane = tid & 63, wr = wid >> 2, wc = wid & 3, fr = lane & 15, fq = lane >> 4;
    constexpr int EB = FP8 ? 1 : 2;
    int K_ = g.K; asm volatile("" : "+s"(K_));
    const int K = K_, nt = K * EB / (BK * 2);
    unsigned voffA[2], voffB[2]; int RA[2], CA[2];
#pragma unroll
    for (int i = 0; i < 2; ++i) { int R, C; stage_rc(tid * 16 + i * 8192, R, C); const int Rb = Epi::PERM ? ((R & ~31) + perm32(R & 31)) : R;
        voffA[i] = (unsigned)(R * K * EB + C * 2); voffB[i] = (unsigned)(Rb * K * EB + C * 2); RA[i] = R; CA[i] = C; }
    const size_t kstep = (size_t)(BK * 2);
    const size_t hstep = (size_t)HALF * K * EB;
    const size_t tstep = 2 * hstep;
    const unsigned ldsw = (unsigned)wid * 1024u;
    const int aoff = lds_byte(wr * 64 + fr, fq * 8), boff = lds_byte(wc * 32 + fr, fq * 8);
    const int aoff8a = lds_byte(wr * 64 + fr, 16 * fq), boff8a = lds_byte(wc * 32 + fr, 16 * fq); constexpr int aoff8b = 16, boff8b = 16;
    unsigned offC[2][2], offN[2][2];
#define PG8_SA(b, h) (((b) * 2 + (h)) * HTB)
#define PG8_SB(b, h) ((4 + (b) * 2 + (h)) * HTB)
#define PG8_GLDS(gp, lp) __builtin_amdgcn_global_load_lds((const unsigned*)(gp), (LAS unsigned*)(lp), 16, 0, 0)
#define PG8_STAGE(bufoff, gbase, voff) do { _Pragma("unroll") for (int _i = 0; _i < 2; ++_i) PG8_GLDS((const char*)(gbase) + (voff)[_i], lds + (bufoff) + ldsw + _i * 8192); } while (0)
#define PG8_STAGE_A(bufoff, gbase, hh, nx) do { if constexpr (GATHER) { _Pragma("unroll") for (int _i = 0; _i < 2; ++_i) { const unsigned _o = (nx) ? offN[hh][_i] : offC[hh][_i]; PG8_GLDS((const char*)(gbase) + _o, lds + (bufoff) + ldsw + _i * 8192); } } \
        else { PG8_STAGE(bufoff, (gbase) + (hh) * hstep, voffA); } } while (0)
#define PG8_LD32(p0, p1) __builtin_bit_cast(v8i_t, __builtin_shufflevector(*(const LAS u32x4*)(p0), *(const LAS u32x4*)(p1), 0, 1, 2, 3, 4, 5, 6, 7))
#define PG8_LDA(dst, b, h) do { if constexpr (FP8) { _Pragma("unroll") for (int m = 0; m < 4; ++m) dst##8[m] = PG8_LD32(lds + PG8_SA(b, h) + aoff8a + m * 2048, lds + PG8_SA(b, h) + aoff8a + aoff8b + m * 2048); } \
        else { _Pragma("unroll") for (int m = 0; m < 4; ++m) _Pragma("unroll") for (int k = 0; k < 2; ++k) dst[m][k] = *(const LAS h8*)(lds + PG8_SA(b, h) + aoff + m * 2048 + k * 1024); } } while (0)
#define PG8_LDB(dst, b, h) do { if constexpr (FP8) { _Pragma("unroll") for (int n = 0; n < 2; ++n) dst##8[n] = PG8_LD32(lds + PG8_SB(b, h) + boff8a + n * 2048, lds + PG8_SB(b, h) + boff8a + boff8b + n * 2048); } \
        else { _Pragma("unroll") for (int n = 0; n < 2; ++n) _Pragma("unroll") for (int k = 0; k < 2; ++k) dst[n][k] = *(const LAS h8*)(lds + PG8_SB(b, h) + boff + n * 2048 + k * 1024); } } while (0)
#define PG8_MMA(ai, bj, At, Bt) do { __builtin_amdgcn_s_setprio(1); if constexpr (FP8) { _Pragma("unroll") for (int m = 0; m < 4; ++m) _Pragma("unroll") for (int n = 0; n < 2; ++n) \
        asm volatile("v_mfma_f32_16x16x128_f8f6f4 %0, %1, %2, %0" : "+v"(acc[ai][bj][m][n]) : "v"(Bt##8[n]), "v"(At##8[m])); PG8_FP8_PAD } \
        else { _Pragma("unroll") for (int m = 0; m < 4; ++m) _Pragma("unroll") for (int n = 0; n < 2; ++n) _Pragma("unroll") for (int k = 0; k < 2; ++k) \
        acc[ai][bj][m][n] = __builtin_amdgcn_mfma_f32_16x16x32_f16(Bt[n][k], At[m][k], acc[ai][bj][m][n], 0, 0, 0); } __builtin_amdgcn_s_setprio(0); } while (0)
#ifdef DBG_DRAIN
#define PG8_WAIT_V(n) asm volatile("s_waitcnt vmcnt(0)" ::: "memory")
#else
#define PG8_WAIT_V(n) asm volatile("s_waitcnt vmcnt(" #n ")" ::: "memory")
#endif
#ifdef DBG_FP8PAD
#define PG8_FP8_PAD asm volatile("s_nop 15\n\ts_nop 15\n\ts_nop 15\n\ts_nop 15\n\ts_nop 15" ::: "memory");
#else
#define PG8_FP8_PAD
#endif
#define PG8_WAIT_L(n) asm volatile("s_waitcnt lgkmcnt(" #n ")" ::: "memory")
#define PG8_BAR __builtin_amdgcn_s_barrier()
#define PG8_SCHED __builtin_amdgcn_sched_barrier(0)
#define PG8_GOFF(dst, u_) do { if constexpr (GATHER) { _Pragma("unroll") for (int _h = 0; _h < 2; ++_h) _Pragma("unroll") for (int _i = 0; _i < 2; ++_i) \
        dst[_h][_i] = (unsigned)(((const GAS int*)g.gidx)[(u_).pm * BM + _h * HALF + RA[_i]] * K * EB + CA[_i] * 2); } } while (0)
    Unit cur, nxt; int ui = 0;
    if (!S.next(0, cur)) return;
    f32x4 acc[2][2][4][2];
#pragma unroll
    for (int a = 0; a < 2; ++a)
#pragma unroll
        for (int b = 0; b < 2; ++b)
#pragma unroll
            for (int m = 0; m < 4; ++m)
#pragma unroll
                for (int n = 0; n < 2; ++n) acc[a][b][m][n] = (f32x4){0.f, 0.f, 0.f, 0.f};
    h8 At[4][2], B0[2][2], B1[2][2];
    v8i_t At8[4], B08[2], B18[2];
    PG8_GOFF(offC, cur);
#pragma unroll
    for (int _h = 0; _h < 2; ++_h)
#pragma unroll
        for (int _i = 0; _i < 2; ++_i) offN[_h][_i] = offC[_h][_i];
    const char* cA = GATHER ? (const char*)g.A : (const char*)g.A + (size_t)cur.pm * tstep; const char* cB = (const char*)g.Bt + (size_t)cur.pb * tstep;
    if constexpr (SP2) {
        PG8_STAGE(PG8_SB(0, 0), cB, voffB); PG8_STAGE(PG8_SB(0, 1), cB + hstep, voffB); PG8_STAGE_A(PG8_SA(0, 0), cA, 0, false); PG8_STAGE_A(PG8_SA(0, 1), cA, 1, false);
        if (wr == 1) PG8_BAR;
        PG8_WAIT_V(2); PG8_BAR;
        PG8_STAGE(PG8_SB(1, 0), cB + kstep, voffB); PG8_STAGE_A(PG8_SA(1, 0), cA + kstep, 0, false); PG8_STAGE(PG8_SB(1, 1), cB + hstep + kstep, voffB);
        PG8_WAIT_V(6); PG8_BAR;
    } else {
        PG8_STAGE(PG8_SB(0, 0), cB, voffB); PG8_STAGE_A(PG8_SA(0, 0), cA, 0, false); PG8_STAGE(PG8_SB(0, 1), cB + hstep, voffB); PG8_STAGE_A(PG8_SA(0, 1), cA, 1, false);
        if (wr == 1) PG8_BAR;
        PG8_WAIT_V(4); PG8_BAR;
        PG8_STAGE(PG8_SB(1, 0), cB + kstep, voffB); PG8_STAGE_A(PG8_SA(1, 0), cA + kstep, 0, false); PG8_STAGE(PG8_SB(1, 1), cB + hstep + kstep, voffB);
        PG8_WAIT_V(6); PG8_BAR;
    }
    for (;;) {
        const bool has_next = S.next(ui + 1, nxt);
        if (g.ssq) {
            LAS float* RS = (LAS float*)(lds + 131072 + 2048);
            if (tid < BM) { const float* sp = g.ssq + (size_t)(cur.pm * BM + tid) * 8; const f32x4 s0 = *(const f32x4*)sp, s1 = *(const f32x4*)(sp + 4);
                RS[tid] = 1.f / sqrtf(((s0[0] + s0[1]) + (s0[2] + s0[3]) + (s1[0] + s1[1])) * (1.f / 384.f) + 1e-6f); } }
        const char* nA = has_next ? (GATHER ? (const char*)g.A : (const char*)g.A + (size_t)nxt.pm * tstep) : cA; const char* nB = has_next ? (const char*)g.Bt + (size_t)nxt.pb * tstep : cB;
#pragma nounroll
        for (int t = 0; t < nt; t += 2) {
#ifndef DBG_NOHOOK
            if (g.ssq && t == g.midk)
#else
            if (false)
#endif
            {
#pragma unroll
                for (int ai = 0; ai < 2; ++ai)
#pragma unroll
                    for (int m = 0; m < 4; ++m) { const float rs = ((const LAS float*)(lds + 131072 + 2048))[ai * HALF + wr * 64 + m * 16 + fr];
#pragma unroll
                        for (int bj = 0; bj < 2; ++bj)
#pragma unroll
                            for (int n = 0; n < 2; ++n) acc[ai][bj][m][n] = acc[ai][bj][m][n] * rs; } }
            const bool last = (t == nt - 2);
            const char* a1 = cA + (size_t)(t + 1) * kstep;
            const char* a2 = last ? nA : cA + (size_t)(t + 2) * kstep; const char* b2 = last ? nB : cB + (size_t)(t + 2) * kstep;
            const char* a3 = a2 + kstep; const char* b3 = b2 + kstep;
            if constexpr (SP2) {
            PG8_LDB(B0, 0, 0); PG8_LDB(B1, 0, 1); PG8_SCHED; PG8_LDA(At, 0, 0); PG8_STAGE_A(PG8_SA(1, 1), a1, 1, false);
            PG8_WAIT_V(8); PG8_WAIT_L(0); PG8_BAR; PG8_MMA(0, 0, At, B0); PG8_MMA(0, 1, At, B1); PG8_BAR; PG8_SCHED;
            PG8_LDA(At, 0, 1); PG8_STAGE(PG8_SB(0, 0), b2, voffB); PG8_STAGE(PG8_SB(0, 1), b2 + hstep, voffB); PG8_STAGE_A(PG8_SA(0, 0), a2, 0, last);
            PG8_WAIT_V(8); PG8_WAIT_L(0); PG8_BAR; PG8_MMA(1, 0, At, B0); PG8_MMA(1, 1, At, B1); PG8_BAR; PG8_SCHED;
            PG8_LDB(B0, 1, 0); PG8_LDB(B1, 1, 1); PG8_SCHED; PG8_LDA(At, 1, 0); PG8_STAGE_A(PG8_SA(0, 1), a2, 1, last);
            PG8_WAIT_V(8); PG8_WAIT_L(0); PG8_BAR; PG8_MMA(0, 0, At, B0); PG8_MMA(0, 1, At, B1); PG8_BAR; PG8_SCHED;
            PG8_LDA(At, 1, 1); PG8_STAGE(PG8_SB(1, 0), b3, voffB); PG8_STAGE(PG8_SB(1, 1), b3 + hstep, voffB); PG8_STAGE_A(PG8_SA(1, 0), a3, 0, last);
            PG8_WAIT_V(8); PG8_WAIT_L(0); PG8_BAR; PG8_MMA(1, 0, At, B0); PG8_MMA(1, 1, At, B1); PG8_BAR; PG8_SCHED;
            } else {
            PG8_LDB(B0, 0, 0); PG8_SCHED; PG8_LDA(At, 0, 0); PG8_STAGE_A(PG8_SA(1, 1), a1, 1, false);
            PG8_WAIT_L(8); PG8_BAR; PG8_WAIT_L(0); PG8_MMA(0, 0, At, B0); PG8_BAR; PG8_SCHED;
            PG8_LDB(B1, 0, 1); PG8_STAGE(PG8_SB(0, 0), b2, voffB);
            PG8_BAR; PG8_WAIT_L(0); PG8_MMA(0, 1, At, B1); PG8_BAR;
            PG8_LDA(At, 0, 1); PG8_STAGE_A(PG8_SA(0, 0), a2, 0, last);
            PG8_BAR; PG8_WAIT_L(0); PG8_MMA(1, 0, At, B0); PG8_BAR; PG8_SCHED;
            PG8_STAGE(PG8_SB(0, 1), b2 + hstep, voffB);
            PG8_WAIT_V(6); PG8_BAR; PG8_MMA(1, 1, At, B1); PG8_BAR;
            PG8_LDB(B0, 1, 0); PG8_SCHED; PG8_LDA(At, 1, 0); PG8_STAGE_A(PG8_SA(0, 1), a2, 1, last);
            PG8_WAIT_L(8); PG8_BAR; PG8_WAIT_L(0); PG8_MMA(0, 0, At, B0); PG8_BAR; PG8_SCHED;
            PG8_LDB(B1, 1, 1); PG8_STAGE(PG8_SB(1, 0), b3, voffB);
            PG8_BAR; PG8_WAIT_L(0); PG8_MMA(0, 1, At, B1); PG8_BAR;
            PG8_LDA(At, 1, 1); PG8_STAGE_A(PG8_SA(1, 0), a3, 0, last);
            PG8_BAR; PG8_WAIT_L(0); PG8_MMA(1, 0, At, B0); PG8_BAR; PG8_SCHED;
            PG8_STAGE(PG8_SB(1, 1), b3 + hstep, voffB);
            PG8_WAIT_V(6); PG8_BAR; PG8_MMA(1, 1, At, B1); PG8_BAR;
            }
        }
        if constexpr (ALIGN_EPI) { if (wr == 0) PG8_BAR; }
        if constexpr (FP8) asm volatile("s_nop 15\n\ts_nop 15" ::: "memory");
        E(acc, cur, wr, wc, fr, fq);
        if (!has_next) break;
#pragma unroll
        for (int a = 0; a < 2; ++a)
#pragma unroll
            for (int b = 0; b < 2; ++b)
#pragma unroll
                for (int m = 0; m < 4; ++m)
#pragma unroll
                    for (int n = 0; n < 2; ++n) acc[a][b][m][n] = (f32x4){0.f, 0.f, 0.f, 0.f};
        cur = nxt; cA = nA; cB = nB; ++ui;
#pragma unroll
        for (int _h = 0; _h < 2; ++_h)
#pragma unroll
            for (int _i = 0; _i < 2; ++_i) offC[_h][_i] = offN[_h][_i];
        if constexpr (ALIGN_EPI) { if (wr == 1) PG8_BAR; }
    }
    PG8_WAIT_V(0);
    if constexpr (!ALIGN_EPI) { if (wr == 0) PG8_BAR; }
    PG8_BAR;
#undef PG8_SA
#undef PG8_SB
#undef PG8_GLDS
#undef PG8_STAGE
#undef PG8_STAGE_A
#undef PG8_LDA
#undef PG8_LDB
#undef PG8_MMA
#undef PG8_LD32
#undef PG8_WAIT_V
#undef PG8_WAIT_L
#undef PG8_BAR
#undef PG8_SCHED
#undef PG8_GOFF
}
}

namespace attn_body {
constexpr int D_ = 64;
constexpr int PQ = NPROJ;
constexpr int PO = D;
constexpr int NW = 8, QBLK = 32, QB = QBLK * NW, KVBLK = 64;
__device__ __forceinline__ int crow(int r, int hi) { return (r & 3) + 8 * (r >> 2) + 4 * hi; }
__device__ __forceinline__ constexpr int crow0(int r) { return (r & 3) + 8 * (r >> 2); }
#define SBAR() __builtin_amdgcn_sched_barrier(0)
__device__ __forceinline__ void cmask(f32x16& p0, f32x16& p1, int jb, int qrel, int hi) {
    const float NEG = -INFINITY; int kb = 64 * jb + 4 * hi;
    const int lim = qrel - kb;
#pragma unroll
    for (int r = 0; r < 16; ++r) { if (crow0(r) > lim) p0[r] = NEG; if (crow0(r) + 32 > lim) p1[r] = NEG; }
}
__device__ __forceinline__ void killmask(f32x16& p0, f32x16& p1, bool dead) {
    const float NEG = -INFINITY;
#pragma unroll
    for (int r = 0; r < 16; ++r) { p0[r] = dead ? NEG : p0[r]; p1[r] = dead ? NEG : p1[r]; }
}
constexpr int NSLOT = 3, SLOTB = 8192;
constexpr int LDS_K = 0, LDS_V = NSLOT * SLOTB, LDS_WS = 2 * NSLOT * SLOTB, LDS_OST = LDS_WS + NW * 64 * 4, LDS_BYTES = LDS_OST + NW * 4096;
__device__ __forceinline__ void glds16(const void* gsrc, unsigned lds_dst) { unsigned keep;
    asm volatile("s_mov_b32 %0, m0\n\ts_mov_b32 m0, %2\n\ts_nop 0\n\tglobal_load_lds_dwordx4 %1, off\n\ts_mov_b32 m0, %0" : "=&s"(keep) : "v"(gsrc), "s"(lds_dst) : "memory"); }
__device__ __forceinline__ float max3f(float a, float b, float c) { float r; asm("v_max3_f32 %0, %1, %2, %3" : "=v"(r) : "v"(a), "v"(b), "v"(c)); return r; }
__device__ __forceinline__ float max2f(float a, float b) { float r; asm("v_max_f32_e32 %0, %1, %2" : "=v"(r) : "v"(a), "v"(b)); return r; }
__device__ __forceinline__ float fadd_s(float a, float b) { float r; asm("v_add_f32_e32 %0, %1, %2" : "=v"(r) : "v"(a), "v"(b)); return r; }
__device__ __forceinline__ float fsub_s(float a, float b) { float r; asm("v_sub_f32_e32 %0, %1, %2" : "=v"(r) : "v"(a), "v"(b)); return r; }
__device__ __forceinline__ unsigned cvtpk_s(float lo, float hi) { return pkh(lo, hi); }
#define WAIT_BAR(N) asm volatile("s_waitcnt vmcnt(" #N ") lgkmcnt(0)\n\ts_barrier" ::: "memory")
#define MFMA32(a, b, c) __builtin_amdgcn_mfma_f32_32x32x16_f16(__builtin_bit_cast(h8, a), __builtin_bit_cast(h8, b), c, 0, 0, 0)

__device__ __forceinline__ void qkt(f32x16& p0, f32x16& p1, const LAS char* Kslot, const s16x8* qr, const f32x16& negm, int r32, int hi) {
    const LAS char* kb = Kslot + hi * 1024 + r32 * 16;
#pragma unroll
    for (int d0 = 0; d0 < 4; ++d0) {
        const s16x8 b0 = *(const LAS s16x8*)(kb + d0 * 2048);
        const s16x8 b1 = *(const LAS s16x8*)(kb + d0 * 2048 + 512);
        if (d0 == 0) { p0 = MFMA32(b0, qr[0], negm); p1 = MFMA32(b1, qr[0], negm); }
        else { p0 = MFMA32(b0, qr[d0], p0); p1 = MFMA32(b1, qr[d0], p1); } }
}
typedef __attribute__((address_space(3))) const char* lds_cptr;
typedef short v4i16_t __attribute__((ext_vector_type(4)));
__device__ __forceinline__ void kload8(s16x8* kf, lds_cptr kp) {
    kf[0] = *(const LAS s16x8*)(kp);        kf[1] = *(const LAS s16x8*)(kp + 512);
    kf[2] = *(const LAS s16x8*)(kp + 2048); kf[3] = *(const LAS s16x8*)(kp + 2560);
    kf[4] = *(const LAS s16x8*)(kp + 4096); kf[5] = *(const LAS s16x8*)(kp + 4608);
    kf[6] = *(const LAS s16x8*)(kp + 6144); kf[7] = *(const LAS s16x8*)(kp + 6656);
}
__device__ __forceinline__ void kload2(s16x8* kf, lds_cptr kp, int j) { kf[2 * j] = *(const LAS s16x8*)(kp + j * 2048); kf[2 * j + 1] = *(const LAS s16x8*)(kp + j * 2048 + 512); }
__device__ __forceinline__ s16x4 vtr(lds_cptr p) { return __builtin_bit_cast(s16x4, __builtin_amdgcn_ds_read_tr16_b64_v4i16((LAS v4i16_t*)p)); }
__device__ __forceinline__ float rowmax(const f32x16& p0, const f32x16& p1) {
    float a = max3f(p0[0], p0[1], p1[0]), b = max3f(p0[2], p0[3], p1[1]); a = max3f(a, p1[2], p1[3]);
#pragma unroll
    for (int r = 4; r < 16; r += 4) { a = max3f(a, p0[r], p0[r + 1]); b = max3f(b, p0[r + 2], p0[r + 3]); a = max3f(a, p1[r], p1[r + 1]); b = max3f(b, p1[r + 2], p1[r + 3]); }
    const float m = max2f(a, b);
    auto rr = __builtin_amdgcn_permlane32_swap(__float_as_uint(m), __float_as_uint(m), false, false);
    return max2f(__uint_as_float(rr[0]), __uint_as_float(rr[1]));
}
__device__ __forceinline__ void pv(f32x16* o, int vb, s16x8 pa0, s16x8 pa1, s16x8 pa2, s16x8 pa3) {
#pragma unroll
    for (int d0 = 0; d0 < 2; ++d0) { s16x4 lo[4], hi[4];
#pragma unroll
        for (int ks = 0; ks < 4; ++ks) {
            asm volatile("ds_read_b64_tr_b16 %0,%1 offset:%c2" : "=&v"(lo[ks]) : "v"(vb), "i"(d0 * 4096 + ks * 1024) : "memory");
            asm volatile("ds_read_b64_tr_b16 %0,%1 offset:%c2" : "=&v"(hi[ks]) : "v"(vb), "i"(d0 * 4096 + ks * 1024 + 512) : "memory"); }
        asm volatile("s_waitcnt lgkmcnt(0)" ::: "memory"); SBAR();
#define PK(k) (s16x8){lo[k][0], lo[k][1], lo[k][2], lo[k][3], hi[k][0], hi[k][1], hi[k][2], hi[k][3]}
        o[d0] = MFMA32(pa0, PK(0), o[d0]);
        o[d0] = MFMA32(pa1, PK(1), o[d0]);
        o[d0] = MFMA32(pa2, PK(2), o[d0]);
        o[d0] = MFMA32(pa3, PK(3), o[d0]);
#undef PK
    }
}

template <int THRL> __device__ __forceinline__ void attn_unit(int b, int h, int qb, const half_t* Q, const half_t* __restrict__ K, const half_t* __restrict__ V, half_t* O, const float* __restrict__ kmean, float* __restrict__ ssq, LAS char* shm, int wave_) {
    unsigned z_ = 0u; asm volatile("" : "+v"(z_)); int tid_ = wave_ * 64 + (int)__builtin_amdgcn_mbcnt_hi(~0u, __builtin_amdgcn_mbcnt_lo(~0u, z_));
    const int tid = tid_, lane = tid & 63, r32 = lane & 31, hi = lane >> 5; const int wid = wave_;
    const long rowbase = (long)b * SEQ; const int q0 = qb * QB;
    const half_t* Qw = Q + (rowbase + q0 + wid * QBLK) * PQ + h * D_;
    const half_t* Kh = K + rowbase * PQ + h * D_, *Vh = V + rowbase * PQ + h * D_;
    const unsigned lds0 = (unsigned)(uintptr_t)shm;
    LAS float* wsf = (LAS float*)(shm + LDS_WS) + wid * 64; LAS float* wsfh = wsf + 4 * hi;
    const half_t* ksrc = Kh + (long)lane * PQ + wid * 8;
    const half_t* vsrc = Vh + (long)(16 * (wid & 3) + (lane >> 2)) * PQ + (wid >> 2) * 32 + (lane & 3) * 8;
    const unsigned kdst = lds0 + LDS_K + wid * 1024, vdst = lds0 + LDS_V + wid * 1024;
    const int NT = (q0 + QB) / KVBLK;
#define PHYS(t) (((t) < 4) ? (NT - 4 + (t)) : ((t) - 4))
#define DMA_K(t, slot) glds16(ksrc + (long)PHYS(t) * KVBLK * PQ, (unsigned)__builtin_amdgcn_readfirstlane(kdst + (slot)))
#define DMA_V(t, slot) glds16(vsrc + (long)PHYS(t) * KVBLK * PQ, (unsigned)__builtin_amdgcn_readfirstlane(vdst + (slot)))
    const int vb0 = (int)(lds0 + LDS_V) + ((lane >> 4) & 1) * 32 + (lane & 3) * 8 + (4 * hi + ((lane & 15) >> 2)) * 64;
    const LAS char* Kbase = shm + LDS_K; s16x8 kf[8];
    const lds_cptr shm3 = (lds_cptr)shm; const lds_cptr kp0 = shm3 + LDS_K + hi * 1024 + r32 * 16; const lds_cptr vp0 = shm3 + LDS_V + ((lane >> 4) & 1) * 32 + (lane & 3) * 8 + (4 * hi + ((lane & 15) >> 2)) * 64;
    DMA_K(0, 0); DMA_V(0, 0); DMA_K(1, SLOTB);
    s16x8 qr[4];
#pragma unroll
    for (int d0 = 0; d0 < 4; ++d0) qr[d0] = *reinterpret_cast<const s16x8*>(&Qw[(long)r32 * PQ + d0 * 16 + hi * 8]);
    unsigned pmask = 0u;
    LAS float* kml = (LAS float*)(shm + 98304);
    if (tid < 256) *(LAS f32x4*)(kml + tid * 4) = *(const f32x4*)(kmean + tid * 4);
    __syncthreads();
    if (qb > 0) {
        float v1 = -INFINITY, v2 = -INFINITY, v3 = -INFINITY; int i1 = 0, i2 = 0, i3 = 0;
        for (int n0 = 0; n0 < qb; n0 += 4) {
            f32x4 ka[4][4], kb2[4][4];
#pragma unroll
            for (int u = 0; u < 4; ++u) { const int n = n0 + u < qb ? n0 + u : qb - 1; const LAS float* km = kml + n * 64 + hi * 8;
#pragma unroll
                for (int d0 = 0; d0 < 4; ++d0) { ka[u][d0] = *(const LAS f32x4*)(km + d0 * 16); kb2[u][d0] = *(const LAS f32x4*)(km + d0 * 16 + 4); } }
#pragma unroll
            for (int u = 0; u < 4; ++u) { const int n = n0 + u; float gsum = 0.f;
#pragma unroll
                for (int d0 = 0; d0 < 4; ++d0) { const h8 qh = __builtin_bit_cast(h8, qr[d0]);
                    gsum += (float)qh[0] * ka[u][d0][0] + (float)qh[1] * ka[u][d0][1] + (float)qh[2] * ka[u][d0][2] + (float)qh[3] * ka[u][d0][3] + (float)qh[4] * kb2[u][d0][0] + (float)qh[5] * kb2[u][d0][1] + (float)qh[6] * kb2[u][d0][2] + (float)qh[7] * kb2[u][d0][3]; }
                { auto rr = __builtin_amdgcn_permlane32_swap(__float_as_uint(gsum), __float_as_uint(gsum), false, false); gsum = __uint_as_float(rr[0]) + __uint_as_float(rr[1]); }
                if (n < qb) {
                    if (gsum > v1) { v3 = v2; i3 = i2; v2 = v1; i2 = i1; v1 = gsum; i1 = n; }
                    else if (gsum > v2) { v3 = v2; i3 = i2; v2 = gsum; i2 = n; }
                    else if (gsum > v3) { v3 = gsum; i3 = n; } } } }
        pmask = 1u << i1; if (qb >= 2) pmask |= 1u << i2; if (qb >= 3) pmask |= 1u << i3;
    }
    float mhat = 0.f, l_reg = 0.f; f32x16 o[2]; o[0] = f32x16{}; o[1] = f32x16{}; f32x16 negm = f32x16{}; asm volatile("" : "+v"(negm));
    const int qrel = wid * QBLK + r32;
#define CMASK(P0, P1, t) do { if ((t) < 4) cmask(P0, P1, (t), qrel, hi); } while (0)
#define SETNEGM(tn) do { const bool dd_ = ((tn) >= 4) && (((pmask >> (((tn) - 4) >> 2)) & 1u) == 0u); const float nv_ = dd_ ? -INFINITY : -mhat; \
      _Pragma("unroll") for (int r = 0; r < 16; ++r) negm[r] = nv_; asm volatile("" : "+v"(negm)); } while (0)
    bool resc = false;
#define START(P0, P1) do { const float rm = rowmax(P0, P1); resc = false; \
    { const float dl = rm; mhat = fadd_s(mhat, dl); \
      _Pragma("unroll") for (int r = 0; r < 16; ++r) { P0[r] = fsub_s(P0[r], dl); P1[r] = fsub_s(P1[r], dl); } \
      _Pragma("unroll") for (int r = 0; r < 16; ++r) negm[r] = -mhat; asm volatile("" : "+v"(negm)); } \
    _Pragma("unroll") for (int r = 0; r < 16; ++r) P0[r] = __builtin_amdgcn_exp2f(P0[r]); } while (0)
#define RESC() do { if (resc) { asm volatile("s_waitcnt lgkmcnt(0)" ::: "memory"); \
      _Pragma("unroll") for (int d_ = 0; d_ < 2; ++d_) _Pragma("unroll") for (int r = 0; r < 16; ++r) o[d_][r] *= wsfh[crow0(r)]; } } while (0)
    f32x16 pA0, pA1, pB0, pB1;
    int sl_prev = 0, sl_cur = 0, sl_next = SLOTB;
#define ROT() do { sl_prev = sl_cur; sl_cur = sl_next; sl_next = (sl_next == (NSLOT - 1) * SLOTB) ? 0 : sl_next + SLOTB; } while (0)
    DMA_K(2, 2 * SLOTB);
    WAIT_BAR(3);
    qkt(pA0, pA1, Kbase, qr, negm, r32, hi); asm volatile("s_nop 15\n\ts_nop 7" : "+v"(pA0), "+v"(pA1)); CMASK(pA0, pA1, 0);
    START(pA0, pA1);
    _Pragma("unroll") for (int r = 0; r < 16; ++r) pA1[r] = __builtin_amdgcn_exp2f(pA1[r]);
    WAIT_BAR(0);
    DMA_K(3, 0); DMA_V(1, SLOTB);
    ROT();
    kload8(kf, kp0 + sl_cur);
    WAIT_BAR(2);
    s16x4 vlo[8], vhi[8]; u32x4 pw0, pw1, pw2, pw3;
#define PKW(P, B) cvtpk_s(P[B], P[B + 1])
#define PAF(k) __builtin_bit_cast(s16x8, pw##k)
#define VFR(i) (s16x8){vlo[i][0], vlo[i][1], vlo[i][2], vlo[i][3], vhi[i][0], vhi[i][1], vhi[i][2], vhi[i][3]}
#define PIN(x) asm volatile("" : "+v"(x))
#define MX3(a, b, c) __builtin_fmaxf(__builtin_fmaxf((a), (b)), (c))
#define GAPA(MF, A0, A1, A2, A3, W0, W1, PW) do { MF; sacc += A0; sacc += A1; sacc += A2; sacc += A3; PIN(sacc); W0; W1; PIN(PW); SBAR(); } while (0)
#define EX(v) __builtin_amdgcn_exp2f(v)
#define GAPB(MF, X, B) do { MF; X[B] = EX(X[B]); X[B + 1] = EX(X[B + 1]); X[B + 2] = EX(X[B + 2]); X[B + 3] = EX(X[B + 3]); PIN(X); SBAR(); } while (0)
#define VRD(i) do { vlo[i] = vtr(vp_ + (((i) >> 2) * 4096 + ((i) & 3) * 1024)); vhi[i] = vtr(vp_ + (((i) >> 2) * 4096 + ((i) & 3) * 1024 + 512)); } while (0)
#define KRD(G, j) do { if (G) { kload2(kf, kp0 + sl_next, j); SBAR(); } } while (0)
#define STEP(C0, C1, P0, P1, t, GK, GV, GL) do { SBAR(); \
    const lds_cptr vp_ = vp0 + sl_prev; \
    VRD(0); SBAR(); float sacc = (P0[0] + P0[1]); \
    GAPA(C0 = MFMA32(kf[0], qr[0], negm), P0[2], P0[3], P0[4], P0[5],     pw0[0] = PKW(P0, 0), pw0[1] = PKW(P0, 2), pw0); \
    VRD(4); SBAR(); GAPA(C1 = MFMA32(kf[1], qr[0], negm), P0[6], P0[7], P0[8], P0[9],     pw0[2] = PKW(P0, 4), pw0[3] = PKW(P0, 6), pw0); \
    VRD(1); SBAR(); GAPA(C0 = MFMA32(kf[2], qr[1], C0),   P0[10], P0[11], P0[12], P0[13], pw1[0] = PKW(P0, 8), pw1[1] = PKW(P0, 10), pw1); \
    VRD(5); SBAR(); GAPA(C1 = MFMA32(kf[3], qr[1], C1),   P0[14], P0[15], P1[0], P1[1],   pw1[2] = PKW(P0, 12), pw1[3] = PKW(P0, 14), pw1); \
    VRD(2); SBAR(); GAPA(C0 = MFMA32(kf[4], qr[2], C0),   P1[2], P1[3], P1[4], P1[5],     pw2[0] = PKW(P1, 0), pw2[1] = PKW(P1, 2), pw2); \
    VRD(6); SBAR(); GAPA(C1 = MFMA32(kf[5], qr[2], C1),   P1[6], P1[7], P1[8], P1[9],     pw2[2] = PKW(P1, 4), pw2[3] = PKW(P1, 6), pw2); \
    VRD(3); SBAR(); GAPA(C0 = MFMA32(kf[6], qr[3], C0),   P1[10], P1[11], P1[12], P1[13], pw3[0] = PKW(P1, 8), pw3[1] = PKW(P1, 10), pw3); \
    VRD(7); SBAR(); GAPA(C1 = MFMA32(kf[7], qr[3], C1),   P1[14], P1[15], 0.f, 0.f,       pw3[2] = PKW(P1, 12), pw3[3] = PKW(P1, 14), pw3); \
    l_reg += sacc; \
    if (GK) { DMA_K((t) + 3, sl_cur); } if (GV) { DMA_V((t) + 1, sl_next); } \
    CMASK(C0, C1, t); \
    { float a = MX3(C0[0], C0[1], C1[0]), b = MX3(C0[2], C0[3], C1[1]); a = MX3(a, C1[2], C1[3]); \
      _Pragma("unroll") for (int r = 4; r < 16; r += 4) { a = MX3(a, C0[r], C0[r + 1]); b = MX3(b, C0[r + 2], C0[r + 3]); a = MX3(a, C1[r], C1[r + 1]); b = MX3(b, C1[r + 2], C1[r + 3]); } \
      float rm = __builtin_fmaxf(a, b); { auto rr = __builtin_amdgcn_permlane32_swap(__float_as_uint(rm), __float_as_uint(rm), false, false); rm = __builtin_fmaxf(__uint_as_float(rr[0]), __uint_as_float(rr[1])); } \
      resc = false; \
      if (__builtin_expect(__any(rm > (float)THRL), 0)) { const float dl = __builtin_fmaxf(rm, 0.f); mhat += dl; \
        _Pragma("unroll") for (int r = 0; r < 16; ++r) { C0[r] -= dl; C1[r] -= dl; } \
        SETNEGM((t) + 1); \
        const float f = __builtin_amdgcn_exp2f(-dl); l_reg *= f; if (hi == 0) wsf[r32] = f; resc = true; } } \
    if (((((t) + 1) & 3) == 0) && (t) + 1 >= 4) SETNEGM((t) + 1); \
    SBAR(); \
    GAPB(o[0] = MFMA32(PAF(0), VFR(0), o[0]), C0, 0); \
    GAPB(o[1] = MFMA32(PAF(0), VFR(4), o[1]), C0, 4); \
    KRD(GL, 0); GAPB(o[0] = MFMA32(PAF(1), VFR(1), o[0]), C0, 8); \
    KRD(GL, 1); GAPB(o[1] = MFMA32(PAF(1), VFR(5), o[1]), C0, 12); \
    KRD(GL, 2); GAPB(o[0] = MFMA32(PAF(2), VFR(2), o[0]), C1, 0); \
    KRD(GL, 3); GAPB(o[1] = MFMA32(PAF(2), VFR(6), o[1]), C1, 4); \
    GAPB(o[0] = MFMA32(PAF(3), VFR(3), o[0]), C1, 8); \
    GAPB(o[1] = MFMA32(PAF(3), VFR(7), o[1]), C1, 12); \
    } while (0)
    int t = 1;
    for (; t + 5 < NT; t += 2) {
        STEP(pB0, pB1, pA0, pA1, t, true, true, true);     WAIT_BAR(2); RESC(); ROT();
        STEP(pA0, pA1, pB0, pB1, t + 1, true, true, true); WAIT_BAR(2); RESC(); ROT();
    }
#define ENDW(tt) do { if ((tt) + 3 < NT) { WAIT_BAR(2); } else if ((tt) + 2 < NT) { WAIT_BAR(1); } else { WAIT_BAR(0); } } while (0)
    for (; t + 1 < NT; t += 2) {
        STEP(pB0, pB1, pA0, pA1, t, (t + 3 < NT), (t + 1 < NT), (t + 1 < NT));           ENDW(t);     RESC(); ROT();
        STEP(pA0, pA1, pB0, pB1, t + 1, (t + 4 < NT), (t + 2 < NT), (t + 2 < NT));       ENDW(t + 1); RESC(); ROT();
    }
    STEP(pB0, pB1, pA0, pA1, NT - 1, false, false, false); RESC();
    { float sacc = pB0[0] + pB0[1]; _Pragma("unroll") for (int r = 2; r < 16; ++r) sacc += pB0[r]; _Pragma("unroll") for (int r = 0; r < 16; ++r) sacc += pB1[r]; l_reg += sacc;
      pw0 = (u32x4){PKW(pB0, 0), PKW(pB0, 2), PKW(pB0, 4), PKW(pB0, 6)}; pw1 = (u32x4){PKW(pB0, 8), PKW(pB0, 10), PKW(pB0, 12), PKW(pB0, 14)}; pw2 = (u32x4){PKW(pB1, 0), PKW(pB1, 2), PKW(pB1, 4), PKW(pB1, 6)}; pw3 = (u32x4){PKW(pB1, 8), PKW(pB1, 10), PKW(pB1, 12), PKW(pB1, 14)};
      SBAR(); pv(o, vb0 + sl_cur, PAF(0), PAF(1), PAF(2), PAF(3)); }
#undef PKW
#undef PAF
#undef VFR
#undef PIN
#undef MX3
#undef GAPA
#undef GAPB
#undef EX
#undef VRD
#undef KRD
#undef STEP
#undef ENDW
    { auto rr = __builtin_amdgcn_permlane32_swap(__float_as_uint(l_reg), __float_as_uint(l_reg), false, false); l_reg = __uint_as_float(rr[0]) + __uint_as_float(rr[1]); }
    if (hi == 0) wsf[32 + r32] = l_reg; asm volatile("s_waitcnt lgkmcnt(0)" ::: "memory");
    float rli[16];
#pragma unroll
    for (int r = 0; r < 16; ++r) rli[r] = __builtin_amdgcn_rcpf(wsfh[32 + crow0(r)]);
    half_t* Ow = O + (rowbase + q0 + wid * QBLK) * PO + h * D_;
    { LAS half_t* stg = (LAS half_t*)(shm + LDS_OST) + wid * 2048; LAS half_t* stgl = stg + hi * 256 + r32;
#pragma unroll
      for (int r = 0; r < 16; ++r) {
#pragma unroll
        for (int d0 = 0; d0 < 2; ++d0) stgl[crow0(r) * 64 + d0 * 32] = (half_t)(o[d0][r] * rli[r]); }
      asm volatile("s_waitcnt lgkmcnt(0)" ::: "memory");
#pragma unroll
      for (int i = 0; i < 4; ++i) { const int row = i * 8 + (lane >> 3), ch = lane & 7; const u32x4 v = *(const LAS u32x4*)(stg + row * 64 + ch * 8); *(u32x4*)(Ow + (long)row * PO + ch * 8) = v;
          const h8 hv = __builtin_bit_cast(h8, v); float s2 = 0.f;
#pragma unroll
          for (int e = 0; e < 8; ++e) s2 += (float)hv[e] * (float)hv[e];
          s2 += xor_lane<1>(s2); s2 += xor_lane<2>(s2); s2 += xor_lane<4>(s2);
#ifndef DBG_NOSSQW
          if (ch == 0) ssq[(rowbase + q0 + wid * QBLK + row) * 8 + h] = s2;
#endif
          } }
    asm volatile("s_waitcnt lgkmcnt(0)\n\ts_barrier" ::: "memory");
#undef DMA_K
#undef DMA_V
#undef PHYS
#undef CMASK
#undef SETNEGM
#undef START
#undef RESC
#undef ROT
}
#undef SBAR
#undef WAIT_BAR
#undef MFMA32
}

constexpr size_t MiB = 1u << 20;
constexpr size_t WS_CTL = 0, CTL_ZERO_BYTES = 32 * 1024;
constexpr size_t WS_MOD = 1 * MiB;
constexpr size_t WS_KMEAN = 1 * MiB + 512 * 1024;
constexpr size_t WS_S5E = 2 * MiB;
constexpr size_t WS_ROPE_C = 6 * MiB, WS_ROPE_S = 10 * MiB;
constexpr size_t WS_SMALL = 14 * MiB;
constexpr size_t SM_ABAR = WS_SMALL, SM_ABART = SM_ABAR + 16384, SM_BBT = SM_ABART + 16384, SM_CMT = SM_BBT + 262144, SM_GLUT = SM_CMT + 131072,
                 SM_WAT = SM_GLUT + 262144, SM_WXT = SM_WAT + 98304, SM_SP = SM_WXT + 98304, SM_END = SM_SP + 4096;
constexpr size_t PAR_CONVW = SM_END, PAR_CONVB = PAR_CONVW + 2 * 4 * 384 * 4, PAR_BA = PAR_CONVB + 2 * 384 * 4, PAR_BX = PAR_BA + 2 * 384 * 4, PAR_S5D = PAR_BX + 2 * 384 * 4, PAR_GLUB = PAR_S5D + 2 * 256 * 4,
                 PAR_GAIN = PAR_GLUB + 2 * 256 * 4, PAR_N1G = PAR_GAIN + 2 * 1024 * 4, PAR_N2G = PAR_N1G + 2 * 1024 * 4, PAR_ROUTER = PAR_N2G + 2 * 1024 * 4, PAR_FG = PAR_ROUTER + 1024 * 8 * 4, PAR_END = PAR_FG + 1024 * 4;
static_assert(PAR_END <= 16 * MiB, "small params");
constexpr size_t WS_MOE = 16 * MiB;
constexpr size_t MO_SEL = WS_MOE, MO_WSEL = MO_SEL + 131072, MO_TOKSLOT = MO_WSEL + 262144, MO_SLOTTOK = MO_TOKSLOT + 262144, MO_TEXP = MO_SLOTTOK + 294912, MO_BLKCNT = MO_TEXP + 4096, MO_END = MO_BLKCNT + 8192;
static_assert(MO_END <= 18 * MiB && MOE_SLOTS * 4 <= 294912, "moe tables");
#ifndef DBG_NOKSCALE
#define DBG_NOKSCALE 0
#endif
constexpr size_t WS_SSQ = 20 * MiB;
constexpr size_t WS_WIN = 32 * MiB, WS_WOUT = 41 * MiB, WS_WGU = 45 * MiB, WS_WD = 56 * MiB, WS_MGU = 62 * MiB, WS_MD = 118 * MiB;
constexpr size_t WS_RES = 146 * MiB;
constexpr size_t WS_XN8 = 210 * MiB;
constexpr size_t WS_XG8 = 242 * MiB;
constexpr size_t WS_XN = 210 * MiB;
constexpr size_t WS_S5CI = WS_XN + 2 * MiB, WS_LRUCI = WS_XN + 6 * MiB;
constexpr size_t WS_PROJ = 274 * MiB;
constexpr size_t WS_O = 410 * MiB;
constexpr size_t WS_PR = 474 * MiB;
constexpr size_t WS_HID = 308 * MiB;
constexpr size_t WS_Y = 427 * MiB;
constexpr size_t WS_END = 559 * MiB;
static_assert(WS_WIN + 2ull * NPROJ_PAD * D * 2 <= WS_WOUT && WS_WOUT + 2ull * D * D * 2 <= WS_WGU && WS_WGU + 2ull * FF * D * 2 <= WS_WD && WS_WD + (size_t)D * FF * 2 <= WS_MGU &&
              WS_MGU + 8ull * 2 * FFE * D <= WS_MD && WS_MD + 8ull * D * FFE <= WS_RES && WS_RES + (size_t)M * D * 2 <= WS_XN8 && WS_XN8 + (size_t)M * D <= WS_XG8 && WS_XG8 + (size_t)MOE_SLOTS * D <= WS_HID && WS_XN + (size_t)M * D * 2 <= WS_PROJ && WS_PROJ + (size_t)M * NPROJ * 2 <= WS_O &&
              WS_O + (size_t)M * D * 2 <= WS_PR && WS_PR + (size_t)M * LRU_W * 4 <= WS_END && WS_XN + (size_t)M * D * 2 <= WS_HID && WS_HID + (size_t)M * FF * 2 <= WS_END && WS_HID + (size_t)MOE_CH_TILES * 256 * FFE * 1 <= WS_Y &&
              WS_Y + (size_t)MOE_SLOTS * D * 2 <= WS_END && (size_t)M * LRU_W * 4 <= (size_t)M * D * 2, "d_ws map");
constexpr int CW_TMO = 0, CW_CODE = 1, CW_Q0 = 64, CW_Q1 = 128, CW_NT = 192, CW_MOD0 = 224, CW_CARRY = 240, CW_BAR = 4096;

__device__ __forceinline__ void wait_count(unsigned* ctr, unsigned n) {
    __syncthreads();
    if (threadIdx.x == 0) { while (__hip_atomic_load(ctr, __ATOMIC_RELAXED, __HIP_MEMORY_SCOPE_AGENT) < n) __builtin_amdgcn_s_sleep(1); __builtin_amdgcn_fence(__ATOMIC_ACQUIRE, "agent"); }
    __syncthreads();
}

constexpr int RING_BYTES = 131072;
constexpr int LDSCTL_OFF = RING_BYTES, MISC_OFF = LDSCTL_OFF + 320;
constexpr int LDS_BYTES = 147456;
constexpr int NWAVES = 8;

typedef GAS unsigned gu32;
#define RLX_AGENT __ATOMIC_RELAXED, __HIP_MEMORY_SCOPE_AGENT

#define XB_TMO      128
#define XB_XCNT(j)  (256  + 64 * (j))
#define XB_XSUB(j)  (1280 + 64 * (j))
#define XB_XGEN(j)  (2304 + 64 * (j))
#define XB_TOP      3328
#define XB_TOPGEN   3392
#define XCD_BAR_WORDS 3456
#define XB_SPIN_CAP (1u << 18)
__device__ __forceinline__ unsigned xb_ld(unsigned* p)              { return __hip_atomic_load(p, __ATOMIC_RELAXED, __HIP_MEMORY_SCOPE_AGENT); }
__device__ __forceinline__ unsigned xb_add(unsigned* p, unsigned v) { return __hip_atomic_fetch_add(p, v, __ATOMIC_RELAXED, __HIP_MEMORY_SCOPE_AGENT); }
__device__ __forceinline__ unsigned xb_xcc_id() { return (unsigned)__builtin_amdgcn_s_getreg((3 << 11) | 20) & 0xFu; }
#define XB_SPIN(cond, bar) do { unsigned _sp = 0; while (cond) { __builtin_amdgcn_s_sleep(1); \
    if ((++_sp & 255u) == 0u) { if (xb_ld(&(bar)[XB_TMO])) break; if (_sp > XB_SPIN_CAP) { atomicAdd(&(bar)[XB_TMO], 1u); break; } } } } while (0)
struct XcdBarrier { unsigned* bar; unsigned x; volatile LAS unsigned* st; };
__device__ __forceinline__ XcdBarrier xcd_barrier_post(unsigned* bar, volatile LAS unsigned* st) {
    XcdBarrier b; b.bar = bar; b.x = xb_xcc_id(); b.st = st;
    if (threadIdx.x == 0) (void)xb_add(&bar[XB_XCNT(b.x)], 1u);
    return b;
}
__device__ __forceinline__ void xcd_barrier_complete(unsigned* bar, unsigned x, unsigned& nloc, unsigned& nx) {
    const unsigned G = gridDim.x * gridDim.y * gridDim.z;
    unsigned sum, cnt, mine, sp = 0u;
    for (;;) {
        sum = 0u; cnt = 0u; mine = 0u;
#pragma unroll
        for (unsigned j = 0; j < 16; ++j) { const unsigned c = xb_ld(&bar[XB_XCNT(j)]); sum += c; cnt += (c > 0u) ? 1u : 0u; mine = (j == x) ? c : mine; }
        if (sum == G) break;
        __builtin_amdgcn_s_sleep(1);
        if ((++sp & 255u) == 0u) { if (xb_ld(&bar[XB_TMO])) break; if (sp > XB_SPIN_CAP) { atomicAdd(&bar[XB_TMO], 1u); break; } }
    }
    nloc = mine > 0u ? mine : 1u; nx = cnt > 0u ? cnt : 1u;
}
__device__ __forceinline__ void xcd_barrier(const XcdBarrier& b) {
    asm volatile("s_waitcnt vmcnt(0)" ::: "memory");
    __syncthreads();
    if (threadIdx.x == 0) {
        unsigned* bar = b.bar;
        __builtin_amdgcn_s_waitcnt(0);
        unsigned nloc = b.st[0], nx = b.st[1];
        if (nloc == 0u) { xcd_barrier_complete(bar, b.x, nloc, nx); b.st[0] = nloc; b.st[1] = nx; }
        const unsigned old = xb_add(&bar[XB_XSUB(b.x)], 1u);
        const unsigned gen = old / nloc;
        if (old + 1u == (gen + 1u) * nloc) {
            __builtin_amdgcn_fence(__ATOMIC_RELEASE, "agent");
            asm volatile("s_waitcnt vmcnt(0)" ::: "memory");
            const unsigned og = xb_add(&bar[XB_TOP], 1u);
            const unsigned tg = og / nx;
            if (og + 1u == (tg + 1u) * nx) xb_add(&bar[XB_TOPGEN], 1u);
            else XB_SPIN(xb_ld(&bar[XB_TOPGEN]) == tg, bar);
            __builtin_amdgcn_fence(__ATOMIC_ACQUIRE, "agent");
            xb_add(&bar[XB_XGEN(b.x)], 1u);
            asm volatile("s_waitcnt vmcnt(0)" ::: "memory");
        } else {
            XB_SPIN(xb_ld(&bar[XB_XGEN(b.x)]) == gen, bar);
            __builtin_amdgcn_fence(__ATOMIC_ACQUIRE, "agent");
            asm volatile("s_waitcnt vmcnt(0)" ::: "memory");
        }
    }
    __syncthreads();
}

struct Args {
    const void* in[35]; float* out; unsigned char* ws; int ph_lo, ph_hi;
};
enum ArgIdx { I_X = 0, I_C, I_POS, I_W_IN, I_CONV_W, I_CONV_B, I_W_A, I_B_A, I_W_X, I_B_X, I_LAM, I_S5_LRE, I_S5_LIM, I_S5_LDT, I_S5_BRE, I_S5_BIM, I_S5_CRE, I_S5_CIM, I_S5_D, I_GLU_W, I_GLU_B,
              I_MIX_GAIN, I_W_OUT, I_NORM1_G, I_NORM2_G, I_ADA_W, I_ADA_B, I_FFN_WG, I_FFN_WU, I_FFN_WD, I_ROUTER_W, I_MOE_WG, I_MOE_WU, I_MOE_WD, I_FINAL_G, I_OUT, I_WS };
__device__ __forceinline__ const void* karg(int i) {
    const __attribute__((address_space(4))) char* kp = (const __attribute__((address_space(4))) char*)__builtin_amdgcn_kernarg_segment_ptr();
    int off = 8 * i; asm volatile("" : "+s"(off));
    typedef const void* cvp_t;
    return *(const __attribute__((address_space(4))) cvp_t*)(kp + off);
}
#define KARG(T, i) ((const T*)(const GAS T*)(unsigned long long)karg(i))

using pg8::Unit;
struct EpiProj {
    static constexpr bool PERM = true;
    half_t* P; const float* rc; const float* rs;
    __device__ __forceinline__ void operator()(const f32x4 (&acc)[2][2][4][2], const Unit& u, int wr, int wc, int fr, int fq) const {
        const int i0 = 16 * (wc & 1) + 4 * fq;
#pragma unroll
        for (int ai = 0; ai < 2; ++ai)
#pragma unroll
            for (int m = 0; m < 4; ++m) {
                const int row = u.pm * 256 + ai * 128 + wr * 64 + m * 16 + fr;
                const f32x4 cv = *(const f32x4*)(rc + (size_t)row * 32 + i0), sv = *(const f32x4*)(rs + (size_t)row * 32 + i0);
#pragma unroll
                for (int bj = 0; bj < 2; ++bj) {
                    const int grp = u.pn * 4 + 2 * bj + (wc >> 1);
                    if (grp < 34) {
                        const f32x4 x1 = acc[ai][bj][m][0], x2 = acc[ai][bj][m][1]; f32x4 o1, o2;
                        if (grp < 12) { o1 = x1 * cv - x2 * sv; o2 = x2 * cv + x1 * sv; if (grp < 6) { o1 = o1 * C2; o2 = o2 * C2; } }
                        else { o1 = x1; o2 = x2; }
                        half_t* dst = P + (size_t)row * NPROJ + grp * 64 + i0;
                        u32x2 w1, w2; w1.x = pkh(o1[0], o1[1]); w1.y = pkh(o1[2], o1[3]); w2.x = pkh(o2[0], o2[1]); w2.y = pkh(o2[2], o2[3]);
                        *(u32x2*)dst = w1; *(u32x2*)(dst + 32) = w2;
                    }
                }
            }
    }
};
__device__ __forceinline__ f32x4 unpk4(u32x2 a) { const h4 h = __builtin_bit_cast(h4, a); return (f32x4){(float)h[0], (float)h[1], (float)h[2], (float)h[3]}; }
template <typename XI>
struct EpiResidT {
    static constexpr bool PERM = true;
    const XI* xin; half_t* xout; const float* gate; float osc;
    __device__ __forceinline__ void operator()(const f32x4 (&acc)[2][2][4][2], const Unit& u, int wr, int wc, int fr, int fq) const {
        const int b = u.pm >> 4; const float* gb = gate + (size_t)b * 6144;
#pragma unroll
        for (int bj = 0; bj < 2; ++bj) {
            const int col = u.pn * 256 + bj * 128 + wc * 32 + 8 * fq; const f32x4 gv0 = *(const f32x4*)(gb + col) * osc, gv1 = *(const f32x4*)(gb + col + 4) * osc;
#pragma unroll
            for (int ai = 0; ai < 2; ++ai)
#pragma unroll
                for (int m = 0; m < 4; ++m) { const size_t off = (size_t)(u.pm * 256 + ai * 128 + wr * 64 + m * 16 + fr) * D + col;
                    f32x4 x0, x1;
                    if constexpr (sizeof(XI) == 4) { x0 = *(const f32x4*)(xin + off); x1 = *(const f32x4*)(xin + off + 4); }
                    else { const u32x4 xv = *(const u32x4*)(xin + off); u32x2 lo2, hi2; lo2.x = xv.x; lo2.y = xv.y; hi2.x = xv.z; hi2.y = xv.w; x0 = unpk4(lo2); x1 = unpk4(hi2); }
                    const f32x4 r0 = x0 + gv0 * acc[ai][bj][m][0], r1 = x1 + gv1 * acc[ai][bj][m][1];
                    u32x4 w; w.x = pkh(r0[0], r0[1]); w.y = pkh(r0[2], r0[3]); w.z = pkh(r1[0], r1[1]); w.w = pkh(r1[2], r1[3]);
                    *(u32x4*)(xout + off) = w; }
        }
    }
};
struct EpiSwiglu {
    static constexpr bool PERM = true;
    half_t* H; int ldh;
    __device__ __forceinline__ void operator()(const f32x4 (&acc)[2][2][4][2], const Unit& u, int wr, int wc, int fr, int fq) const {
#pragma unroll
        for (int ai = 0; ai < 2; ++ai)
#pragma unroll
            for (int m = 0; m < 4; ++m) {
                const int row = u.pm * 256 + ai * 128 + wr * 64 + m * 16 + fr;
                const f32x4 g0 = acc[ai][0][m][0], g1 = acc[ai][0][m][1], u0 = acc[ai][1][m][0], u1 = acc[ai][1][m][1];
                u32x4 w; w.x = pkh(siluf_(g0[0]) * u0[0], siluf_(g0[1]) * u0[1]); w.y = pkh(siluf_(g0[2]) * u0[2], siluf_(g0[3]) * u0[3]);
                w.z = pkh(siluf_(g1[0]) * u1[0], siluf_(g1[1]) * u1[1]); w.w = pkh(siluf_(g1[2]) * u1[2], siluf_(g1[3]) * u1[3]);
                *(u32x4*)(H + (size_t)row * ldh + u.pn * 128 + wc * 32 + 8 * fq) = w;
            }
    }
};
struct EpiSwiglu8 {
    static constexpr bool PERM = true;
    unsigned char* H; int ldh; float osc;
    __device__ __forceinline__ void operator()(const f32x4 (&acc)[2][2][4][2], const Unit& u, int wr, int wc, int fr, int fq) const {
#pragma unroll
        for (int ai = 0; ai < 2; ++ai)
#pragma unroll
            for (int m = 0; m < 4; ++m) {
                const int row = u.pm * 256 + ai * 128 + wr * 64 + m * 16 + fr;
                const f32x4 g0 = acc[ai][0][m][0] * osc, g1 = acc[ai][0][m][1] * osc, u0 = acc[ai][1][m][0] * osc, u1 = acc[ai][1][m][1] * osc;
                u32x2 w; w.x = pk_fp8x4(siluf_(g0[0]) * u0[0], siluf_(g0[1]) * u0[1], siluf_(g0[2]) * u0[2], siluf_(g0[3]) * u0[3]);
                w.y = pk_fp8x4(siluf_(g1[0]) * u1[0], siluf_(g1[1]) * u1[1], siluf_(g1[2]) * u1[2], siluf_(g1[3]) * u1[3]);
                *(u32x2*)(H + (size_t)row * ldh + u.pn * 128 + wc * 32 + 8 * fq) = w;
            }
    }
};
struct EpiY {
    static constexpr bool PERM = true;
    half_t* Y; float osc;
    __device__ __forceinline__ void operator()(const f32x4 (&acc)[2][2][4][2], const Unit& u, int wr, int wc, int fr, int fq) const {
#pragma unroll
        for (int ai = 0; ai < 2; ++ai)
#pragma unroll
            for (int m = 0; m < 4; ++m) {
                const int row = u.pm * 256 + ai * 128 + wr * 64 + m * 16 + fr;
#pragma unroll
                for (int bj = 0; bj < 2; ++bj) { const f32x4 v0 = acc[ai][bj][m][0] * osc, v1 = acc[ai][bj][m][1] * osc;
                    u32x4 w; w.x = pkh(v0[0], v0[1]); w.y = pkh(v0[2], v0[3]); w.z = pkh(v1[0], v1[1]); w.w = pkh(v1[2], v1[3]);
                    *(u32x4*)(Y + (size_t)row * D + u.pn * 256 + bj * 128 + wc * 32 + 8 * fq) = w; }
            }
    }
};

__device__ __forceinline__ int map_row(int kind, int c) {
    if (kind == 0) return c;
    if (kind == 1) { const int grp = c >> 6, d = c & 63, n = d >> 5, i = d & 31, wcl = i >> 4, fq = (i >> 2) & 3, e = i & 3, pn = grp >> 2, hl = grp & 3, bj = hl >> 1, wc = 2 * (hl & 1) + wcl;
        return pn * 256 + 128 * bj + 32 * wc + 8 * fq + 4 * n + e; }
    const int tile = c >> 7, w = c & 127; return tile * 256 + (kind == 3 ? 128 : 0) + w;
}
__device__ __forceinline__ void p0_transpose_item(const float* W, int K, int N, half_t* WT, int kind, LAS half_t* scr, int item, int lane, const float* kscale = nullptr) {
    const int nblk = N / 64, kb = item / nblk, nb = item % nblk, k0 = 64 * kb, n0 = 64 * nb;
    const int n4 = lane & 15, kr = lane >> 4;
    f32x4 v[16];
#pragma unroll
    for (int i = 0; i < 16; ++i) v[i] = *(const f32x4*)(W + (size_t)(k0 + 4 * i + kr) * N + n0 + 4 * n4);
    if (kscale && !DBG_NOKSCALE) {
#pragma unroll
        for (int i = 0; i < 16; ++i) v[i] = v[i] * kscale[k0 + 4 * i + kr]; }
#pragma unroll
    for (int i = 0; i < 16; ++i) {
#pragma unroll
        for (int j = 0; j < 4; ++j) scr[(4 * n4 + j) * 72 + 4 * i + kr] = (half_t)v[i][j]; }
    LDS_WAIT(); asm volatile("" ::: "memory");
#pragma unroll
    for (int r = 0; r < 8; ++r) { const int idx = r * 64 + lane, n = idx >> 3, c = idx & 7;
        const u32x4 o = *(const LAS u32x4*)(scr + n * 72 + 8 * c);
        *(u32x4*)(WT + (size_t)map_row(kind, n0 + n) * K + k0 + 8 * c) = o; }
    LDS_WAIT(); asm volatile("" ::: "memory");
}
__device__ __forceinline__ void p0_transpose_item_fp8(const float* W, int K, int N, unsigned char* WT, int kind, float wscale, LAS unsigned char* scr, int item, int lane) {
    const int nblk = N / 32, kb = item / nblk, nb = item % nblk, k0 = 128 * kb, n0 = 32 * nb;
    const int n4 = lane & 7, kr = lane >> 3;
    LAS unsigned* sd = (LAS unsigned*)scr;
    f32x4 v[16];
#pragma unroll
    for (int i = 0; i < 16; ++i) v[i] = *(const f32x4*)(W + (size_t)(k0 + 32 * (i >> 2) + 4 * kr + (i & 3)) * N + n0 + 4 * n4);
#pragma unroll
    for (int ii = 0; ii < 4; ++ii) {
#pragma unroll
        for (int j = 0; j < 4; ++j) sd[(4 * n4 + j) * 33 + 8 * ii + kr] = pk_fp8x4(v[4 * ii][j] * wscale, v[4 * ii + 1][j] * wscale, v[4 * ii + 2][j] * wscale, v[4 * ii + 3][j] * wscale); }
    LDS_WAIT(); asm volatile("" ::: "memory");
#pragma unroll
    for (int r = 0; r < 4; ++r) { const int idx = r * 64 + lane, n = idx >> 3, c = idx & 7;
        u32x4 o; o.x = sd[n * 33 + 4 * c]; o.y = sd[n * 33 + 4 * c + 1]; o.z = sd[n * 33 + 4 * c + 2]; o.w = sd[n * 33 + 4 * c + 3];
        *(u32x4*)(WT + (size_t)map_row(kind, n0 + n) * K + k0 + 16 * c) = o; }
    LDS_WAIT(); asm volatile("" ::: "memory");
}
__device__ __forceinline__ void sincos_d(double a, double& s, double& c) {
    const double q = rint(a * 0.63661977236758134308), y = a - q * 1.57079632679489661923, y2 = y * y;
    const double sy = y * (1.0 + y2 * (-1.0 / 6 + y2 * (1.0 / 120 + y2 * (-1.0 / 5040 + y2 * (1.0 / 362880 + y2 * (-1.0 / 39916800 + y2 * (1.0 / 6227020800.0)))))));
    const double cy = 1.0 + y2 * (-0.5 + y2 * (1.0 / 24 + y2 * (-1.0 / 720 + y2 * (1.0 / 40320 + y2 * (-1.0 / 3628800 + y2 * (1.0 / 479001600.0))))));
    const int qi = ((int)(long long)q) & 3;
    s = (qi == 0) ? sy : (qi == 1) ? cy : (qi == 2) ? -sy : -cy;
    c = (qi == 0) ? cy : (qi == 1) ? -sy : (qi == 2) ? -cy : sy;
}

struct Ctx {
    LAS unsigned char* lds; int tid, lane, wave, G, bid, gw, NGW;
    unsigned char* ws;
};
#define WSP(T, off) ((T*)(GAS T*)((unsigned long long)C.ws + (off)))

__device__ __forceinline__ void p0_prologue(const Ctx& C) {
    LAS half_t* scr = (LAS half_t*)(C.lds + C.wave * 16384);
    constexpr int I_IN = (D / 64) * (NPROJ / 64), I_OUT = (D / 64) * (D / 64), I_FG = (D / 64) * (FF / 64), I_FD = (FF / 64) * (D / 64), I_MG = (D / 64) * (FFE / 64), I_MD = (FFE / 64) * (D / 64);
    constexpr int NITEMS = 2 * I_IN + 2 * I_OUT + 2 * I_FG + I_FD + 16 * I_MG + 8 * I_MD;
#ifndef DBG_P0MASK
#define DBG_P0MASK 0x7f
#endif
#ifndef DBG_ITEM_LO
#define DBG_ITEM_LO 0
#define DBG_ITEM_HI NITEMS
#endif
    if (DBG_P0MASK & 64) for (int it = C.bid; it < 2 * 96; it += C.G) {
        __syncthreads();
        LAS float* sc = (LAS float*)C.lds; LAS float* red = (LAS float*)(C.lds + 32768);
        for (int i = C.tid; i < BATCH * D; i += 512) sc[i] = siluf_(KARG(float, I_C)[i]);
        __syncthreads();
        const int l = it / 96, n = (it % 96) * 64 + C.lane; float acc[8];
#pragma unroll
        for (int b = 0; b < 8; ++b) acc[b] = 0.f;
        const float* wp = KARG(float, I_ADA_W) + ((size_t)l * D + C.wave * 128) * 6144 + n;
#pragma unroll 8
        for (int k = 0; k < 128; ++k) { const float wv = wp[(size_t)k * 6144];
#pragma unroll
            for (int b = 0; b < 8; ++b) acc[b] += sc[b * D + C.wave * 128 + k] * wv; }
#pragma unroll
        for (int b = 0; b < 8; ++b) red[(C.wave * 8 + b) * 64 + C.lane] = acc[b];
        __syncthreads();
        { const int b = C.wave; float s = KARG(float, I_ADA_B)[(size_t)l * 6144 + n];
#pragma unroll
          for (int w = 0; w < 8; ++w) s += red[(w * 8 + b) * 64 + C.lane];
          WSP(float, WS_MOD)[((size_t)l * 8 + b) * 6144 + n] = s; }
        asm volatile("s_waitcnt vmcnt(0)" ::: "memory");
        __syncthreads();
        if (it < 32 && C.tid == 0) {
            __builtin_amdgcn_fence(__ATOMIC_RELEASE, "agent"); (void)__hip_atomic_fetch_add(WSP(unsigned, WS_CTL) + CW_MOD0, 1u, __ATOMIC_RELAXED, __HIP_MEMORY_SCOPE_AGENT); }
    }
    constexpr int NMODB = 2 * 96, LATE = 3;
    if (DBG_P0MASK & 1) for (int rnd = (C.bid < NMODB ? LATE : 0); ; ++rnd) {
        const int it = rnd < LATE ? rnd * ((C.G - NMODB) * NWAVES) + (C.gw - NMODB * NWAVES) : LATE * ((C.G - NMODB) * NWAVES) + (rnd - LATE) * C.NGW + C.gw;
        if (it >= NITEMS) break;
        int r = it; if (it < DBG_ITEM_LO || it >= DBG_ITEM_HI) continue;
        if (r < 2 * I_IN) { const int l = r / I_IN; p0_transpose_item(KARG(float, I_W_IN) + (size_t)l * D * NPROJ, D, NPROJ, WSP(half_t, WS_WIN) + (size_t)l * NPROJ_PAD * D, 1, scr, r % I_IN, C.lane); continue; } r -= 2 * I_IN;
        if (r < 2 * I_OUT) { const int l = r / I_OUT; p0_transpose_item(KARG(float, I_W_OUT) + (size_t)l * D * D, D, D, WSP(half_t, WS_WOUT) + (size_t)l * D * D, 0, scr, r % I_OUT, C.lane, KARG(float, I_MIX_GAIN) + (size_t)l * D); continue; } r -= 2 * I_OUT;
#if DENSE_FP8
        if (r < I_FG) { p0_transpose_item_fp8(KARG(float, I_FFN_WG), D, FF, WSP(unsigned char, WS_WGU), 2, 32.f, (LAS unsigned char*)scr, r, C.lane); continue; } r -= I_FG;
        if (r < I_FG) { p0_transpose_item_fp8(KARG(float, I_FFN_WU), D, FF, WSP(unsigned char, WS_WGU), 3, 32.f, (LAS unsigned char*)scr, r, C.lane); continue; } r -= I_FG;
        if (r < I_FD) { p0_transpose_item_fp8(KARG(float, I_FFN_WD), FF, D, WSP(unsigned char, WS_WD), 0, 64.f, (LAS unsigned char*)scr, r, C.lane); continue; } r -= I_FD;
#else
        if (r < I_FG) { p0_transpose_item(KARG(float, I_FFN_WG), D, FF, WSP(half_t, WS_WGU), 2, scr, r, C.lane); continue; } r -= I_FG;
        if (r < I_FG) { p0_transpose_item(KARG(float, I_FFN_WU), D, FF, WSP(half_t, WS_WGU), 3, scr, r, C.lane); continue; } r -= I_FG;
        if (r < I_FD) { p0_transpose_item(KARG(float, I_FFN_WD), FF, D, WSP(half_t, WS_WD), 0, scr, r, C.lane); continue; } r -= I_FD;
#endif
        if (r < 8 * I_MG) { const int e = r / I_MG; p0_transpose_item_fp8(KARG(float, I_MOE_WG) + (size_t)e * D * FFE, D, FFE, WSP(unsigned char, WS_MGU) + (size_t)e * 2 * FFE * D, 2, 32.f, (LAS unsigned char*)scr, r % I_MG, C.lane); continue; } r -= 8 * I_MG;
        if (r < 8 * I_MG) { const int e = r / I_MG; p0_transpose_item_fp8(KARG(float, I_MOE_WU) + (size_t)e * D * FFE, D, FFE, WSP(unsigned char, WS_MGU) + (size_t)e * 2 * FFE * D, 3, 32.f, (LAS unsigned char*)scr, r % I_MG, C.lane); continue; } r -= 8 * I_MG;
        { const int e = r / I_MD; p0_transpose_item_fp8(KARG(float, I_MOE_WD) + (size_t)e * FFE * D, FFE, D, WSP(unsigned char, WS_MD) + (size_t)e * D * FFE, 0, 64.f, (LAS unsigned char*)scr, r % I_MD, C.lane); }
    }
    const int gt = C.bid * 512 + C.tid, NTH = C.G * 512;
    if (DBG_P0MASK & 2) for (int i = gt; i < 2 * 128 * D / 8; i += NTH) { const int l = i / (128 * D / 8), r = i % (128 * D / 8);
        *(u32x4*)(WSP(half_t, WS_WIN) + (size_t)l * NPROJ_PAD * D + (size_t)NPROJ * D + (size_t)r * 8) = (u32x4){0u, 0u, 0u, 0u}; }
    if (DBG_P0MASK & 4) for (int i = gt; i < M * 32; i += NTH) { const int row = i >> 5, fi = i & 31;
        const double inv = exp2(-(double)fi * (13.287712379549449 / 32.0));
        double s, c; sincos_d((double)KARG(int, I_POS)[row] * inv, s, c);
        WSP(float, WS_ROPE_C)[i] = (float)c; WSP(float, WS_ROPE_S)[i] = (float)s; }
    if (DBG_P0MASK & 8) for (int i = gt; i < 2 * S5_G * S5_P * 16; i += NTH) { const int q = i >> 4, h = i & 15, lg = q >> 6, p = q & 63;
        const double dt = exp((double)KARG(float, I_S5_LDT)[lg]), lr = KARG(float, I_S5_LRE)[q], li = KARG(float, I_S5_LIM)[q];
        const double mag = exp(lr * dt); double s, c; sincos_d(li * dt, s, c);
        const double are = mag * c, aim = mag * s, den = lr * lr + li * li, nr = are - 1.0, ni = aim;
        const double cre = (nr * lr + ni * li) / den, cim = (ni * lr - nr * li) / den;
        if (h == 0) { WSP(float, SM_ABAR)[2 * q] = (float)are; WSP(float, SM_ABAR)[2 * q + 1] = (float)aim;
            const double magT = exp(lr * dt * CH_T); double sT, cT; sincos_d(li * dt * CH_T, sT, cT);
            WSP(float, SM_ABART)[2 * q] = (float)(magT * cT); WSP(float, SM_ABART)[2 * q + 1] = (float)(magT * sT); }
        half_t* bbt = WSP(half_t, SM_BBT) + (size_t)lg * 128 * 32;
        const double br = KARG(float, I_S5_BRE)[(size_t)q * 16 + h], bi = KARG(float, I_S5_BIM)[(size_t)q * 16 + h];
        bbt[(2 * p) * 32 + h] = (half_t)(float)(cre * br - cim * bi); bbt[(2 * p + 1) * 32 + h] = (half_t)(float)(cre * bi + cim * br);
        bbt[(2 * p) * 32 + 16 + h] = (half_t)0.f; bbt[(2 * p + 1) * 32 + 16 + h] = (half_t)0.f;
        half_t* cmt = WSP(half_t, SM_CMT) + (size_t)lg * 16 * 128;
        cmt[h * 128 + 2 * p] = (half_t)KARG(float, I_S5_CRE)[((size_t)lg * 16 + h) * 64 + p]; cmt[h * 128 + 2 * p + 1] = (half_t)(-KARG(float, I_S5_CIM)[((size_t)lg * 16 + h) * 64 + p]);
    }
    if (DBG_P0MASK & 16) for (int i = gt; i < 2 * 256 * 256; i += NTH) { const int l = i >> 16, n = (i >> 8) & 255, k = i & 255; WSP(half_t, SM_GLUT)[i] = (half_t)KARG(float, I_GLU_W)[((size_t)l * 256 + k) * 256 + n]; }
    for (int i = gt; i < 2 * 6 * 64 * 64; i += NTH) { const int lh = i >> 12, j = (i >> 6) & 63, ii = i & 63;
        WSP(half_t, SM_WAT)[i] = (half_t)KARG(float, I_W_A)[((size_t)lh * 64 + ii) * 64 + j]; WSP(half_t, SM_WXT)[i] = (half_t)KARG(float, I_W_X)[((size_t)lh * 64 + ii) * 64 + j]; }
    for (int i = gt; i < 2 * LRU_W; i += NTH) WSP(float, SM_SP)[i] = (float)log1p(exp(-(double)KARG(float, I_LAM)[i]));
#define CPY(dst_off, src, n) for (int i = gt; i < (n); i += NTH) WSP(float, dst_off)[i] = (src)[i];
    CPY(PAR_CONVW, KARG(float, I_CONV_W), 2 * 4 * 384) CPY(PAR_CONVB, KARG(float, I_CONV_B), 2 * 384) CPY(PAR_BA, KARG(float, I_B_A), 2 * 384) CPY(PAR_BX, KARG(float, I_B_X), 2 * 384) CPY(PAR_S5D, KARG(float, I_S5_D), 2 * 256) CPY(PAR_GLUB, KARG(float, I_GLU_B), 2 * 256)
    CPY(PAR_GAIN, KARG(float, I_MIX_GAIN), 2 * 1024) CPY(PAR_N1G, KARG(float, I_NORM1_G), 2 * 1024) CPY(PAR_N2G, KARG(float, I_NORM2_G), 2 * 1024) CPY(PAR_ROUTER, KARG(float, I_ROUTER_W), 1024 * 8) CPY(PAR_FG, KARG(float, I_FINAL_G), 1024)
#undef CPY
}

template <typename XI> __device__ __forceinline__ f32x4 ldrow4(const XI* xin, int m, int lane, int j) {
    if constexpr (sizeof(XI) == 4) return ((const f32x4*)(xin + (size_t)m * D) + lane)[64 * j];
    else return unpk4(((const u32x2*)(xin + (size_t)m * D) + lane)[64 * j]);
}
template <bool ROUTER, bool FP8OUT = ROUTER, typename XI = half_t>
__device__ __forceinline__ void row_pass_xn(const Ctx& C, const XI* xin, const float* g, const float* shift0, const float* scale0, half_t* XN, const float* router_w, LAS unsigned* lcnt) {
    constexpr int RPW = M / (256 * NWAVES);
    const int m0 = C.gw * RPW, b = m0 >> 12;
    const float* shb = shift0 + (size_t)b * 6144; const float* scb = scale0 + (size_t)b * 6144;
    f32x4 gs[4], sh[4];
#pragma unroll
    for (int j = 0; j < 4; ++j) { const int col = 4 * C.lane + 256 * j; gs[j] = *(const f32x4*)(g + col) * (*(const f32x4*)(scb + col) + 1.f); sh[j] = *(const f32x4*)(shb + col); }
    f32x4 rw[ROUTER ? 16 : 1][2];
    if constexpr (ROUTER) {
#pragma unroll
        for (int j = 0; j < 4; ++j)
#pragma unroll
            for (int cc = 0; cc < 4; ++cc) { const int col = 4 * C.lane + 256 * j + cc; rw[4 * j + cc][0] = *(const f32x4*)(router_w + (size_t)col * 8); rw[4 * j + cc][1] = *(const f32x4*)(router_w + (size_t)col * 8 + 4); } }
    constexpr int RG = ROUTER ? 4 : 8;
    for (int mg = m0; mg < m0 + RPW; mg += RG) {
      f32x4 vv[RG][4];
#pragma unroll
      for (int r = 0; r < RG; ++r)
#pragma unroll
        for (int j = 0; j < 4; ++j) vv[r][j] = ldrow4(xin, mg + r, C.lane, j);
#pragma unroll
      for (int r = 0; r < RG; ++r) { const int m = mg + r;
        f32x4 v[4]; float ss = 0.f;
#pragma unroll
        for (int j = 0; j < 4; ++j) { v[j] = vv[r][j]; ss += (v[j].x * v[j].x + v[j].y * v[j].y) + (v[j].z * v[j].z + v[j].w * v[j].w); }
        const float rstd = 1.f / sqrtf(wave_sum(ss) * (1.f / D) + EPS);
        u32x2* o8 = (u32x2*)(XN + (size_t)m * D) + C.lane;
#pragma unroll
        for (int j = 0; j < 4; ++j) { v[j] = v[j] * rstd * gs[j] + sh[j];
            if constexpr (FP8OUT) ((unsigned*)((unsigned char*)XN + (size_t)m * D) + C.lane)[64 * j] = pk_fp8x4(v[j].x, v[j].y, v[j].z, v[j].w);
            else { u32x2 w; w.x = pkh(v[j].x, v[j].y); w.y = pkh(v[j].z, v[j].w); o8[64 * j] = w; } }
        if constexpr (ROUTER) {
            float lg[8];
#pragma unroll
            for (int e = 0; e < 8; ++e) lg[e] = 0.f;
#pragma unroll
            for (int j = 0; j < 4; ++j)
#pragma unroll
                for (int cc = 0; cc < 4; ++cc) { const f32x4 r0 = rw[4 * j + cc][0], r1 = rw[4 * j + cc][1]; const float hv = v[j][cc];
                    lg[0] += hv * r0.x; lg[1] += hv * r0.y; lg[2] += hv * r0.z; lg[3] += hv * r0.w; lg[4] += hv * r1.x; lg[5] += hv * r1.y; lg[6] += hv * r1.z; lg[7] += hv * r1.w; }
#pragma unroll
            for (int e = 0; e < 8; ++e) lg[e] = wave_sum(lg[e]);
            int e0 = 0; float t0 = lg[0];
#pragma unroll
            for (int e = 1; e < 8; ++e) if (lg[e] > t0) { t0 = lg[e]; e0 = e; }
            int e1 = -1; float t1 = -INFINITY;
#pragma unroll
            for (int e = 0; e < 8; ++e) if (e != e0 && lg[e] > t1) { t1 = lg[e]; e1 = e; }
            const float w0 = 1.f / (1.f + expf(t1 - t0));
            if (C.lane == 0) { WSP(int, MO_SEL)[m] = e0 | (e1 << 8); WSP(float, MO_WSEL)[2 * m] = w0; WSP(float, MO_WSEL)[2 * m + 1] = 1.f - w0;
                __hip_atomic_fetch_add(&lcnt[e0], 1u, __ATOMIC_RELAXED, __HIP_MEMORY_SCOPE_WORKGROUP); __hip_atomic_fetch_add(&lcnt[e1], 1u, __ATOMIC_RELAXED, __HIP_MEMORY_SCOPE_WORKGROUP); }
        }
      }
    }
}
__device__ __forceinline__ void row_pass_final(const Ctx& C, const half_t* xin, float* xout, const float* gate2_0, const float* fg) {
    constexpr int RPW = M / (256 * NWAVES);
    const int m0 = C.gw * RPW, b = m0 >> 12;
    int ts = 0; float wsv = 0.f;
    if (C.lane < 2 * RPW) { ts = WSP(int, MO_TOKSLOT)[2 * m0 + C.lane]; wsv = WSP(float, MO_WSEL)[2 * m0 + C.lane]; }
    f32x4 gg[4], fgv[4];
#pragma unroll
    for (int j = 0; j < 4; ++j) { const int col = 4 * C.lane + 256 * j; gg[j] = *(const f32x4*)(gate2_0 + (size_t)b * 6144 + col); fgv[j] = *(const f32x4*)(fg + col); }
    const half_t* Y = WSP(half_t, WS_Y);
    constexpr int FG = 4;
    for (int mg = 0; mg < RPW; mg += FG) {
        u32x2 xr[FG][4], ya[FG][4], yc[FG][4]; float w0[FG], w1[FG];
#pragma unroll
        for (int r = 0; r < FG; ++r) { const int s0 = __builtin_amdgcn_readlane(ts, 2 * (mg + r)), s1 = __builtin_amdgcn_readlane(ts, 2 * (mg + r) + 1);
            w0[r] = __builtin_bit_cast(float, __builtin_amdgcn_readlane(__builtin_bit_cast(int, wsv), 2 * (mg + r))); w1[r] = __builtin_bit_cast(float, __builtin_amdgcn_readlane(__builtin_bit_cast(int, wsv), 2 * (mg + r) + 1));
            const u32x2* y0 = (const u32x2*)(Y + (size_t)s0 * D) + C.lane; const u32x2* y1 = (const u32x2*)(Y + (size_t)s1 * D) + C.lane; const u32x2* xp = (const u32x2*)(xin + (size_t)(m0 + mg + r) * D) + C.lane;
#pragma unroll
            for (int j = 0; j < 4; ++j) { xr[r][j] = xp[64 * j]; ya[r][j] = y0[64 * j]; yc[r][j] = y1[64 * j]; } }
#pragma unroll
        for (int r = 0; r < FG; ++r) { f32x4* xo = (f32x4*)(xout + (size_t)(m0 + mg + r) * D) + C.lane;
            f32x4 v[4]; float ss = 0.f;
#pragma unroll
            for (int j = 0; j < 4; ++j) { v[j] = unpk4(xr[r][j]) + gg[j] * (unpk4(ya[r][j]) * w0[r] + unpk4(yc[r][j]) * w1[r]); ss += (v[j].x * v[j].x + v[j].y * v[j].y) + (v[j].z * v[j].z + v[j].w * v[j].w); }
            const float rstd = 1.f / sqrtf(wave_sum(ss) * (1.f / D) + EPS);
#pragma unroll
            for (int j = 0; j < 4; ++j) xo[64 * j] = v[j] * rstd * fgv[j]; }
    }
}
__device__ __forceinline__ void row_pass_attnorm(const Ctx& C, half_t* O, const float* gain) {
    constexpr int RPW = M / (256 * NWAVES);
    for (int m = C.gw * RPW; m < C.gw * RPW + RPW && m < M; ++m) {
        u32x2* o8 = (u32x2*)(O + (size_t)m * D) + C.lane;
        f32x4 v0, v1 = {0.f, 0.f, 0.f, 0.f};
        v0 = unpk4(o8[0]);
        if (C.lane < 32) v1 = unpk4(o8[64]);
        const float ss = (v0.x * v0.x + v0.y * v0.y) + (v0.z * v0.z + v0.w * v0.w) + (v1.x * v1.x + v1.y * v1.y) + (v1.z * v1.z + v1.w * v1.w);
#ifdef DBG_ATTSCALE
        const float rstd = DBG_ATTSCALE / sqrtf(wave_sum(ss) * (1.f / 384.f) + EPS);
#else
        const float rstd = 1.f / sqrtf(wave_sum(ss) * (1.f / 384.f) + EPS);
#endif
        { const f32x4 gg = *(const f32x4*)(gain + 4 * C.lane); const f32x4 r = v0 * rstd * gg; u32x2 w; w.x = pkh(r.x, r.y); w.y = pkh(r.z, r.w); o8[0] = w; }
        if (C.lane < 32) { const f32x4 gg = *(const f32x4*)(gain + 256 + 4 * C.lane); const f32x4 r = v1 * rstd * gg; u32x2 w; w.x = pkh(r.x, r.y); w.y = pkh(r.z, r.w); o8[64] = w; }
#ifdef DBG_KEEP
        { const u32x2 z = {0u, 0u};
          if (!(DBG_KEEP & 1)) { o8[0] = z; if (C.lane < 32) o8[64] = z; }
          if (!(DBG_KEEP & 2)) { if (C.lane >= 32) o8[64] = z; o8[128] = z; }
          if (!(DBG_KEEP & 4)) { o8[192] = z; } }
#endif
    }
}

__device__ __forceinline__ f32x4 mm16(const LAS half_t* Ap, int lda, const half_t* Bt, int ldb, int ksteps, f32x4 acc, int lane) {
    const int ar = lane & 15, kq = lane >> 4;
    for (int ks = 0; ks < ksteps; ++ks) { const h8 a = *(const LAS h8*)(Ap + ar * lda + ks * 32 + kq * 8); const h8 b = *(const h8*)(Bt + (size_t)ar * ldb + ks * 32 + kq * 8);
        acc = __builtin_amdgcn_mfma_f32_16x16x32_f16(a, b, acc, 0, 0, 0); }
    return acc;
}

__device__ __forceinline__ f32x4 mm16t(const LAS half_t* Ap, int lda, const half_t* Bt, int ldb, int ksteps, f32x4 acc, int lane) {
    const int ar = lane & 15, kq = lane >> 4;
    for (int ks = 0; ks < ksteps; ++ks) { const h8 a = *(const LAS h8*)(Ap + ar * lda + ks * 32 + kq * 8); const h8 b = *(const h8*)(Bt + (size_t)ar * ldb + ks * 32 + kq * 8);
        acc = __builtin_amdgcn_mfma_f32_16x16x32_f16(b, a, acc, 0, 0, 0); }
    return acc;
}
__device__ __forceinline__ void kmean_items(const Ctx& C) {
    const half_t* P = WSP(half_t, WS_PROJ); const int dch = C.lane & 7, rg = C.lane >> 3;
    for (int it = C.bid + C.G * C.wave; it < BATCH * NH * 16; it += C.NGW) { const int n = it & 15, bh = it >> 4, h = bh % NH, b = bh / NH;
        const half_t* kp = P + ((size_t)b * SEQ + n * 256 + rg) * NPROJ + COL_K + h * 64 + dch * 8; float s[8];
#pragma unroll
        for (int k = 0; k < 8; ++k) s[k] = 0.f;
#pragma unroll
        for (int r = 0; r < 32; ++r) { const h8 v = *(const h8*)(kp + (size_t)(8 * r) * NPROJ);
#pragma unroll
            for (int k = 0; k < 8; ++k) s[k] += (float)v[k]; }
#pragma unroll
        for (int k = 0; k < 8; ++k) { s[k] += xor_lane<8>(s[k]); s[k] += xor_lane<16>(s[k]); s[k] += xor_lane<32>(s[k]); }
        if (rg == 0) { float* o = WSP(float, WS_KMEAN) + (size_t)it * 64 + dch * 8; *(f32x4*)o = (f32x4){s[0], s[1], s[2], s[3]} * (1.f / 256.f); *(f32x4*)(o + 4) = (f32x4){s[4], s[5], s[6], s[7]} * (1.f / 256.f); } }
}
__device__ __forceinline__ void lru_prep_unit(const Ctx& C, int l, int b, int c) {
    constexpr int LDX = 392;
    LAS half_t* XC = (LAS half_t*)C.lds;
    LAS float* PRE = (LAS float*)(C.lds + 65536) + C.wave * 2048;
    const half_t* P = WSP(half_t, WS_PROJ); const size_t row0 = (size_t)b * SEQ + c * CH_T;
    const int h = C.wave < 6 ? C.wave : 0, ch = h * 64 + C.lane; const int ar = C.lane & 15, kq = C.lane >> 4; const bool act = C.wave < 6;
    const half_t* wat = WSP(half_t, SM_WAT) + ((size_t)l * 6 + h) * 4096; const half_t* wxt = WSP(half_t, SM_WXT) + ((size_t)l * 6 + h) * 4096;
    h8 wa[4][2], wx[4][2];
#pragma unroll
    for (int nt = 0; nt < 4; ++nt)
#pragma unroll
        for (int ks = 0; ks < 2; ++ks) { wa[nt][ks] = *(const h8*)(wat + (size_t)(nt * 16 + ar) * 64 + ks * 32 + kq * 8); wx[nt][ks] = *(const h8*)(wxt + (size_t)(nt * 16 + ar) * 64 + ks * 32 + kq * 8); }
    const float ba = WSP(float, PAR_BA)[l * LRU_W + ch], bx = WSP(float, PAR_BX)[l * LRU_W + ch], sp = WSP(float, SM_SP)[l * LRU_W + ch];
    __syncthreads();
    for (int i = C.tid; i < 67 * 48; i += 512) { const int r = i / 48, cc = i % 48; u32x4 v = {0u, 0u, 0u, 0u};
        if (c > 0 || r >= 3) v = *(const u32x4*)(P + (row0 + r - 3) * NPROJ + COL_XR + cc * 8);
        *(LAS u32x4*)(XC + r * LDX + cc * 8) = v; }
    __syncthreads();
    if (C.tid < LRU_W) { const int cch = C.tid; const float* cw = WSP(float, PAR_CONVW) + (size_t)l * 4 * LRU_W + cch; const float w0 = cw[0], w1 = cw[LRU_W], w2 = cw[2 * LRU_W], w3 = cw[3 * LRU_W], cb = WSP(float, PAR_CONVB)[l * LRU_W + cch];
        half_t xin[CH_T + 3];
#pragma unroll
        for (int t = 0; t < CH_T + 3; ++t) xin[t] = XC[t * LDX + cch];
#pragma unroll
        for (int t = 0; t < CH_T; ++t) XC[(t + 3) * LDX + cch] = (half_t)(w0 * (float)xin[t] + w1 * (float)xin[t + 1] + w2 * (float)xin[t + 2] + w3 * (float)xin[t + 3] + cb); }
    __syncthreads();
    float hl = 0.f, pr = 1.f; unsigned* HP = WSP(unsigned, WS_PR);
    for (int sc = 0; sc < 4; ++sc) {
        if (act) {
            const h8 a0 = *(const LAS h8*)(XC + (sc * 16 + 3 + ar) * LDX + h * 64 + kq * 8), a1 = *(const LAS h8*)(XC + (sc * 16 + 3 + ar) * LDX + h * 64 + 32 + kq * 8);
#pragma unroll
            for (int nt = 0; nt < 4; ++nt) { const f32x4 z = {0.f, 0.f, 0.f, 0.f};
                f32x4 ra = __builtin_amdgcn_mfma_f32_16x16x32_f16(wa[nt][0], a0, z, 0, 0, 0); ra = __builtin_amdgcn_mfma_f32_16x16x32_f16(wa[nt][1], a1, ra, 0, 0, 0);
                f32x4 rx = __builtin_amdgcn_mfma_f32_16x16x32_f16(wx[nt][0], a0, z, 0, 0, 0); rx = __builtin_amdgcn_mfma_f32_16x16x32_f16(wx[nt][1], a1, rx, 0, 0, 0);
                *(LAS f32x4*)(PRE + ar * 64 + nt * 16 + 4 * kq) = ra; *(LAS f32x4*)(PRE + 1024 + ar * 64 + nt * 16 + 4 * kq) = rx; } }
        __syncthreads();
        if (act) {
            float pa[16], px[16]; half_t xv[16];
#pragma unroll
            for (int tt = 0; tt < 16; ++tt) { pa[tt] = PRE[tt * 64 + C.lane]; px[tt] = PRE[1024 + tt * 64 + C.lane]; xv[tt] = XC[(sc * 16 + tt + 3) * LDX + ch]; }
#pragma unroll
            for (int tt = 0; tt < 16; ++tt) { const int t = sc * 16 + tt;
                const float rg = sigmoidf_(pa[tt] + ba), ig = sigmoidf_(px[tt] + bx), xcv = (float)xv[tt];
                const float a = __expf(-8.f * rg * sp); const float mult = __builtin_amdgcn_sqrtf(fmaxf((1.f - a) * (1.f + a), 0.f));
                hl = a * hl + mult * ig * xcv; pr *= a;
                HP[(row0 + t) * LRU_W + ch] = pkh(hl, pr); } }
        LDS_WAIT();
    }
    if (act) WSP(f32x2, WS_XN)[((size_t)b * NCH + c) * LRU_W + ch] = (f32x2){hl, pr};
}
__device__ __forceinline__ void carry_unit(const Ctx& C, int l, int b) {
    __syncthreads();
    { const f32x2* E0 = WSP(f32x2, WS_S5E) + (size_t)b * NCH * 1024; f32x2* CI = WSP(f32x2, WS_S5CI) + (size_t)b * NCH * 1024;
      float tre[2], tim[2], xre[2] = {0.f, 0.f}, xim[2] = {0.f, 0.f};
#pragma unroll
      for (int k = 0; k < 2; ++k) { const int q = C.tid + 512 * k; tre[k] = WSP(float, SM_ABART)[2 * (l * 1024 + q)]; tim[k] = WSP(float, SM_ABART)[2 * (l * 1024 + q) + 1]; }
      for (int j0 = 0; j0 < NCH; j0 += 32) { f32x2 ev[2][32];
#pragma unroll
          for (int u = 0; u < 32; ++u)
#pragma unroll
              for (int k = 0; k < 2; ++k) ev[k][u] = E0[(size_t)(j0 + u) * 1024 + C.tid + 512 * k];
#pragma unroll
          for (int u = 0; u < 32; ++u)
#pragma unroll
              for (int k = 0; k < 2; ++k) { CI[(size_t)(j0 + u) * 1024 + C.tid + 512 * k] = (f32x2){xre[k], xim[k]};
                  const float nre = tre[k] * xre[k] - tim[k] * xim[k] + ev[k][u].x, nim = tre[k] * xim[k] + tim[k] * xre[k] + ev[k][u].y; xre[k] = nre; xim[k] = nim; } } }
    if (C.tid < LRU_W) { const f32x2* L0 = WSP(f32x2, WS_XN) + (size_t)b * NCH * LRU_W + C.tid; float* LC = WSP(float, WS_LRUCI) + (size_t)b * NCH * LRU_W + C.tid; float carry = 0.f;
      for (int j0 = 0; j0 < NCH; j0 += 32) { f32x2 ev[32];
#pragma unroll
          for (int u = 0; u < 32; ++u) ev[u] = L0[(size_t)(j0 + u) * LRU_W];
#pragma unroll
          for (int u = 0; u < 32; ++u) { LC[(size_t)(j0 + u) * LRU_W] = carry; carry = ev[u].y * carry + ev[u].x; } } }
    asm volatile("s_waitcnt vmcnt(0)" ::: "memory");
    __syncthreads();
    if (C.tid == 0) { __builtin_amdgcn_fence(__ATOMIC_RELEASE, "agent"); (void)__hip_atomic_fetch_add(WSP(unsigned, WS_CTL) + CW_CARRY + l * 8 + b, 1u, __ATOMIC_RELAXED, __HIP_MEMORY_SCOPE_AGENT); }
}
__device__ __forceinline__ void lru_final_unit(const Ctx& C, int l, int b, int c) {
    LAS float* CAR = (LAS float*)C.lds;
    const unsigned* HP = WSP(unsigned, WS_PR); const half_t* P = WSP(half_t, WS_PROJ); const size_t row0 = (size_t)b * SEQ + c * CH_T;
    const bool hasB = C.lane < 32; const int cA = 4 * C.lane, cB = 256 + 4 * (C.lane & 31);
    u32x4 hpA[8], hpB[8]; u32x2 gtA[8], gtB[8];
#pragma unroll
    for (int r = 0; r < 8; ++r) { const size_t row = row0 + C.wave * 8 + r;
        hpA[r] = *(const u32x4*)(HP + row * LRU_W + cA); gtA[r] = *(const u32x2*)(P + row * NPROJ + COL_GT + cA);
        hpB[r] = *(const u32x4*)(HP + row * LRU_W + cB); gtB[r] = *(const u32x2*)(P + row * NPROJ + COL_GT + cB); }
    const float* LC = WSP(float, WS_LRUCI) + ((size_t)b * NCH + c) * LRU_W;
    const f32x4 carA = *(const f32x4*)(LC + cA), carB = *(const f32x4*)(LC + cB);
    half_t* O = WSP(half_t, WS_O);
#pragma unroll
    for (int r = 0; r < 8; ++r) { const size_t row = row0 + C.wave * 8 + r;
        const h8 pa = __builtin_bit_cast(h8, hpA[r]), pb = __builtin_bit_cast(h8, hpB[r]);
        const f32x4 ga = unpk4(gtA[r]), gb = unpk4(gtB[r]);
        f32x4 oa = (f32x4){(float)pa[0], (float)pa[2], (float)pa[4], (float)pa[6]} + (f32x4){(float)pa[1], (float)pa[3], (float)pa[5], (float)pa[7]} * carA;
        f32x4 ob = (f32x4){(float)pb[0], (float)pb[2], (float)pb[4], (float)pb[6]} + (f32x4){(float)pb[1], (float)pb[3], (float)pb[5], (float)pb[7]} * carB;
        oa = (f32x4){oa.x * gelu_tanh(ga.x), oa.y * gelu_tanh(ga.y), oa.z * gelu_tanh(ga.z), oa.w * gelu_tanh(ga.w)};
        ob = (f32x4){ob.x * gelu_tanh(gb.x), ob.y * gelu_tanh(gb.y), ob.z * gelu_tanh(gb.z), ob.w * gelu_tanh(gb.w)};
        if (!hasB) ob = (f32x4){0.f, 0.f, 0.f, 0.f};
        const float ss = (oa.x * oa.x + oa.y * oa.y) + (oa.z * oa.z + oa.w * oa.w) + (ob.x * ob.x + ob.y * ob.y) + (ob.z * ob.z + ob.w * ob.w);
        const float rstd = 1.f / sqrtf(wave_sum(ss) * (1.f / 384.f) + EPS);
        { const f32x4 q = oa * rstd; u32x2 w; w.x = pkh(q.x, q.y); w.y = pkh(q.z, q.w); *(u32x2*)(O + row * D + 384 + cA) = w; }
        if (hasB) { const f32x4 q = ob * rstd; u32x2 w; w.x = pkh(q.x, q.y); w.y = pkh(q.z, q.w); *(u32x2*)(O + row * D + 384 + cB) = w; } }
}
template <bool FINAL>
__device__ __forceinline__ void s5_unit(const Ctx& C, int l, int b, int c) {
    constexpr int LDU = 264, LDB = 136;
    LAS half_t* UT = (LAS half_t*)C.lds;
    LAS half_t* SCR = (LAS half_t*)(C.lds + 34816) + C.wave * (2 * 16 * LDB);
    const half_t* P = WSP(half_t, WS_PROJ); const size_t row0 = (size_t)b * SEQ + c * CH_T;
    __syncthreads();
    for (int i = C.tid; i < 64 * 32; i += 512) { const int t = i >> 5, cc = i & 31; *(LAS u32x4*)(UT + t * LDU + cc * 8) = *(const u32x4*)(P + (row0 + t) * NPROJ + COL_U + cc * 8); }
    const int ar = C.lane & 15, kq = C.lane >> 4, p = C.lane;
    float xre[2] = {0.f, 0.f}, xim[2] = {0.f, 0.f};
    if constexpr (FINAL) {
        const f32x2* CI = WSP(f32x2, WS_S5CI) + (((size_t)b * NCH + c) * 16 + C.wave) * 64 + p;
        const f32x2 c0 = CI[0], c1 = CI[8 * 64]; xre[0] = c0.x; xim[0] = c0.y; xre[1] = c1.x; xim[1] = c1.y; }
    float are[2], aim[2]; f32x4 dskv[2]; h8 bfr[2][8], cfr[2][4];
#pragma unroll
    for (int gi = 0; gi < 2; ++gi) { const int g = C.wave + 8 * gi, lg = l * 16 + g;
        are[gi] = WSP(float, SM_ABAR)[2 * (lg * 64 + p)]; aim[gi] = WSP(float, SM_ABAR)[2 * (lg * 64 + p) + 1];
        const half_t* bbt = WSP(half_t, SM_BBT) + (size_t)lg * 128 * 32;
#pragma unroll
        for (int nt = 0; nt < 8; ++nt) bfr[gi][nt] = *(const h8*)(bbt + (nt * 16 + ar) * 32 + kq * 8);
        if constexpr (FINAL) { const half_t* cmt = WSP(half_t, SM_CMT) + (size_t)lg * 16 * 128;
#pragma unroll
            for (int ks = 0; ks < 4; ++ks) cfr[gi][ks] = *(const h8*)(cmt + ar * 128 + ks * 32 + kq * 8);
            dskv[gi] = *(const f32x4*)(WSP(float, PAR_S5D) + l * S5_W + g * 16 + 4 * kq); } }
    h8 gf[FINAL ? 2 : 1][FINAL ? 8 : 1];
    if constexpr (FINAL) { const half_t* glut = WSP(half_t, SM_GLUT) + (size_t)l * 65536;
#pragma unroll
        for (int j = 0; j < 2; ++j)
#pragma unroll
            for (int ks = 0; ks < 8; ++ks) gf[j][ks] = *(const h8*)(glut + (size_t)((2 * C.wave + j) * 16 + ar) * 256 + ks * 32 + kq * 8); }
    __syncthreads();
    for (int sc = 0; sc < 4; ++sc) {
#pragma unroll
        for (int gi = 0; gi < 2; ++gi) { const int g = C.wave + 8 * gi; LAS half_t* S = SCR + gi * (16 * LDB);
            h8 af = {}; if (kq < 2) af = *(const LAS h8*)(UT + (sc * 16 + ar) * LDU + g * 16 + kq * 8);
#pragma unroll
            for (int nt = 0; nt < 8; ++nt) { const f32x4 z = {0.f, 0.f, 0.f, 0.f}; const f32x4 r = __builtin_amdgcn_mfma_f32_16x16x32_f16(bfr[gi][nt], af, z, 0, 0, 0);
                u32x2 w; w.x = pkh(r[0], r[1]); w.y = pkh(r[2], r[3]); *(LAS u32x2*)(S + ar * LDB + nt * 16 + 4 * kq) = w; } }
        __syncthreads();
        { unsigned bw[2][16];
#pragma unroll
          for (int gi = 0; gi < 2; ++gi)
#pragma unroll
            for (int tt = 0; tt < 16; ++tt) bw[gi][tt] = ((const LAS unsigned*)(SCR + gi * (16 * LDB)))[tt * (LDB / 2) + p];
#pragma unroll
          for (int tt = 0; tt < 16; ++tt)
#pragma unroll
            for (int gi = 0; gi < 2; ++gi) { const h2 bu = __builtin_bit_cast(h2, bw[gi][tt]); const float bre = (float)bu[0], bim = (float)bu[1];
                const float nre = are[gi] * xre[gi] - aim[gi] * xim[gi] + bre, nim = are[gi] * xim[gi] + aim[gi] * xre[gi] + bim; xre[gi] = nre; xim[gi] = nim;
                if constexpr (FINAL) bw[gi][tt] = pkh(xre[gi], xim[gi]); }
          if constexpr (FINAL) {
#pragma unroll
            for (int gi = 0; gi < 2; ++gi)
#pragma unroll
              for (int tt = 0; tt < 16; ++tt) ((LAS unsigned*)(SCR + gi * (16 * LDB)))[tt * (LDB / 2) + p] = bw[gi][tt]; } }
        if constexpr (FINAL) {
            __syncthreads();
#pragma unroll
            for (int gi = 0; gi < 2; ++gi) { const int g = C.wave + 8 * gi; LAS half_t* S = SCR + gi * (16 * LDB);
                f32x4 y = {0.f, 0.f, 0.f, 0.f};
#pragma unroll
                for (int ks = 0; ks < 4; ++ks) { const h8 a = *(const LAS h8*)(S + ar * LDB + ks * 32 + kq * 8); y = __builtin_amdgcn_mfma_f32_16x16x32_f16(cfr[gi][ks], a, y, 0, 0, 0); }
                LAS u32x2* up = (LAS u32x2*)(UT + (sc * 16 + ar) * LDU + g * 16 + 4 * kq); const f32x4 uv = unpk4(*up); const f32x4 yv = y + dskv[gi] * uv;
                u32x2 w; w.x = pkh(gelu_tanh(yv.x), gelu_tanh(yv.y)); w.y = pkh(gelu_tanh(yv.z), gelu_tanh(yv.w)); *up = w; }
        }
        __syncthreads();
    }
    if constexpr (!FINAL) {
#pragma unroll
        for (int gi = 0; gi < 2; ++gi) WSP(f32x2, WS_S5E)[(((size_t)b * NCH + c) * 16 + C.wave + 8 * gi) * 64 + p] = (f32x2){xre[gi], xim[gi]}; }
    if constexpr (FINAL) {
        LAS float* OT = (LAS float*)(C.lds + 34816);
        f32x4 gb[2];
#pragma unroll
        for (int j = 0; j < 2; ++j) gb[j] = *(const f32x4*)(WSP(float, PAR_GLUB) + l * S5_W + (2 * C.wave + j) * 16 + 4 * kq);
#pragma unroll
        for (int mt = 0; mt < 4; ++mt) { h8 a[8];
#pragma unroll
            for (int ks = 0; ks < 8; ++ks) a[ks] = *(const LAS h8*)(UT + (mt * 16 + ar) * LDU + ks * 32 + kq * 8);
#pragma unroll
            for (int j = 0; j < 2; ++j) { const int nt = 2 * C.wave + j; f32x4 r = {0.f, 0.f, 0.f, 0.f};
#pragma unroll
                for (int ks = 0; ks < 8; ++ks) r = __builtin_amdgcn_mfma_f32_16x16x32_f16(gf[j][ks], a[ks], r, 0, 0, 0);
                const int t = mt * 16 + ar; const f32x4 yv = unpk4(*(const LAS u32x2*)(UT + t * LDU + nt * 16 + 4 * kq)); r = r + gb[j];
                *(LAS f32x4*)(OT + t * 260 + nt * 16 + 4 * kq) = (f32x4){yv.x * sigmoidf_(r.x), yv.y * sigmoidf_(r.y), yv.z * sigmoidf_(r.z), yv.w * sigmoidf_(r.w)}; } }
        __syncthreads();
        half_t* O = WSP(half_t, WS_O);
#pragma unroll
        for (int rr = 0; rr < 8; ++rr) { const int t = C.wave * 8 + rr; const f32x4 v = *(const LAS f32x4*)(OT + t * 260 + 4 * C.lane);
            const float ss = wave_sum((v.x * v.x + v.y * v.y) + (v.z * v.z + v.w * v.w)); const float rstd = 1.f / sqrtf(ss * (1.f / 256.f) + EPS);
            const f32x4 r = v * rstd; u32x2 w; w.x = pkh(r.x, r.y); w.y = pkh(r.z, r.w);
            *(u32x2*)(O + (row0 + t) * D + 768 + 4 * C.lane) = w; }
    }
}

__device__ __forceinline__ void moe_gather_rows(const Ctx& C, int nslots) {
    const unsigned char* X = WSP(unsigned char, WS_XN8); unsigned char* G = WSP(unsigned char, WS_XG8); const int* st = WSP(int, MO_SLOTTOK);
    for (int s = C.gw; s < nslots; s += C.NGW) { const int tok = st[s]; *((u32x4*)(G + (size_t)s * D) + C.lane) = *((const u32x4*)(X + (size_t)tok * D) + C.lane); }
}
__device__ __forceinline__ void moe_lists(const Ctx& C) {
    LAS int* cnt = (LAS int*)C.lds;
    LAS int* tot = cnt + 2048;
    const int* bc = WSP(int, MO_BLKCNT);
    u32x4 v[M / 256 / NWAVES];
    { const unsigned char* X = WSP(unsigned char, WS_XN8);
#pragma unroll
      for (int i = 0; i < M / 256 / NWAVES; ++i) { const int m = C.bid * (M / 256) + C.wave + NWAVES * i; v[i] = *((const u32x4*)(X + (size_t)m * D) + C.lane); } }
    __syncthreads();
    for (int i = C.tid; i < C.G * 8; i += 512) cnt[i] = bc[i];
    if (C.tid < 8) tot[32 + C.tid] = 0;
    __syncthreads();
    { const int e = C.wave; float t = 0.f, mine = 0.f;
      for (int k = C.lane; k < C.G; k += 64) { const float v = (float)cnt[k * 8 + e]; t += v; mine += (k < C.bid) ? v : 0.f; }
      t = wave_sum(t); mine = wave_sum(mine);
      if (C.lane == 0) { tot[e] = (int)t; tot[8 + e] = (int)mine; } }
    __syncthreads();
    if (C.tid == 0) { int base = 0; for (int e = 0; e < 8; ++e) { const int nt = (tot[e] + 255) >> 8; tot[16 + e] = base; tot[24 + e] = nt; base += nt * 256; } tot[40] = base >> 8; }
    __syncthreads();
    int* slot_tok = WSP(int, MO_SLOTTOK); int* tok_slot = WSP(int, MO_TOKSLOT); const int* sel = WSP(int, MO_SEL);
    { LAS int* wc = tot + 48;
      int e0 = 0, e1 = 0; const int mtok = C.bid * (M / 256) + C.tid;
      if (C.tid < 128) { const int s = sel[mtok]; e0 = s & 255; e1 = s >> 8; }
      const unsigned long long lt = (1ull << C.lane) - 1ull; int r0 = 0, r1 = 0;
      if (C.wave < 2) {
#pragma unroll
          for (int e = 0; e < 8; ++e) { const unsigned long long b0 = __ballot(e0 == e), b1 = __ballot(e1 == e);
              if (e0 == e) r0 = __popcll(b0 & lt); if (e1 == e) r1 = __popcll(b1 & lt);
              if (C.lane == 0) { wc[(C.wave * 2 + 0) * 8 + e] = __popcll(b0); wc[(C.wave * 2 + 1) * 8 + e] = __popcll(b1); } } }
      __syncthreads();
      if (C.tid < 128) { const int w = C.wave;
          const int s0 = tot[16 + e0] + tot[8 + e0] + (w == 1 ? wc[(0 * 2 + 0) * 8 + e0] : 0) + r0;
          const int s1 = tot[16 + e1] + tot[8 + e1] + wc[(0 * 2 + 0) * 8 + e1] + wc[(1 * 2 + 0) * 8 + e1] + (w == 1 ? wc[(0 * 2 + 1) * 8 + e1] : 0) + r1;
          slot_tok[s0] = mtok; slot_tok[s1] = mtok; tok_slot[2 * mtok] = s0; tok_slot[2 * mtok + 1] = s1; tot[64 + 2 * C.tid] = s0; tot[64 + 2 * C.tid + 1] = s1; } }
    __syncthreads();
    { const unsigned char* X = WSP(unsigned char, WS_XN8); unsigned char* G = WSP(unsigned char, WS_XG8);
#pragma unroll
      for (int i = 0; i < M / 256 / NWAVES; ++i) { const int r = C.wave + NWAVES * i; const int s0 = tot[64 + 2 * r], s1 = tot[64 + 2 * r + 1];
          *((u32x4*)(G + (size_t)s0 * D) + C.lane) = v[i]; *((u32x4*)(G + (size_t)s1 * D) + C.lane) = v[i]; } }
    if (C.bid < 8) {
        { const int e = C.bid; const int lo = tot[16 + e] + tot[e], hi = tot[16 + e] + tot[24 + e] * 256; for (int s = lo + C.tid; s < hi; s += 512) slot_tok[s] = 0;
            unsigned zz = 0u; asm volatile("" : "+v"(zz));
            for (int i = C.tid; i < (hi - lo) * 64; i += 512) *((u32x4*)(WSP(unsigned char, WS_XG8) + (size_t)(lo + (i >> 6)) * D) + (i & 63)) = (u32x4){zz, zz, zz, zz}; } }
    if (C.bid == 0) {
        int* texp = WSP(int, MO_TEXP);
        for (int t = C.tid; t < 512; t += 512) { int e = 0; for (int k = 0; k < 8; ++k) if (t * 256 >= tot[16 + k]) e = k; texp[t] = e; }
        if (C.tid == 0) __hip_atomic_store((gu32*)(WSP(unsigned, WS_CTL) + CW_NT), (unsigned)tot[40], RLX_AGENT);
    }
}

#ifdef DBG_CHECK
__device__ __forceinline__ void dbg_attn_check(const Ctx& C) {
    const half_t* P = WSP(half_t, WS_PROJ); const half_t* O = WSP(half_t, WS_O); float* acc = (float*)(WSP(unsigned, WS_CTL) + 256);
    for (int i = C.gw; i < 2048; i += C.NGW) {
#ifdef DBG_J
        const int s = ((i * 97 + 13) & 255) + 256 * DBG_J, h = i % 6, b = (i / 6) & 7, j = s >> 8; const size_t row = (size_t)b * SEQ + s; const int d = C.lane;
#else
        const int s = (i * 97 + 13) & 4095, h = i % 6, b = (i / 6) & 7, j = s >> 8; const size_t row = (size_t)b * SEQ + s; const int d = C.lane;
#endif
        const float qd = (float)P[row * NPROJ + h * 64 + d];
        const float* km = WSP(float, WS_KMEAN) + (size_t)(b * NH + h) * 16 * 64;
        float v1 = -INFINITY, v2 = -INFINITY, v3 = -INFINITY; int i1 = -1, i2 = -1, i3 = -1;
        for (int n = 0; n < j; ++n) { const float g = wave_sum(qd * km[n * 64 + d]);
            if (g > v1) { v3 = v2; i3 = i2; v2 = v1; i2 = i1; v1 = g; i1 = n; } else if (g > v2) { v3 = v2; i3 = i2; v2 = g; i2 = n; } else if (g > v3) { v3 = g; i3 = n; } }
        float m = -INFINITY, l = 0.f, od = 0.f;
        for (int pass = 0; pass < 2; ++pass)
            for (int blk = 0; blk <= j; ++blk) { if (blk < j && blk != i1 && blk != i2 && blk != i3) continue;
                const int kend = (blk == j) ? (s - blk * 256) : 255;
                for (int kk = 0; kk <= kend; ++kk) { const size_t kr = ((size_t)b * SEQ + blk * 256 + kk) * NPROJ + h * 64 + d;
                    const float sc = wave_sum(qd * (float)P[kr + COL_K]);
                    if (pass == 0) m = fmaxf(m, sc); else { const float p = exp2f(sc - m); l += p; od += p * (float)P[kr + COL_V]; } } }
        od /= l; const float mine = (float)O[row * D + h * 64 + d];
        const float e = wave_sum((od - mine) * (od - mine)), r = wave_sum(od * od);
        if (C.lane == 0) { atomicAdd(acc, e / r); atomicAdd(acc + 1, 1.f); }
    }
}
__device__ __forceinline__ void dbg_attn_check2(const Ctx& C, int l) {
    const half_t* P = WSP(half_t, WS_PROJ); const half_t* O = WSP(half_t, WS_O); float* acc = (float*)(WSP(unsigned, WS_CTL) + 256);
    const float* gain = WSP(float, PAR_GAIN) + (size_t)l * D;
    for (int i = C.gw; i < 512; i += C.NGW) {
        const int s = (i * 97 + 13) & 4095, b = i & 7, j = s >> 8; const size_t row = (size_t)b * SEQ + s; const int d = C.lane;
        float oh[6]; float ss = 0.f;
#pragma unroll
        for (int h = 0; h < 6; ++h) {
            const float qd = (float)P[row * NPROJ + h * 64 + d];
            const float* km = WSP(float, WS_KMEAN) + (size_t)(b * NH + h) * 16 * 64;
            float v1 = -INFINITY, v2 = -INFINITY, v3 = -INFINITY; int i1 = -1, i2 = -1, i3 = -1;
            for (int n = 0; n < j; ++n) { const float g = wave_sum(qd * km[n * 64 + d]);
                if (g > v1) { v3 = v2; i3 = i2; v2 = v1; i2 = i1; v1 = g; i1 = n; } else if (g > v2) { v3 = v2; i3 = i2; v2 = g; i2 = n; } else if (g > v3) { v3 = g; i3 = n; } }
            float m = -INFINITY, lsum = 0.f, od = 0.f;
            for (int pass = 0; pass < 2; ++pass)
                for (int blk = 0; blk <= j; ++blk) { if (blk < j && blk != i1 && blk != i2 && blk != i3) continue;
                    const int kend = (blk == j) ? (s - blk * 256) : 255;
                    for (int kk = 0; kk <= kend; ++kk) { const size_t kr = ((size_t)b * SEQ + blk * 256 + kk) * NPROJ + h * 64 + d;
                        const float sc = wave_sum(qd * (float)P[kr + COL_K]);
                        if (pass == 0) m = fmaxf(m, sc); else { const float p = exp2f(sc - m); lsum += p; od += p * (float)P[kr + COL_V]; } } }
            oh[h] = od / lsum; ss += oh[h] * oh[h];
        }
        const float msq_ = wave_sum(ss) * (1.f / 384.f); const float rstd = 1.f / sqrtf(msq_ + EPS); float e = 0.f, r = 0.f;
#ifdef DBG_MS
        if (C.lane == 0) { atomicAdd(acc + 6, msq_ * DBG_MS); atomicAdd(acc + 7, 1.f); }
#endif
#ifdef DBG_RHO
        { float sm = 0.f, so = 0.f, smo = 0.f;
#pragma unroll
          for (int h = 0; h < 6; ++h) { const float mv = (float)O[row * D + h * 64 + d]; sm += mv * mv; so += oh[h] * oh[h]; smo += mv * oh[h]; }
          sm = wave_sum(sm); so = wave_sum(so); smo = wave_sum(smo);
          if (C.lane == 0) { atomicAdd(acc + 6, smo * smo / (sm * so)); atomicAdd(acc + 7, 1.f); } }
#endif
#pragma unroll
        for (int h = 0; h < 6; ++h) {
#ifdef DBG_RAW
            const float want = oh[h],
#else
            const float want = oh[h] * rstd * gain[h * 64 + d],
#endif
            mine = (float)O[row * D + h * 64 + d]; const float eh = wave_sum((want - mine) * (want - mine)), rh = wave_sum(want * want); if (C.lane == 0) { atomicAdd(acc + 2 * (h >> 1 > 1 ? 1 : h >> 1 == 1 ? 2 : 0), eh); atomicAdd(acc + 2 * (h >> 1 > 1 ? 1 : h >> 1 == 1 ? 2 : 0) + 1, rh); } }
        (void)e; (void)r;
    }
}
__device__ __forceinline__ void dbg_meansq(const Ctx& C, int c0) {
    const half_t* O = WSP(half_t, WS_O); float* acc = (float*)(WSP(unsigned, WS_CTL) + 256);
    for (int i = C.gw; i < 4096; i += C.NGW) { const size_t row = ((size_t)i * 7919 + 3) % M; float s = 0.f;
        for (int k = 0; k < 6; ++k) { const float v = (float)O[row * D + c0 + C.lane + 64 * k]; s += v * v; }
        s = wave_sum(s); if (C.lane == 0) { atomicAdd(acc, s); atomicAdd(acc + 1, 384.f); } }
}
__device__ __forceinline__ void dbg_out_check(const Ctx& C, int l, const float* xin, const float* xres) {
    const half_t* O = WSP(half_t, WS_O); float* acc = (float*)(WSP(unsigned, WS_CTL) + 256);
    const float* W = KARG(float, I_W_OUT) + (size_t)l * D * D; const float* mod = WSP(float, WS_MOD) + (size_t)l * 8 * 6144;
    for (int i = C.gw; i < 256 * 16; i += C.NGW) {
        const int cg = i & 15, sr = i >> 4; const size_t row = ((size_t)sr * 12347 + 101) % M; const int n = cg * 64 + C.lane, b = (int)(row >> 12);
        float a = 0.f;
        for (int k = 0; k < D; ++k) a += (float)O[row * D + k] * W[(size_t)k * D + n];
        const float want = xin[row * D + n] + mod[(size_t)b * 6144 + 2048 + n] * a, mine = xres[row * D + n];
        const float e = wave_sum((want - mine) * (want - mine)), r = wave_sum((want - xin[row * D + n]) * (want - xin[row * D + n]));
        if (C.lane == 0) { atomicAdd(acc, e); atomicAdd(acc + 1, r); }
    }
}
__device__ __forceinline__ float fp8_dec(unsigned char b) { return __builtin_amdgcn_cvt_f32_fp8((int)b, 0); }
__device__ __forceinline__ void dbg_moeup_check(const Ctx& C) {
    const unsigned char* X = WSP(unsigned char, WS_XG8); const unsigned char* Wt = WSP(unsigned char, WS_MGU); const unsigned char* H = WSP(unsigned char, WS_HID); const int* texp = WSP(int, MO_TEXP);
    float* acc = (float*)(WSP(unsigned, WS_CTL) + 256);
    for (int i = C.gw; i < 4096; i += C.NGW) { const int s = (i * 131 + 7) & 16383, j = (i * 977 + 5) % FFE, e = texp[s >> 8];
        const int tile = j >> 7, w = j & 127; const unsigned char* wg = Wt + ((size_t)e * 2 * FFE + tile * 256 + w) * D; const unsigned char* wu = wg + (size_t)128 * D;
        float g = 0.f, u = 0.f;
        for (int k = DBG_K0 + C.lane; k < DBG_K1; k += 64) { const float x = fp8_dec(X[(size_t)s * D + k]); g += x * fp8_dec(wg[k]); u += x * fp8_dec(wu[k]); }
        for (int o = 1; o < 64; o <<= 1) { g += __shfl_xor(g, o); u += __shfl_xor(u, o); }
        g *= (1.f / 32.f); u *= (1.f / 32.f);
        const float want = siluf_(g) * u, mine = fp8_dec(H[(size_t)s * FFE + j]);
        if (C.lane == 0) { atomicAdd(acc, (want - mine) * (want - mine)); atomicAdd(acc + 1, want * want); } }
}
__device__ __forceinline__ f32x4 dbg_mfma8(v8i_t a, v8i_t b) { f32x4 c = {0.f, 0.f, 0.f, 0.f}; asm volatile("s_nop 15\n\ts_nop 15\n\tv_mfma_f32_16x16x128_f8f6f4 %0, %1, %2, %0\n\ts_nop 15\n\ts_nop 15" : "+v"(c) : "v"(a), "v"(b)); return c; }
__device__ __forceinline__ void dbg_mfma_probe(const Ctx& C) {
    if (C.bid != 0 || C.wave != 0) return;
    float* acc = (float*)(WSP(unsigned, WS_CTL) + 256); const int fq = C.lane >> 4; const int ONE = 0x38383838;
    v8i_t all1; for (int r = 0; r < 8; ++r) all1[r] = ONE;
    v8i_t r0 = {ONE, 0, 0, 0, 0, 0, 0, 0}, r1 = {0, ONE, 0, 0, 0, 0, 0, 0}, r4 = {0, 0, 0, 0, ONE, 0, 0, 0}, z = {0, 0, 0, 0, 0, 0, 0, 0};
    v8i_t g0 = fq == 0 ? all1 : z, g1 = fq == 1 ? all1 : z;
    const float d1 = dbg_mfma8(all1, all1)[0], d2 = dbg_mfma8(r0, r0)[0], d3 = dbg_mfma8(r0, r1)[0], d4 = dbg_mfma8(g0, g0)[0], d5 = dbg_mfma8(g0, g1)[0], d6 = dbg_mfma8(r0, r4)[0];
    v8i_t b0 = {0x38, 0, 0, 0, 0, 0, 0, 0}, b1 = {0x3800, 0, 0, 0, 0, 0, 0, 0};
    const float d7 = dbg_mfma8(b0, b0)[0], d8 = dbg_mfma8(b0, b1)[0];
    v8i_t arow3 = (C.lane & 15) == 3 ? all1 : z, bcol5 = (C.lane & 15) == 5 ? all1 : z;
    const f32x4 e1 = dbg_mfma8(arow3, all1), e2 = dbg_mfma8(all1, bcol5);
    const float e2l5 = __builtin_bit_cast(float, __builtin_amdgcn_readlane(__builtin_bit_cast(int, e2[0]), 5)), e2l4 = __builtin_bit_cast(float, __builtin_amdgcn_readlane(__builtin_bit_cast(int, e2[0]), 4));
    const float e1l17 = __builtin_bit_cast(float, __builtin_amdgcn_readlane(__builtin_bit_cast(int, e1[3]), 17));
    float wsv = (float)C.lane; asm volatile("" : "+v"(wsv)); const float ws_total = wave_sum(wsv); const float x1 = xor_lane<1>(wsv), x16 = xor_lane<16>(wsv);
    float h32 = wsv; h32 += xor_lane<1>(h32); h32 += xor_lane<2>(h32); h32 += xor_lane<4>(h32); h32 += xor_lane<8>(h32); h32 += xor_lane<16>(h32);
    if (C.lane == 0) {
#if DBG_PROBE == 6
        atomicAdd(acc, DBG_PSEL == 0 ? ws_total : DBG_PSEL == 1 ? x1 + 100.f * x16 : h32);
        atomicAdd(acc + 1, 0.f);
#elif DBG_PROBE == 66
        { }
#elif DBG_PROBE == 5
        { float one = 1.0f; asm volatile("" : "+v"(one)); const int enc = __builtin_amdgcn_cvt_pk_fp8_f32(one, one, 0, false) & 0xff; int b38 = 0x38; asm volatile("" : "+v"(b38)); const float dec = __builtin_amdgcn_cvt_f32_fp8(b38, 0);
          atomicAdd(acc, (enc == 0x38 ? 1.f : enc == 0x40 ? 2.f : 3.f) + (dec == 1.0f ? 10.f : dec == 0.5f ? 20.f : 30.f)); }
#elif DBG_PROBE == 4
        atomicAdd(acc, (e1[3] == 128.f ? 1.f : 0.f) + (e1[0] == 0.f ? 2.f : 0.f) + (e2l5 == 128.f ? 4.f : 0.f) + (e2l4 == 0.f ? 8.f : 0.f) + (e1l17 == 0.f ? 16.f : 0.f));
#elif DBG_PROBE == 0
        atomicAdd(acc, d1);
#elif DBG_PROBE == 1
        atomicAdd(acc, (d2 == 16.f ? 1.f : 0.f) + (d3 == 0.f ? 2.f : 0.f) + (d4 == 32.f ? 4.f : 0.f) + (d5 == 0.f ? 8.f : 0.f) + (d6 == 0.f ? 16.f : 0.f) + (d7 == 4.f ? 32.f : 0.f));
#elif DBG_PROBE == 2
        atomicAdd(acc, d2 + 100.f * d4);
#else
        atomicAdd(acc, d7 + 10.f * d8 + 100.f * d3 + 1000.f * d5);
#endif
        atomicAdd(acc + 1, 100.f); }
}
__device__ __forceinline__ void dbg_proj_check(const Ctx& C, int l) {
    const half_t* P = WSP(half_t, WS_PROJ); const half_t* X = WSP(half_t, WS_XN); float* acc = (float*)(WSP(unsigned, WS_CTL) + 256);
    const float* W = KARG(float, I_W_IN) + (size_t)l * D * NPROJ; const int* pos = KARG(int, I_POS);
    for (int i = C.gw; i < 256 * 34; i += C.NGW) {
        const int grp = i % 34, sr = i / 34; const size_t row = ((size_t)sr * 12347 + 101) % M; const int d = C.lane, col = grp * 64 + d;
        float a = 0.f;
        for (int k = 0; k < D; ++k) a += (float)X[row * D + k] * W[(size_t)k * NPROJ + col];
        float outv = a;
        if (grp < 12) { const float partner = __shfl_xor(a, 32); const int fi = d & 31; const float ang = (float)pos[row] * powf(10000.f, -(float)fi / 32.f); const float cs = cosf(ang), sn = sinf(ang);
            outv = (d < 32) ? a * cs - partner * sn : a * cs + partner * sn; if (grp < 6) outv *= C2; }
        const float mine = (float)P[row * NPROJ + col];
        const float e = wave_sum((outv - mine) * (outv - mine)), r = wave_sum(outv * outv); const int sel = grp < 6 ? 0 : grp < 12 ? 1 : grp < 18 ? 2 : 3;
        if (C.lane == 0) { atomicAdd(acc + 2 * sel, e); atomicAdd(acc + 2 * sel + 1, r); }
    }
}
__device__ __forceinline__ void dbg_emit(const Ctx& C, float* out) {
    const float* acc = (const float*)(WSP(unsigned, WS_CTL) + 256); float worst = 0.f;
#ifndef DBG_SEL
    for (int k = 0; k < 4; ++k) { const float e = __hip_atomic_load(acc + 2 * k, RLX_AGENT), r = __hip_atomic_load(acc + 2 * k + 1, RLX_AGENT); if (r > 0.f) worst = fmaxf(worst, e / r); }
#else
    { const float e = __hip_atomic_load(acc + 2 * DBG_SEL, RLX_AGENT), r = __hip_atomic_load(acc + 2 * DBG_SEL + 1, RLX_AGENT); worst = e / fmaxf(r, 1e-30f); }
#endif
#ifdef DBG_BUCKET
    const float c = worst > 0.f ? 2.f + 2.f * floorf(log10f(worst)) : 0.f;
#else
    const float c = sqrtf(100.f * worst);
#endif
    for (size_t i = (size_t)C.bid * 512 + C.tid; i < (size_t)M * D; i += (size_t)C.G * 512) out[i] = c;
}
#endif

#ifdef DBG_SNAP
#define DBG_EXTRA_WS (20u << 20)
#else
#define DBG_EXTRA_WS 0
#endif
#ifndef MK_N_LAUNCHES
#define MK_N_LAUNCHES 1
#endif
constexpr int NPHASE = 1 + 8 + (4 + 2 + 2 * MOE_NCHUNK + 1);

__global__ void __launch_bounds__(NWAVES * 64, 2) mk_fwd(Args A_unused) {
    extern __shared__ __attribute__((aligned(16))) unsigned char lds_raw[];
    Ctx C0; { Ctx& C = C0; C.lds = (LAS unsigned char*)lds_raw; C.tid = threadIdx.x; C.lane = C.tid & 63; C.wave = __builtin_amdgcn_readfirstlane(C.tid >> 6);
    C.G = gridDim.x; C.bid = blockIdx.x; C.gw = C.bid * NWAVES + C.wave; C.NGW = C.G * NWAVES; C.ws = (unsigned char*)karg(I_WS); }
    const Ctx& C = C0;
    volatile LAS unsigned* MISC = (volatile LAS unsigned*)(C.lds + MISC_OFF);
    unsigned* ctl = (unsigned*)(GAS unsigned*)((unsigned long long)C.ws + WS_CTL);
    for (int u = C.tid; u < (LDS_BYTES - LDSCTL_OFF) / 4; u += NWAVES * 64) ((LAS unsigned*)(C.lds + LDSCTL_OFF))[u] = 0u;
    __syncthreads();
    XcdBarrier bar = xcd_barrier_post(ctl + CW_BAR, MISC + 8);
    const int lo = A_unused.ph_lo, hi = A_unused.ph_hi; int pid = 0;
#define OPAQUE_CTX(Cn, Co) Ctx Cn = Co; { unsigned long long w_ = (unsigned long long)Cn.ws; unsigned l_ = (unsigned)(uintptr_t)Cn.lds; unsigned z_ = 0u; asm volatile("" : "+v"(z_)); Cn.lane = (int)__builtin_amdgcn_mbcnt_hi(~0u, __builtin_amdgcn_mbcnt_lo(~0u, z_)); Cn.tid = Cn.wave * 64 + Cn.lane; \
    asm volatile("" : "+s"(Cn.wave), "+s"(Cn.bid), "+s"(Cn.gw), "+s"(w_), "+s"(l_)); Cn.ws = (unsigned char*)w_; Cn.lds = (LAS unsigned char*)(uintptr_t)l_; }
#define WSQ(Cx, T, off) ((T*)(GAS T*)((unsigned long long)Cx.ws + (off)))
#ifndef DBG_REPMASK
#define DBG_REPMASK 0ull
#endif
#define PH_BEGIN if (lo <= pid && pid < hi) { const int nrep_ = ((DBG_REPMASK >> pid) & 1ull) ? 2 : 1; for (int rep_ = 0; rep_ < nrep_; ++rep_) { OPAQUE_CTX(C, C0)
#define PH_END if (rep_ + 1 < nrep_) { XcdBarrier b3_ = bar; asm volatile("" : "+s"(b3_.bar)); xcd_barrier(b3_); } } } if (lo <= pid && pid + 1 < hi) { XcdBarrier b2_ = bar; asm volatile("" : "+s"(b2_.bar)); xcd_barrier(b2_); } ++pid;
    half_t* xres = WSP(half_t, WS_RES);
    float* mod = WSP(float, WS_MOD);

#if defined(DBG_CHECK) && DBG_CHECK == 11
    PH_BEGIN dbg_mfma_probe(C); PH_END  PH_BEGIN dbg_emit(C, (float*)(GAS float*)(unsigned long long)karg(I_OUT)); PH_END
#endif
    PH_BEGIN p0_prologue(C);
        wait_count(ctl + CW_MOD0, 32u);
        { const Ctx& Cp_ = C; { OPAQUE_CTX(C, Cp_) row_pass_xn<false>(C, KARG(float, I_X), KARG(float, I_NORM1_G), mod + 0, mod + 1024, WSP(half_t, WS_XN), nullptr, nullptr); } }
    PH_END

    for (int l = 0; l < 2; ++l) {
        const float* modl = mod + (size_t)l * 8 * 6144;
        PH_BEGIN
            pg8::Gemm g{WSP(half_t, WS_XN), WSP(half_t, WS_WIN) + (size_t)l * NPROJ_PAD * D, M, NPROJ_PAD, D, nullptr}; pg8::StaticOrder S; S.init(M, NPROJ_PAD, C.G, C.bid);
            EpiProj E{WSP(half_t, WS_PROJ), WSP(float, WS_ROPE_C), WSP(float, WS_ROPE_S)};
            pg8::gemm_phase<EpiProj, pg8::StaticOrder, true, true, false>(C.lds, g, S, E, C.wave);
        PH_END
#if defined(DBG_CHECK) && DBG_CHECK == 2
        if (l == 0) { PH_BEGIN dbg_proj_check(C, l); PH_END  PH_BEGIN dbg_emit(C, (float*)(GAS float*)(unsigned long long)karg(I_OUT)); PH_END }
#endif
        PH_BEGIN
#ifndef DBG_PREPREP
#define DBG_PREPREP 0
#endif
            kmean_items(C);
            for (int pr_ = 0; pr_ < ((DBG_PREPREP & 1) ? 2 : 1); ++pr_)
            for (int u = C.bid; u < BATCH * NCH; u += C.G) { OPAQUE_CTX(Cu, C) lru_prep_unit(Cu, l, u / NCH, u % NCH); }
            for (int pr_ = 0; pr_ < ((DBG_PREPREP & 2) ? 2 : 1); ++pr_)
            for (int u = C.bid; u < BATCH * NCH; u += C.G) { OPAQUE_CTX(Cu, C) s5_unit<false>(Cu, l, u / NCH, u % NCH); }
        PH_END
        PH_BEGIN
            unsigned* qw = ctl + (l == 0 ? CW_Q0 : CW_Q1) + 320 * rep_;
            constexpr int NATT = BATCH * NH * 16, NSC = BATCH * NCH;
            unsigned rdy_ = 0u;
            unsigned nxt_ = 0u; if (C.tid == 0) nxt_ = __hip_atomic_fetch_add(qw, 1u, RLX_AGENT);
            for (;;) {
                __syncthreads();
                if (C.tid == 0) MISC[0] = nxt_;
                __syncthreads();
#ifndef DBG_MIXREP
#define DBG_MIXREP 0
#endif
                constexpr int RA = (DBG_MIXREP & 1) ? 2 : 1, RS = (DBG_MIXREP & 2) ? 2 : 1, RL = (DBG_MIXREP & 4) ? 2 : 1;
                int idx = (int)MISC[0];
                if (idx >= BATCH + RA * NATT + (RS + RL) * NSC) break;
                if (C.tid == 0) nxt_ = __hip_atomic_fetch_add(qw, 1u, RLX_AGENT);
                const bool carry_ = idx < BATCH; const int cb_ = idx; idx -= BATCH;
                if (carry_) idx = 0; else if (idx < RA * NATT) idx %= NATT; else { idx -= RA * NATT; if (idx < RS * NSC) idx = NATT + idx % NSC; else idx = NATT + NSC + (idx - RS * NSC) % NSC; }
                OPAQUE_CTX(Cu, C)
                if (carry_) carry_unit(Cu, l, cb_);
                else if (idx < NATT) { const int j = 15 - idx / (BATCH * NH), bh = idx % (BATCH * NH), b = bh / NH, h = bh % NH;
                    attn_body::attn_unit<8>(b, h, j, WSQ(Cu, half_t, WS_PROJ), WSQ(Cu, half_t, WS_PROJ) + COL_K, WSQ(Cu, half_t, WS_PROJ) + COL_V, WSQ(Cu, half_t, WS_O), WSQ(Cu, float, WS_KMEAN) + (size_t)bh * 16 * 64, WSQ(Cu, float, WS_SSQ), (LAS char*)Cu.lds, Cu.wave); }
                else { const int u = idx < NATT + NSC ? idx - NATT : idx - NATT - NSC, ub = u / NCH;
                    if (!((rdy_ >> ub) & 1u)) { wait_count(ctl + CW_CARRY + l * 8 + ub, 1u); rdy_ |= 1u << ub; }
                    if (idx < NATT + NSC) s5_unit<true>(Cu, l, ub, u % NCH); else lru_final_unit(Cu, l, ub, u % NCH); }
            }
        PH_END
#if defined(DBG_CHECK) && DBG_CHECK == 1
        if (l == 0) { PH_BEGIN dbg_attn_check(C); PH_END  PH_BEGIN dbg_emit(C, (float*)(GAS float*)(unsigned long long)karg(I_OUT)); PH_END }
#endif
#if defined(DBG_CHECK) && DBG_CHECK == 5
        if (l == 0) { PH_BEGIN dbg_attn_check2(C, l); PH_END  PH_BEGIN dbg_emit(C, (float*)(GAS float*)(unsigned long long)karg(I_OUT)); PH_END }
#endif
#if defined(DBG_CHECK) && DBG_CHECK == 4
        if (l == 0) { PH_BEGIN dbg_meansq(C, DBG_C0); PH_END  PH_BEGIN dbg_emit(C, (float*)(GAS float*)(unsigned long long)karg(I_OUT)); PH_END }
#endif
#if defined(DBG_CHECK) && DBG_CHECK == 3
        if (l == 0) { PH_BEGIN dbg_attn_check2(C, l); PH_END  PH_BEGIN dbg_emit(C, (float*)(GAS float*)(unsigned long long)karg(I_OUT)); PH_END }
#endif
        PH_BEGIN
            pg8::Gemm g{WSP(half_t, WS_O), WSP(half_t, WS_WOUT) + (size_t)l * D * D, M, D, D, nullptr, WSP(float, WS_SSQ), 6}; pg8::StaticOrder S; S.init(M, D, C.G, C.bid);
            if (l == 0) { EpiResidT<float> E{KARG(float, I_X), xres, modl + 2048, 1.f}; pg8::gemm_phase<EpiResidT<float>, pg8::StaticOrder, true, true, false>(C.lds, g, S, E, C.wave); }
            else { EpiResidT<half_t> E{xres, xres, modl + 2048, 1.f}; pg8::gemm_phase<EpiResidT<half_t>, pg8::StaticOrder, true, true, false>(C.lds, g, S, E, C.wave); }
        PH_END
#if defined(DBG_CHECK) && DBG_CHECK == 6
        if (l == 0) { PH_BEGIN dbg_out_check(C, l, KARG(float, I_X), xres); PH_END  PH_BEGIN dbg_emit(C, (float*)(GAS float*)(unsigned long long)karg(I_OUT)); PH_END }
#endif
        if (l == 0) {
            PH_BEGIN row_pass_xn<false, DENSE_FP8 != 0>(C, xres, WSP(float, PAR_N2G), modl + 3072, modl + 4096, WSP(half_t, WS_XN), nullptr, nullptr); PH_END
            PH_BEGIN
#if DENSE_FP8
                pg8::Gemm g{WSP(unsigned char, WS_XN), WSP(unsigned char, WS_WGU), M, 2 * FF, D, nullptr, nullptr, 0}; pg8::StaticOrder S; S.init(M, 2 * FF, C.G, C.bid);
                EpiSwiglu8 E{WSP(unsigned char, WS_HID), FF, 1.f / 32.f};
                pg8::gemm_phase<EpiSwiglu8, pg8::StaticOrder, true, true, false, true>(C.lds, g, S, E, C.wave);
#else
                pg8::Gemm g{WSP(half_t, WS_XN), WSP(half_t, WS_WGU), M, 2 * FF, D, nullptr, nullptr, 0}; pg8::StaticOrder S; S.init(M, 2 * FF, C.G, C.bid);
                EpiSwiglu E{WSP(half_t, WS_HID), FF};
                pg8::gemm_phase<EpiSwiglu, pg8::StaticOrder, true, true, false>(C.lds, g, S, E, C.wave);
#endif
            PH_END
            PH_BEGIN
#if DENSE_FP8
                pg8::Gemm g{WSP(unsigned char, WS_HID), WSP(unsigned char, WS_WD), M, D, FF, nullptr, nullptr, 0}; pg8::StaticOrder S; S.init(M, D, C.G, C.bid);
                EpiResidT<half_t> E{xres, xres, modl + 5120, 1.f / 64.f};
                pg8::gemm_phase<EpiResidT<half_t>, pg8::StaticOrder, true, true, false, true>(C.lds, g, S, E, C.wave);
#else
                pg8::Gemm g{WSP(half_t, WS_HID), WSP(half_t, WS_WD), M, D, FF, nullptr, nullptr, 0}; pg8::StaticOrder S; S.init(M, D, C.G, C.bid);
                EpiResidT<half_t> E{xres, xres, modl + 5120, 1.f};
                pg8::gemm_phase<EpiResidT<half_t>, pg8::StaticOrder, true, true, false>(C.lds, g, S, E, C.wave);
#endif
            PH_END
            PH_BEGIN row_pass_xn<false>(C, xres, WSP(float, PAR_N1G) + D, mod + 8 * 6144 + 0, mod + 8 * 6144 + 1024, WSP(half_t, WS_XN), nullptr, nullptr); PH_END
        } else {
            PH_BEGIN
                LAS unsigned* lcnt = (LAS unsigned*)C.lds;
                __syncthreads(); if (C.tid < 8) lcnt[C.tid] = 0u; __syncthreads();
                row_pass_xn<true>(C, xres, WSP(float, PAR_N2G) + D, modl + 3072, modl + 4096, (half_t*)WSP(unsigned char, WS_XN8), WSP(float, PAR_ROUTER), lcnt);
                __syncthreads(); if (C.tid < 8) WSP(int, MO_BLKCNT)[C.bid * 8 + C.tid] = (int)lcnt[C.tid];
            PH_END
            PH_BEGIN moe_lists(C); PH_END
            for (int ch = 0; ch < MOE_NCHUNK; ++ch) {
                PH_BEGIN
                    const int NT = (int)__hip_atomic_load((gu32*)(ctl + CW_NT), RLX_AGENT); const int nt0 = NT > MOE_REG_TILES ? NT - MOE_REG_TILES : NT; const int t0 = ch == 0 ? 0 : nt0; const int nt = ch == 0 ? nt0 : NT - nt0;
#ifdef DBG_MOE_UP_COPY
                    if (nt > 0) { const int* st = WSP(int, MO_SLOTTOK) + t0 * 256; half_t* H = WSP(half_t, WS_HID); const half_t* X = WSP(half_t, WS_XN);
                        for (size_t i = (size_t)C.bid * 512 + C.tid; i < (size_t)nt * 256 * FFE; i += (size_t)C.G * 512) { const int r = (int)(i / FFE), k = (int)(i % FFE); H[i] = X[(size_t)st[r] * D + (k & 1023)] * (half_t)0.05f; } }
                    if (false) {
#else
                    if (nt > 0) {
#endif
#ifdef DBG_NOGATHER
                        pg8::Gemm g{WSP(half_t, WS_XN) + (size_t)((t0 * 256) % 16384) * D, WSP(half_t, WS_MGU), nt * 256, 2 * FFE, D, nullptr};
                        pg8::MoeOrder S; S.so.init(nt * 256, 2 * FFE, C.G, C.bid); S.texp = WSP(int, MO_TEXP) + t0; S.nNe = 2 * FFE / 256;
                        EpiSwiglu E{WSP(half_t, WS_HID), FFE};
                        pg8::gemm_phase<EpiSwiglu, pg8::MoeOrder, true, true, false>(C.lds, g, S, E, C.wave);
#else
                        int T = 0;
                        if (ch == 1 && nt0 > MOE_REG_TILES) {
                            const int ntt = nt0 - MOE_REG_TILES; T = ntt * 4;
                            pg8::Gemm g{WSP(unsigned char, WS_HID) + (size_t)MOE_REG_TILES * 256 * FFE, WSP(unsigned char, WS_MD), ntt * 256, D, FFE, nullptr, nullptr, 0};
                            pg8::MoeOrder S; S.so.init(ntt * 256, D, C.G, C.bid); S.texp = WSP(int, MO_TEXP) + MOE_REG_TILES; S.nNe = D / 256;
                            EpiY E{WSP(half_t, WS_Y) + (size_t)MOE_REG_TILES * 256 * D, 1.f / 64.f};
                            pg8::gemm_phase<EpiY, pg8::MoeOrder, true, true, false, true>(C.lds, g, S, E, C.wave);
                        }
                        pg8::Gemm g{WSP(unsigned char, WS_XG8) + (size_t)t0 * 256 * D, WSP(unsigned char, WS_MGU), nt * 256, 2 * FFE, D, nullptr, nullptr, 0};
                        pg8::MoeSkewOrder S; S.so.init(nt * 256, 2 * FFE, C.G, C.bid); S.texp = WSP(int, MO_TEXP) + t0; S.nNe = 2 * FFE / 256; S.T = T;
                        EpiSwiglu8 E{WSP(unsigned char, WS_HID), FFE, 1.f / 32.f};
                        pg8::gemm_phase<EpiSwiglu8, pg8::MoeSkewOrder, true, true, false, true>(C.lds, g, S, E, C.wave);
#endif
                    }
                PH_END
#if defined(DBG_CHECK) && DBG_CHECK == 10
                if (ch == 0) { PH_BEGIN dbg_moeup_check(C); PH_END  PH_BEGIN dbg_emit(C, (float*)(GAS float*)(unsigned long long)karg(I_OUT)); PH_END }
#endif
                PH_BEGIN
                    const int NT = (int)__hip_atomic_load((gu32*)(ctl + CW_NT), RLX_AGENT); const int nt0 = NT > MOE_REG_TILES ? NT - MOE_REG_TILES : NT; const int t0 = ch == 0 ? 0 : nt0; const int nt = ch == 0 ? nt0 : NT - nt0;
#ifdef DBG_MOE_DOWN_COPY
                    if (nt > 0) { const half_t* H = WSP(half_t, WS_HID); half_t* Yc = WSP(half_t, WS_Y) + (size_t)t0 * 256 * D;
                        for (size_t i = (size_t)C.bid * 512 + C.tid; i < (size_t)nt * 256 * D; i += (size_t)C.G * 512) { const int r = (int)(i / D), k = (int)(i % D); Yc[i] = H[(size_t)r * FFE + k] + H[(size_t)r * FFE + 1024 + k] + H[(size_t)r * FFE + 2048 + k]; } }
                    if (false) {
#else
                    if (nt > 0) {
#endif
                        const int ntr = nt > MOE_REG_TILES ? MOE_REG_TILES : nt;
                        pg8::Gemm g{WSP(unsigned char, WS_HID), WSP(unsigned char, WS_MD), ntr * 256, D, FFE, nullptr, nullptr, 0};
                        pg8::MoeOrder S; S.so.init(ntr * 256, D, C.G, C.bid); S.texp = WSP(int, MO_TEXP) + t0; S.nNe = D / 256;
                        EpiY E{WSP(half_t, WS_Y) + (size_t)t0 * 256 * D, 1.f / 64.f};
                        pg8::gemm_phase<EpiY, pg8::MoeOrder, true, true, false, true>(C.lds, g, S, E, C.wave);
                    }
                PH_END
            }
            PH_BEGIN row_pass_final(C, xres, (float*)(GAS float*)(unsigned long long)karg(I_OUT), modl + 5120, WSP(float, PAR_FG)); PH_END
        }
    }
#ifdef DBG_EXTRABAR
    for (int eb_ = 0; eb_ < DBG_EXTRABAR; ++eb_) { XcdBarrier b4_ = bar; asm volatile("" : "+s"(b4_.bar)); xcd_barrier(b4_); }
#endif
#ifdef DBG_SNAP
    constexpr size_t SNAP_OFF = 553 * MiB, SNAP_N = 4u << 20;
#ifndef DBG_IDX
#define DBG_IDX(i) ((i) * DBG_STRIDE)
#endif
#if DBG_SRC_MIB < 0
    const unsigned* dsrc = (const unsigned*)xres;
#else
    const unsigned* dsrc = WSP(unsigned, (size_t)DBG_SRC_MIB * MiB);
#endif
    PH_BEGIN { unsigned* snap = WSP(unsigned, SNAP_OFF); for (size_t i = (size_t)C.bid * 512 + C.tid; i < SNAP_N; i += (size_t)C.G * 512) snap[i] = dsrc[DBG_IDX(i)]; } PH_END
    PH_BEGIN if (C.bid == 0 && C.tid == 0) { __hip_atomic_store(ctl + CW_Q0, 0u, RLX_AGENT); __hip_atomic_store(ctl + CW_Q1, 0u, RLX_AGENT); } PH_END
    PH_BEGIN { const unsigned* snap = WSP(unsigned, SNAP_OFF); float* acc = (float*)(ctl + 256); float cnt = 0.f;
               for (size_t i = (size_t)C.bid * 512 + C.tid; i < SNAP_N; i += (size_t)C.G * 512) cnt += (snap[i] != dsrc[DBG_IDX(i)]) ? 1.f : 0.f;
               cnt = wave_sum(cnt); if (C.lane == 0 && cnt > 0.f) atomicAdd(acc, cnt);
               if (C.bid == 0 && C.tid == 0) atomicAdd(acc + 1, 1.f); } PH_END
    PH_BEGIN dbg_emit(C, (float*)(GAS float*)(unsigned long long)karg(I_OUT)); PH_END
#endif
#undef PH_BEGIN
#undef PH_END
}

extern "C" void kernel_launch(void* const* d_in, const int* in_sizes, int n_in, void* d_out, int out_size, void* d_ws, size_t ws_size, hipStream_t stream) {
    static int grid = 0;
    if (grid == 0) {
        if (n_in != 35 || in_sizes[0] != M * D || out_size != M * D || ws_size < WS_END + DBG_EXTRA_WS) { fprintf(stderr, "kernel_launch: unexpected problem (n_in %d, in0 %d, out %d, ws %zu < %zu)\n", n_in, n_in > 0 ? in_sizes[0] : -1, out_size, ws_size, (size_t)WS_END); grid = -1; return; }
        int dev = 0, cus = 0, per_cu = 0;
        if (hipGetDevice(&dev) != hipSuccess || hipDeviceGetAttribute(&cus, hipDeviceAttributeMultiprocessorCount, dev) != hipSuccess) { grid = -1; return; }
        if (hipFuncSetAttribute((const void*)mk_fwd, hipFuncAttributeMaxDynamicSharedMemorySize, LDS_BYTES) != hipSuccess) { fprintf(stderr, "kernel_launch: hipFuncSetAttribute failed\n"); grid = -1; return; }
        if (hipOccupancyMaxActiveBlocksPerMultiprocessor(&per_cu, (const void*)mk_fwd, NWAVES * 64, LDS_BYTES) != hipSuccess || per_cu < 1) { fprintf(stderr, "kernel_launch: occupancy query says %d blocks per CU\n", per_cu); grid = -1; (void)hipGetLastError(); return; }
        (void)hipGetLastError();
        if (cus < 256) { fprintf(stderr, "kernel_launch: needs 256 CUs\n"); grid = -1; return; }
        grid = 256;
    }
    if (grid < 0) return;
    if (hipMemsetAsync((char*)d_ws + WS_CTL, 0, CTL_ZERO_BYTES, stream) != hipSuccess) return;
    Args a{};
    for (int i = 0; i < 35; ++i) a.in[i] = d_in[i];
    a.out = (float*)d_out; a.ws = (unsigned char*)d_ws;
#ifndef DBG_PH_HI
#define DBG_PH_HI NPHASE
#endif
#if MK_N_LAUNCHES == 1
    a.ph_lo = 0; a.ph_hi = DBG_PH_HI;
    hipLaunchKernelGGL(mk_fwd, dim3(grid), dim3(NWAVES * 64), LDS_BYTES, stream, a);
#else
#ifdef DBG_PHLIST
    { static const int plist[] = {DBG_PHLIST}; for (int i = 0; i < (int)(sizeof(plist) / sizeof(int)); ++i) { a.ph_lo = plist[i]; a.ph_hi = plist[i] + 1; hipLaunchKernelGGL(mk_fwd, dim3(grid), dim3(NWAVES * 64), LDS_BYTES, stream, a); } }
#else
    for (int p = 0; p < DBG_PH_HI; ++p) { a.ph_lo = p; a.ph_hi = p + 1; hipLaunchKernelGGL(mk_fwd, dim3(grid), dim3(NWAVES * 64), LDS_BYTES, stream, a); }
#endif
#endif
}
```
